# Optimizing an MI355X kernel written in HIP

```python
import math
import jax, jax.numpy as jnp
from jax import lax
import numpy as np

D_MODEL = 1024
BATCH = 8
SEQ = 4096
DEPTH = 4

MIX_WIDTH = D_MODEL
FOURIER_WIDTH = MIX_WIDTH // 2
ATTN_WIDTH = MIX_WIDTH - FOURIER_WIDTH
N_FOURIER_GROUPS = 4
FOURIER_GROUP_DIM = FOURIER_WIDTH // N_FOURIER_GROUPS
N_ATTN_HEADS = 4
HEAD_DIM = ATTN_WIDTH // (2 * N_ATTN_HEADS)
V_HEAD_DIM = 2 * HEAD_DIM
QK_WIDTH = N_ATTN_HEADS * 2 * HEAD_DIM
V_WIDTH = N_ATTN_HEADS * V_HEAD_DIM
IN_WIDTH = FOURIER_WIDTH + 2 * QK_WIDTH + V_WIDTH + MIX_WIDTH
ROT_DIM = HEAD_DIM // 4
ROPE_THETA = 500000.0
N_META = 16
Q_BLOCK = 128
NORM_EPS = 1e-6

kernel_name = "hybrid_fourier_diffattn_encoder"


def rms_norm(x, g, eps=NORM_EPS):
    xf = x.astype(jnp.float32)
    y = xf * lax.rsqrt(jnp.mean(xf * xf, axis=-1, keepdims=True) + eps)
    return y.astype(x.dtype) * g


def rope_tables(length):
    inv_freq = ROPE_THETA ** (-jnp.arange(0, ROT_DIM, 2, dtype=jnp.float32) / ROT_DIM)
    pos = jnp.arange(length, dtype=jnp.float32)
    ang = pos[:, None] * inv_freq[None, :]
    return jnp.cos(ang), jnp.sin(ang)


def apply_partial_rotary(x, cos, sin):
    xr = x[..., :ROT_DIM].astype(jnp.float32)
    half = ROT_DIM // 2
    x1, x2 = xr[..., :half], xr[..., half:]
    c = cos[None, :, None, None, :]
    s = sin[None, :, None, None, :]
    rot = jnp.concatenate([x1 * c - x2 * s, x2 * c + x1 * s], axis=-1)
    return jnp.concatenate([rot.astype(x.dtype), x[..., ROT_DIM:]], axis=-1)


def fourier_mixer(f_in, w_f):
    b, l, _ = f_in.shape
    u = f_in.reshape(b, l, N_FOURIER_GROUPS, FOURIER_GROUP_DIM).astype(jnp.float32)
    f = jnp.fft.fft2(u, axes=(1, 3), norm="ortho").real.astype(f_in.dtype)
    out = jnp.einsum('blgc,gce->blge', f, w_f)
    return out.reshape(b, l, FOURIER_WIDTH)


def diff_attention(q, k, v, lam):
    b, l = q.shape[0], q.shape[1]
    seq = l - N_META
    scale = HEAD_DIM ** -0.5
    vf = v.astype(jnp.float32)
    lam_f = lam.astype(jnp.float32)

    def attend(qb):
        s = jnp.einsum('bqhcd,bkhcd->bhcqk', qb, k).astype(jnp.float32) * scale
        p = jax.nn.softmax(s, axis=-1)
        a = p[:, :, 0] - lam_f * p[:, :, 1]
        o = jnp.einsum('bhqk,bkhd->bqhd', a, vf)
        return o.astype(v.dtype)

    o_meta = attend(q[:, :N_META])
    nb = seq // Q_BLOCK
    q_real = q[:, N_META:].reshape(b, nb, Q_BLOCK, N_ATTN_HEADS, 2, HEAD_DIM)
    o_real = lax.map(attend, jnp.moveaxis(q_real, 1, 0))
    o_real = jnp.moveaxis(o_real, 0, 1).reshape(b, seq, N_ATTN_HEADS, V_HEAD_DIM)
    return jnp.concatenate([o_meta, o_real], axis=1)


def setup_inputs(seed: int = 0) -> dict:
    key = jax.random.key(seed)
    ks = jax.random.split(key, 16)
    f32 = jnp.float32
    x = jax.random.normal(ks[0], (BATCH, SEQ, D_MODEL), f32)
    meta_tokens = jax.random.normal(ks[1], (N_META, D_MODEL), f32)
    norm_gain = 1.0 + 0.02 * jax.random.normal(ks[2], (DEPTH, D_MODEL), f32)
    w_in = jax.random.normal(ks[3], (DEPTH, D_MODEL, IN_WIDTH), f32) * D_MODEL ** -0.5
    w_fourier = jax.random.normal(ks[4], (DEPTH, N_FOURIER_GROUPS, FOURIER_GROUP_DIM, FOURIER_GROUP_DIM), f32) * FOURIER_GROUP_DIM ** -0.5
    q_norm_gain = 1.0 + 0.02 * jax.random.normal(ks[5], (DEPTH, HEAD_DIM), f32)
    k_norm_gain = 1.0 + 0.02 * jax.random.normal(ks[6], (DEPTH, HEAD_DIM), f32)
    lambda_q1 = 0.1 * jax.random.normal(ks[7], (DEPTH, HEAD_DIM), f32)
    lambda_k1 = 0.1 * jax.random.normal(ks[8], (DEPTH, HEAD_DIM), f32)
    lambda_q2 = 0.1 * jax.random.normal(ks[9], (DEPTH, HEAD_DIM), f32)
    lambda_k2 = 0.1 * jax.random.normal(ks[10], (DEPTH, HEAD_DIM), f32)
    subln_gain = 1.0 + 0.02 * jax.random.normal(ks[11], (DEPTH, V_HEAD_DIM), f32)
    w_out = jax.random.normal(ks[12], (DEPTH, MIX_WIDTH, D_MODEL), f32) * MIX_WIDTH ** -0.5
    return {"x": x, "meta_tokens": meta_tokens, "norm_gain": norm_gain, "w_in": w_in,
            "w_fourier": w_fourier, "q_norm_gain": q_norm_gain, "k_norm_gain": k_norm_gain,
            "lambda_q1": lambda_q1, "lambda_k1": lambda_k1, "lambda_q2": lambda_q2,
            "lambda_k2": lambda_k2, "subln_gain": subln_gain, "w_out": w_out}


def reference(x, meta_tokens, norm_gain, w_in, w_fourier, q_norm_gain, k_norm_gain,
              lambda_q1, lambda_k1, lambda_q2, lambda_k2, subln_gain, w_out):
    b = x.shape[0]
    meta = jnp.broadcast_to(meta_tokens[None].astype(x.dtype), (b, N_META, D_MODEL))
    h_res = jnp.concatenate([meta, x], axis=1)
    l = h_res.shape[1]
    cos, sin = rope_tables(l)
    splits = [FOURIER_WIDTH, FOURIER_WIDTH + QK_WIDTH, FOURIER_WIDTH + 2 * QK_WIDTH,
              FOURIER_WIDTH + 2 * QK_WIDTH + V_WIDTH]

    for li in range(DEPTH):
        lambda_init = 0.8 - 0.6 * math.exp(-0.3 * li)
        h = rms_norm(h_res, norm_gain[li])
        proj = h @ w_in[li]
        f_in, q, k, v, gate = jnp.split(proj, splits, axis=-1)

        f_out = fourier_mixer(f_in, w_fourier[li])

        q = q.reshape(b, l, N_ATTN_HEADS, 2, HEAD_DIM)
        k = k.reshape(b, l, N_ATTN_HEADS, 2, HEAD_DIM)
        v = v.reshape(b, l, N_ATTN_HEADS, V_HEAD_DIM)
        q = apply_partial_rotary(rms_norm(q, q_norm_gain[li]), cos, sin)
        k = apply_partial_rotary(rms_norm(k, k_norm_gain[li]), cos, sin)
        lam = (jnp.exp(jnp.sum(lambda_q1[li].astype(jnp.float32) * lambda_k1[li].astype(jnp.float32)))
               - jnp.exp(jnp.sum(lambda_q2[li].astype(jnp.float32) * lambda_k2[li].astype(jnp.float32)))
               + lambda_init)
        o = diff_attention(q, k, v, lam)
        o = rms_norm(o, subln_gain[li]) * (1.0 - lambda_init)
        a_out = o.reshape(b, l, V_WIDTH)

        y = jnp.concatenate([f_out, a_out], axis=-1) * jax.nn.silu(gate)
        h_res = h_res + y @ w_out[li]

    return h_res[:, N_META:]
```

```cpp
#include <hip/hip_runtime.h>
#include <hip/hip_bf16.h>
#include <hip/hip_cooperative_groups.h>
#include <cstdio>
#include <cstdint>
namespace cg = cooperative_groups;

#ifndef MULTI_LAUNCH
#define MULTI_LAUNCH 0
#endif

typedef unsigned short u16;
using bf16x8 = __attribute__((ext_vector_type(8))) short;
using s16x4  = __attribute__((ext_vector_type(4))) short;
using f32x4  = __attribute__((ext_vector_type(4))) float;
using f32x16 = __attribute__((ext_vector_type(16))) float;
using u32x4  = __attribute__((ext_vector_type(4))) unsigned;
using u32x2  = __attribute__((ext_vector_type(2))) unsigned;

constexpr int NB = 8, SEQ = 4096, NMETA = 16, L = 4112, DM = 1024, DEPTH = 4;
constexpr int R = NB * L;
constexpr int RP = 33024;
constexpr int INW = 3072;
constexpr int NH = 4;
constexpr int LP = 4224;
constexpr int LH = 2056;
constexpr int KROWS = 2176;
constexpr int KP = 2112;
constexpr int NKT = 65;
constexpr float EPS = 1e-6f;

constexpr size_t al256(size_t x) { return (x + 255) / 256 * 256; }
constexpr size_t OFF_META = 0;
constexpr size_t OFF_XB   = al256(OFF_META + (size_t)NB * NMETA * DM * 4);
constexpr size_t OFF_GY   = al256(OFF_XB + (size_t)RP * DM * 2);
constexpr size_t OFF_QN   = al256(OFF_GY + (size_t)RP * DM * 2);
constexpr size_t QKV_BYTES = (size_t)NB * NH * LP * 128 * 2;
constexpr size_t OFF_KN   = al256(OFF_QN + QKV_BYTES);
constexpr size_t OFF_VN   = al256(OFF_KN + QKV_BYTES);
constexpr size_t OFF_WIN  = al256(OFF_VN + QKV_BYTES);
constexpr size_t OFF_WOUT = al256(OFF_WIN + (size_t)DEPTH * INW * DM * 2);
constexpr size_t OFF_CM   = al256(OFF_WOUT + (size_t)DEPTH * DM * DM * 2);
constexpr size_t OFF_SM   = al256(OFF_CM + (size_t)KROWS * KP * 2);
constexpr size_t OFF_MCS  = al256(OFF_SM + (size_t)KROWS * KP * 2);
constexpr size_t OFF_UTA  = al256(OFF_MCS + (size_t)DEPTH * 4 * 128 * 256 * 2);
constexpr size_t OFF_UTB  = al256(OFF_UTA + (size_t)NB * 512 * KP * 2);
constexpr size_t OFF_RSS  = al256(OFF_UTB + (size_t)NB * 512 * KP * 2);
constexpr size_t OFF_ROPE = al256(OFF_RSS + (size_t)RP * 16 * 4);
constexpr size_t OFF_CST  = al256(OFF_ROPE + (size_t)L * 16 * 4);
constexpr size_t OFF_SMALL = al256(OFF_CST + 256);
constexpr size_t OFF_CNT  = al256(OFF_SMALL + 4096);
constexpr size_t OFF_GG   = al256(OFF_CNT + 256);
constexpr size_t OFF_Q    = al256(OFF_GG + (size_t)RP * DM * 2);
constexpr size_t WS_END   = OFF_Q + 4 * 2 * 16 * 16 * 4;

struct Params {
  const float *x, *meta, *norm_gain, *w_in, *w_f, *qg, *kg, *lq1, *lk1, *lq2, *lk2, *subln, *w_out;
  float* out;
  char* ws;
};

struct P2 { float* out; char* ws; const float* x; const float* meta; };
__device__ __forceinline__ void grid_barrier(unsigned* bar, unsigned target) {
  asm volatile("s_waitcnt vmcnt(0) lgkmcnt(0)" ::: "memory");
  __syncthreads();
  if (threadIdx.x == 0) {
    __builtin_amdgcn_fence(__ATOMIC_RELEASE, "agent");
    asm volatile("s_waitcnt vmcnt(0)" ::: "memory");
    __hip_atomic_fetch_add(bar, 1u, __ATOMIC_RELAXED, __HIP_MEMORY_SCOPE_AGENT);
    while (__hip_atomic_load(bar, __ATOMIC_RELAXED, __HIP_MEMORY_SCOPE_AGENT) < target) __builtin_amdgcn_s_sleep(2);
    __builtin_amdgcn_fence(__ATOMIC_ACQUIRE, "agent");
    asm volatile("s_waitcnt vmcnt(0)" ::: "memory");
  }
  __syncthreads();
}
#define DI __device__ __forceinline__
#define MFMA16(a, b, c) __builtin_amdgcn_mfma_f32_16x16x32_bf16((a), (b), (c), 0, 0, 0)
#define MFMA32(a, b, c) __builtin_amdgcn_mfma_f32_32x32x16_bf16((a), (b), (c), 0, 0, 0)

using bf16v2 = __attribute__((ext_vector_type(2))) __bf16;
DI void wait_sig(unsigned* sig, unsigned target) {
  if (threadIdx.x == 0) {
    while (__hip_atomic_load(sig, __ATOMIC_RELAXED, __HIP_MEMORY_SCOPE_AGENT) < target) __builtin_amdgcn_s_sleep(2);
    __builtin_amdgcn_fence(__ATOMIC_ACQUIRE, "agent");
    asm volatile("s_waitcnt vmcnt(0)" ::: "memory");
  }
  __syncthreads();
}
DI unsigned cvtpk(float lo, float hi) { bf16v2 v; v[0] = (__bf16)lo; v[1] = (__bf16)hi; return __builtin_bit_cast(unsigned, v); }
DI u16 f2bf(float x) { return (u16)(cvtpk(x, x) & 0xffffu); }
DI float bf2f(u16 v) { return __uint_as_float(((unsigned)v) << 16); }
DI float wave_sum(float v) { for (int o = 32; o; o >>= 1) v += __shfl_xor(v, o); return v; }
DI float wave_max(float v) { for (int o = 32; o; o >>= 1) v = fmaxf(v, __shfl_xor(v, o)); return v; }
DI float addf(float a, float b) { float r; asm volatile("v_add_f32 %0, %1, %2" : "=v"(r) : "v"(a), "v"(b)); return r; }
DI int crow(int r, int hi) { return (r & 3) + 8 * (r >> 2) + 4 * hi; }

DI float* hres_row(const Params& p, int row) {
  const int b = row / L, l = row - b * L;
  return l < NMETA ? (float*)(p.ws + OFF_META) + (size_t)(b * NMETA + l) * DM
                   : p.out + ((size_t)b * SEQ + (l - NMETA)) * DM;
}

DI void row_bl(int row, int b0, int& b, int& l) { b = b0 + ((row >= (b0 + 1) * L) ? 1 : 0); l = row - b * L; }
#define CBAR() asm volatile("" ::: "memory")
DI int opaque_tid() { int t = threadIdx.x; asm volatile("" : "+v"(t)); return t; }

__device__ const double INVF[8] = {1.0, 0.19392274474868576, 0.03760603093086393, 0.007292664737217109, 0.001414213562373095, 0.0002742481756762073, 5.318295896944988e-05, 1.031338537721246e-05};

DI void phase0(const Params& p) {
  const int tid = threadIdx.x, gtid = blockIdx.x * 512 + tid, gsz = gridDim.x * 512;
  const int lane = tid & 63, gw = gtid >> 6, nw = gsz >> 6;
  u16* xb = (u16*)(p.ws + OFF_XB);
  float* rss = (float*)(p.ws + OFF_RSS);
  for (int row = gw; row < RP; row += nw) {
    if (row < R) {
      const int b = row / L, l = row - b * L;
      const float* src = l < NMETA ? p.meta + (size_t)l * DM : p.x + ((size_t)b * SEQ + (l - NMETA)) * DM;
      float ss = 0.f;
#pragma unroll
      for (int i = 0; i < 4; ++i) {
        const f32x4 v = *(const f32x4*)(src + i * 256 + lane * 4);
        ss += v[0] * v[0] + v[1] * v[1] + v[2] * v[2] + v[3] * v[3];
        u32x2 o = {cvtpk(v[0], v[1]), cvtpk(v[2], v[3])};
        *(u32x2*)(xb + (size_t)row * DM + i * 256 + lane * 4) = o;
      }
      ss = wave_sum(ss);
      if (lane == 0) rss[(size_t)row * 16] = ss;
    } else {
#pragma unroll
      for (int i = 0; i < 4; ++i) { u32x2 o = {0u, 0u}; *(u32x2*)(xb + (size_t)row * DM + i * 256 + lane * 4) = o; }
      if (lane == 0) rss[(size_t)row * 16] = 1024.f;
    }
    if (lane >= 1 && lane < 16) rss[(size_t)row * 16 + lane] = 0.f;
  }
  {
    u16* WinT = (u16*)(p.ws + OFF_WIN);
    for (long it = gtid; it < (long)DEPTH * 128 * INW; it += gsz) {
      const int nd = (int)(it % INW); const long t2 = it / INW; const int kc = (int)(t2 % 128), li = (int)(t2 / 128);
      const int c1 = nd & 255;
      const int n = (nd & ~255) + ((c1 >> 5) & 3) * 64 + (c1 >> 7) * 32 + (c1 & 31);
      const float* w = p.w_in + ((size_t)li * DM + kc * 8) * INW + n;
      const float* g = p.norm_gain + li * DM + kc * 8;
      float v[8];
#pragma unroll
      for (int j = 0; j < 8; ++j) v[j] = w[(size_t)j * INW] * g[j];
      u32x4 o = {cvtpk(v[0], v[1]), cvtpk(v[2], v[3]), cvtpk(v[4], v[5]), cvtpk(v[6], v[7])};
      *(u32x4*)(WinT + ((size_t)li * INW + nd) * DM + kc * 8) = o;
    }
  }
  {
    u16* WoutT = (u16*)(p.ws + OFF_WOUT);
    for (long it = gtid; it < (long)DEPTH * 128 * DM; it += gsz) {
      const int n = (int)(it % DM); const long t2 = it / DM; const int kc = (int)(t2 % 128), li = (int)(t2 / 128);
      const float* w = p.w_out + ((size_t)li * DM + kc * 8) * DM + n;
      float v[8];
#pragma unroll
      for (int j = 0; j < 8; ++j) v[j] = w[(size_t)j * DM];
      u32x4 o = {cvtpk(v[0], v[1]), cvtpk(v[2], v[3]), cvtpk(v[4], v[5]), cvtpk(v[6], v[7])};
      *(u32x4*)(WoutT + ((size_t)li * DM + n) * DM + kc * 8) = o;
    }
  }
  {
    u16* Cm = (u16*)(p.ws + OFF_CM); u16* Sm = (u16*)(p.ws + OFF_SM);
    for (int it = gtid; it < KROWS * (KP / 8); it += gsz) {
      const int k = it / (KP / 8), j0 = (it % (KP / 8)) * 8;
      float c[8], s[8];
#pragma unroll
      for (int jj = 0; jj < 8; ++jj) {
        const int j = j0 + jj;
        const bool valid = (k <= LH) && (j <= LH);
        const int m = valid ? (k * j) % L : 0;
        const float rev = (float)m / (float)L;
        c[jj] = valid ? __builtin_amdgcn_cosf(rev) : 0.f;
        s[jj] = valid ? __builtin_amdgcn_sinf(rev) : 0.f;
      }
      u32x4 oc = {cvtpk(c[0], c[1]), cvtpk(c[2], c[3]), cvtpk(c[4], c[5]), cvtpk(c[6], c[7])};
      u32x4 os = {cvtpk(s[0], s[1]), cvtpk(s[2], s[3]), cvtpk(s[4], s[5]), cvtpk(s[6], s[7])};
      *(u32x4*)(Cm + (size_t)k * KP + j0) = oc;
      *(u32x4*)(Sm + (size_t)k * KP + j0) = os;
    }
  }
  {
    u16* Mcs = (u16*)(p.ws + OFF_MCS);
    const float norm = 1.0f / sqrtf((float)L * 128.f);
    for (int it = gtid; it < DEPTH * 4 * 256 * 128; it += gsz) {
      const int e = it & 127, cc = (it >> 7) & 255, lg = it >> 15;
      const int c = cc & 127; const bool isS = cc >= 128;
      const float* wf = p.w_f + (size_t)lg * 128 * 128 + e;
      float acc = 0.f;
      for (int m = 0; m < 128; ++m) {
        const float rev = (float)((m * c) & 127) * (1.0f / 128.f);
        const float t = isS ? __builtin_amdgcn_sinf(rev) : __builtin_amdgcn_cosf(rev);
        acc += t * wf[m * 128];
      }
      acc *= isS ? -norm : norm;
      Mcs[((size_t)lg * 128 + e) * 256 + cc] = f2bf(acc);
    }
  }
  {
    u16* uta = (u16*)(p.ws + OFF_UTA); u16* utb = (u16*)(p.ws + OFF_UTB);
    for (int it = gtid; it < NB * 512 * 64; it += gsz) {
      const int row = it >> 6, i = it & 63;
      if (i < 55) { uta[(size_t)row * KP + 2057 + i] = 0; utb[(size_t)row * KP + 2057 + i] = 0; }
      else if (i == 55) utb[(size_t)row * KP] = 0;
      else if (i == 56) utb[(size_t)row * KP + LH] = 0;
    }
  }
  {
    u16* qn = (u16*)(p.ws + OFF_QN); u16* kn = (u16*)(p.ws + OFF_KN); u16* vt = (u16*)(p.ws + OFF_VN);
    for (int it = gtid; it < NB * NH * (LP - L) * 16; it += gsz) {
      const int ch = it & 15, rr = (it >> 4) % (LP - L), bh = (it >> 4) / (LP - L);
      const size_t off = ((size_t)bh * LP + L + rr) * 128 + ch * 8;
      u32x4 z = {0u, 0u, 0u, 0u};
      *(u32x4*)(qn + off) = z; *(u32x4*)(kn + off) = z;
    }
    for (int it = gtid; it < NB * NH * 128 * ((LP - L) / 8); it += gsz) {
      const int ch = it % ((LP - L) / 8), row = it / ((LP - L) / 8);
      u32x4 z = {0u, 0u, 0u, 0u};
      *(u32x4*)(vt + (size_t)row * LP + L + ch * 8) = z;
    }
  }
  {
    float* rope = (float*)(p.ws + OFF_ROPE);
    for (int it = gtid; it < L * 8; it += gsz) {
      const int l = it >> 3, i = it & 7;
      double rv = (double)l * INVF[i] * 0.15915494309189535;
      rv -= floor(rv);
      const float r = (float)rv;
      rope[l * 16 + i] = __builtin_amdgcn_cosf(r);
      rope[l * 16 + 8 + i] = __builtin_amdgcn_sinf(r);
    }
  }
  if (blockIdx.x == 0) {
    const int wid = tid >> 6;
    if (wid < DEPTH) {
      const int li = wid;
      float a = p.lq1[li * 64 + lane] * p.lk1[li * 64 + lane];
      float bq = p.lq2[li * 64 + lane] * p.lk2[li * 64 + lane];
      a = wave_sum(a); bq = wave_sum(bq);
      const float gq = wave_max(fabsf(p.qg[li * 64 + lane]));
      const float gk = wave_max(fabsf(p.kg[li * 64 + lane]));
      if (lane == 0) {
        float* cst = (float*)(p.ws + OFF_CST) + li * 8;
        const float lam_init = 0.8f - 0.6f * expf(-0.3f * (float)li);
        cst[0] = expf(a) - expf(bq) + lam_init;
        cst[1] = 1.0f - lam_init;
        cst[2] = (8.0f * gq * gk * 1.01f + 0.05f) * 1.4426950408889634f;
      }
    }
    if (tid < 64) ((int*)(p.ws + OFF_CNT))[tid] = 0;
    for (int i = tid; i < 4 * 2 * 16 * 16; i += 512) ((int*)(p.ws + OFF_Q))[i] = 0;
    float* sm = (float*)(p.ws + OFF_SMALL);
    if (tid < 256) { sm[tid] = p.qg[tid]; sm[256 + tid] = p.kg[tid]; }
    sm[512 + tid] = p.subln[tid];
  }
}

namespace pg8 {
#define PG8_LAS __attribute__((address_space(3)))
constexpr int BM = 256, BK = 64, HALF = 128, HTB = HALF * BK * 2, NXCD = 8, WGM = 8;
DI int lds_byte(int r, int c) { const int st = (r >> 4) * 2 + (c >> 5), rr = r & 15, cc = c & 31, ob = rr * 64 + cc * 2; return st * 1024 + (ob ^ (((ob >> 9) & 1) << 5)); }
DI void stage_rc(int b, int& R, int& C) { const int st = b / 1024, sb = b % 1024, swz = sb ^ (((sb >> 9) & 1) << 5); R = (st >> 1) * 16 + swz / 64; C = (st & 1) * 32 + (swz % 64) / 2; }
DI int perm32(int rho) { const int n = rho >> 4, i = rho & 15; return 8 * (i >> 2) + 4 * n + (i & 3); }
struct Unit { int pm, pn; };
struct Gemm { const u16* A; const u16* Bt; int M, N, K; };
struct StaticOrder {
  int nM, nN, nwg, G, c;
  DI void init(int M, int N, int G_, int c_) { nM = M / BM; nN = N / BM; nwg = nM * nN; G = G_; c = c_; }
  DI bool next(int i, Unit& u) const {
    const long Lx = (long)i * G + c; if (Lx >= nwg) return false;
    int wgid = (int)Lx; { const int q = nwg / NXCD, r = nwg % NXCD, xcd = wgid % NXCD, off = wgid / NXCD; wgid = (xcd < r ? xcd * (q + 1) : r * (q + 1) + (xcd - r) * q) + off; }
    const int nig = WGM * nN, gid = wgid / nig, fm = gid * WGM, gsz = (nM - fm) < WGM ? (nM - fm) : WGM;
    u.pm = fm + ((wgid % nig) % gsz); u.pn = (wgid % nig) / gsz; return true;
  }
  DI void done(int) const {}
};
struct Order {
  int mode; StaticOrder st; int pm, pn; unsigned* sig;
  const unsigned* bready;
  DI void a_ready(const Unit& u) const {
    if (bready == nullptr) return;
    if (threadIdx.x < 64) {
      const int b1 = (u.pm * 256) / L; int b2 = (u.pm * 256 + 255) / L; if (b2 > NB - 1) b2 = NB - 1;
      while ((unsigned)__builtin_amdgcn_readfirstlane(__hip_atomic_load(bready + b1 * 16, __ATOMIC_RELAXED, __HIP_MEMORY_SCOPE_AGENT)) < 200u ||
             (unsigned)__builtin_amdgcn_readfirstlane(__hip_atomic_load(bready + b2 * 16, __ATOMIC_RELAXED, __HIP_MEMORY_SCOPE_AGENT)) < 200u) __builtin_amdgcn_s_sleep(2);
      __builtin_amdgcn_fence(__ATOMIC_ACQUIRE, "agent");
      asm volatile("s_waitcnt vmcnt(0)" ::: "memory");
    }
    asm volatile("" ::: "memory"); __builtin_amdgcn_s_barrier(); asm volatile("" ::: "memory");
  }
  DI bool next(int i, Unit& u) const { if (mode == 0) return st.next(i, u); if (i != 0) return false; u.pm = pm; u.pn = pn; return true; }
  DI void done(int lane) const {
    if (mode == 1) {
      asm volatile("s_waitcnt vmcnt(0)" ::: "memory");
      __builtin_amdgcn_fence(__ATOMIC_RELEASE, "agent");
      asm volatile("s_waitcnt vmcnt(0)" ::: "memory");
      if (lane == 0) __hip_atomic_fetch_add(sig, 1u, __ATOMIC_RELAXED, __HIP_MEMORY_SCOPE_AGENT);
    }
  }
};
template <class Epi, class Sched>
DI void gemm_phase(PG8_LAS unsigned char* lds, const Gemm g, const Sched& S, const Epi& E) {
  const int tid = opaque_tid(), wid = __builtin_amdgcn_readfirstlane(tid >> 6), lane = tid & 63, wr = wid >> 2, wc = wid & 3, fr = lane & 15, fq = lane >> 4;
  const int K = g.K, nt = K / BK;
  unsigned voffA[2], voffB[2];
#pragma unroll
  for (int i = 0; i < 2; ++i) { int R_, C_; stage_rc(tid * 16 + i * 8192, R_, C_); const int Rb = (R_ & ~31) + perm32(R_ & 31);
    voffA[i] = (unsigned)(R_ * K + C_) * 2u; voffB[i] = (unsigned)(Rb * K + C_) * 2u; }
  const size_t kstep = (size_t)(BK * 2);
  const size_t hstep = (size_t)HALF * K * 2;
  const size_t tstep = 2 * hstep;
  const unsigned ldsw = (unsigned)wid * 1024u;
  const int aoff = lds_byte(wr * 64 + fr, fq * 8), boff = lds_byte(wc * 32 + fr, fq * 8);
#define PG8_SA(b, h) (((b) * 2 + (h)) * HTB)
#define PG8_SB(b, h) ((4 + (b) * 2 + (h)) * HTB)
#define PG8_STAGE(bufoff, gbase, voff) do { _Pragma("unroll") for (int _i = 0; _i < 2; ++_i) \
    __builtin_amdgcn_global_load_lds((const unsigned*)((const char*)(gbase) + (voff)[_i]), (PG8_LAS unsigned*)(lds + (bufoff) + ldsw + _i * 8192), 16, 0, 0); } while (0)
#define PG8_LDA(dst, b, h) do { _Pragma("unroll") for (int m = 0; m < 4; ++m) _Pragma("unroll") for (int k = 0; k < 2; ++k) dst[m][k] = *(const PG8_LAS bf16x8*)(lds + PG8_SA(b, h) + aoff + m * 2048 + k * 1024); } while (0)
#define PG8_LDB(dst, b, h) do { _Pragma("unroll") for (int n = 0; n < 2; ++n) _Pragma("unroll") for (int k = 0; k < 2; ++k) dst[n][k] = *(const PG8_LAS bf16x8*)(lds + PG8_SB(b, h) + boff + n * 2048 + k * 1024); } while (0)
#define PG8_MMA(ai, bj, At, Bt) do { __builtin_amdgcn_s_setprio(1); _Pragma("unroll") for (int m = 0; m < 4; ++m) _Pragma("unroll") for (int n = 0; n < 2; ++n) _Pragma("unroll") for (int k = 0; k < 2; ++k) \
    acc[ai][bj][m][n] = __builtin_amdgcn_mfma_f32_16x16x32_bf16(Bt[n][k], At[m][k], acc[ai][bj][m][n], 0, 0, 0); __builtin_amdgcn_s_setprio(0); } while (0)
#define PG8_WAIT_V(n) asm volatile("s_waitcnt vmcnt(" #n ")" ::: "memory")
#define PG8_WAIT_L(n) asm volatile("s_waitcnt lgkmcnt(" #n ")" ::: "memory")
#define PG8_BAR __builtin_amdgcn_s_barrier()
#define PG8_SCHED __builtin_amdgcn_sched_barrier(0)
  Unit cur, nxt; int ui = 0;
  if (!S.next(0, cur)) return;
  f32x4 acc[2][2][4][2];
#pragma unroll
  for (int a = 0; a < 2; ++a)
#pragma unroll
    for (int b = 0; b < 2; ++b)
#pragma unroll
      for (int m = 0; m < 4; ++m)
#pragma unroll
        for (int n = 0; n < 2; ++n) acc[a][b][m][n] = (f32x4){0.f, 0.f, 0.f, 0.f};
  bf16x8 At[4][2], B0[2][2], B1[2][2];
  const char* cA = (const char*)g.A + (size_t)cur.pm * tstep; const char* cB = (const char*)g.Bt + (size_t)cur.pn * tstep;
  S.a_ready(cur);
  PG8_STAGE(PG8_SB(0, 0), cB, voffB); PG8_STAGE(PG8_SA(0, 0), cA, voffA); PG8_STAGE(PG8_SB(0, 1), cB + hstep, voffB); PG8_STAGE(PG8_SA(0, 1), cA + hstep, voffA);
  if (wr == 1) PG8_BAR;
  PG8_WAIT_V(4); PG8_BAR;
  PG8_STAGE(PG8_SB(1, 0), cB + kstep, voffB); PG8_STAGE(PG8_SA(1, 0), cA + kstep, voffA); PG8_STAGE(PG8_SB(1, 1), cB + hstep + kstep, voffB);
  PG8_WAIT_V(6); PG8_BAR;
  for (;;) {
    const bool has_next = S.next(ui + 1, nxt);
    const char* nA = has_next ? (const char*)g.A + (size_t)nxt.pm * tstep : cA; const char* nB = has_next ? (const char*)g.Bt + (size_t)nxt.pn * tstep : cB;
    for (int t = 0; t < nt; t += 2) {
      const bool last = (t == nt - 2);
      const char* a1 = cA + (size_t)(t + 1) * kstep;
      const char* a2 = last ? nA : cA + (size_t)(t + 2) * kstep; const char* b2 = last ? nB : cB + (size_t)(t + 2) * kstep;
      const char* a3 = a2 + kstep; const char* b3 = b2 + kstep;
      if (last && has_next) S.a_ready(nxt);
      PG8_LDB(B0, 0, 0); PG8_SCHED; PG8_LDA(At, 0, 0); PG8_STAGE(PG8_SA(1, 1), a1 + hstep, voffA);
      PG8_WAIT_L(8); PG8_BAR; PG8_WAIT_L(0); PG8_MMA(0, 0, At, B0); PG8_BAR; PG8_SCHED;
      PG8_LDB(B1, 0, 1); PG8_STAGE(PG8_SB(0, 0), b2, voffB);
      PG8_BAR; PG8_WAIT_L(0); PG8_MMA(0, 1, At, B1); PG8_BAR;
      PG8_LDA(At, 0, 1); PG8_STAGE(PG8_SA(0, 0), a2, voffA);
      PG8_BAR; PG8_WAIT_L(0); PG8_MMA(1, 0, At, B0); PG8_BAR; PG8_SCHED;
      PG8_STAGE(PG8_SB(0, 1), b2 + hstep, voffB);
      PG8_WAIT_V(6); PG8_BAR; PG8_MMA(1, 1, At, B1); PG8_BAR;
      PG8_LDB(B0, 1, 0); PG8_SCHED; PG8_LDA(At, 1, 0); PG8_STAGE(PG8_SA(0, 1), a2 + hstep, voffA);
      PG8_WAIT_L(8); PG8_BAR; PG8_WAIT_L(0); PG8_MMA(0, 0, At, B0); PG8_BAR; PG8_SCHED;
      PG8_LDB(B1, 1, 1); PG8_STAGE(PG8_SB(1, 0), b3, voffB);
      PG8_BAR; PG8_WAIT_L(0); PG8_MMA(0, 1, At, B1); PG8_BAR;
      PG8_LDA(At, 1, 1); PG8_STAGE(PG8_SA(1, 0), a3, voffA);
      PG8_BAR; PG8_WAIT_L(0); PG8_MMA(1, 0, At, B0); PG8_BAR; PG8_SCHED;
      PG8_STAGE(PG8_SB(1, 1), b3 + hstep, voffB);
      PG8_WAIT_V(6); PG8_BAR; PG8_MMA(1, 1, At, B1); PG8_BAR;
    }
    E(acc, cur, wr, wc, fr, fq);
    S.done(lane);
    if (!has_next) break;
#pragma unroll
    for (int a = 0; a < 2; ++a)
#pragma unroll
      for (int b = 0; b < 2; ++b)
#pragma unroll
        for (int m = 0; m < 4; ++m)
#pragma unroll
          for (int n = 0; n < 2; ++n) acc[a][b][m][n] = (f32x4){0.f, 0.f, 0.f, 0.f};
    cur = nxt; cA = nA; cB = nB; ++ui;
  }
  PG8_WAIT_V(0);
  if (wr == 0) PG8_BAR;
  PG8_BAR;
#undef PG8_SA
#undef PG8_SB
#undef PG8_STAGE
#undef PG8_LDA
#undef PG8_LDB
#undef PG8_MMA
#undef PG8_WAIT_V
#undef PG8_WAIT_L
#undef PG8_BAR
#undef PG8_SCHED
}
}

DI float row_scale(const float* rsp, int row) {
  const f32x4* rp = (const f32x4*)(rsp + (size_t)row * 16);
  const f32x4 a0 = rp[0], a1 = rp[1], a2 = rp[2], a3 = rp[3];
  const float s = ((a0[0] + a0[1]) + (a0[2] + a0[3])) + ((a1[0] + a1[1]) + (a1[2] + a1[3])) + ((a2[0] + a2[1]) + (a2[2] + a2[3])) + ((a3[0] + a3[1]) + (a3[2] + a3[3]));
  return rsqrtf(s * (1.0f / DM) + EPS);
}

struct EpiA {
  char* ws; int li;
  DI void operator()(const f32x4 (&acc)[2][2][4][2], const pg8::Unit& u, int wr, int wc, int fr, int fq) const {
    const int mt = u.pm, nt = u.pn;
    const float* rsp = (const float*)(ws + OFF_RSS);
    const int b0 = (mt * 256) / L;
    const int rbase = mt * 256 + wr * 64 + fr;
    float scv[2][4];
    {
      const int lane_ = fq * 16 + fr, r0_ = mt * 256 + wr * 64 + lane_;
      const float so0 = row_scale(rsp, r0_ < R ? r0_ : 0), so1 = row_scale(rsp, r0_ + 128 < R ? r0_ + 128 : 0);
#pragma unroll
      for (int m = 0; m < 4; ++m) { scv[0][m] = __shfl(so0, m * 16 + fr); scv[1][m] = __shfl(so1, m * 16 + fr); }
    }
    if (nt < 2) {
      u16* uta = (u16*)(ws + OFF_UTA); u16* utb = (u16*)(ws + OFF_UTB);
      const int chb = nt * 256 + wc * 64 + 8 * fq;
#pragma unroll
      for (int ai = 0; ai < 2; ++ai)
#pragma unroll
        for (int m = 0; m < 4; ++m) {
          const int row = rbase + ai * 128 + m * 16;
          if (row < R) {
            int b, l; row_bl(row, b0, b, l);
            const float sc = scv[ai][m];
            u16* dst = (l <= LH) ? uta + (size_t)b * 512 * KP + l : utb + (size_t)b * 512 * KP + (L - l);
#pragma unroll
            for (int bj = 0; bj < 2; ++bj)
#pragma unroll
              for (int n = 0; n < 2; ++n)
#pragma unroll
                for (int j = 0; j < 4; ++j) dst[(size_t)(chb + bj * 32 + n * 4 + j) * KP] = f2bf(acc[ai][bj][m][n][j] * sc);
          }
          CBAR();
        }
    } else if (nt < 6) {
      const bool isq = nt < 4;
      const int gi = (isq ? nt - 2 : nt - 4) * 4 + wc;
      const int h = gi >> 1, comp = gi & 1;
      const float* gain = (const float*)(ws + OFF_SMALL) + (isq ? 0 : 256) + li * 64 + 8 * fq;
      const f32x4 g00 = *(const f32x4*)(gain), g01 = *(const f32x4*)(gain + 4), g10 = *(const f32x4*)(gain + 32), g11 = *(const f32x4*)(gain + 36);
      const float qsc = isq ? 0.125f * 1.4426950408889634f : 1.0f;
      const float* rope = (const float*)(ws + OFF_ROPE);
      u16* dbase = (u16*)(ws + (isq ? OFF_QN : OFF_KN));
#pragma unroll
      for (int ai = 0; ai < 2; ++ai)
#pragma unroll
        for (int m = 0; m < 4; ++m) {
          const int row = rbase + ai * 128 + m * 16;
          const bool valid = row < R;
          const int rowc = valid ? row : 0;
          int b, l; row_bl(rowc, valid ? b0 : 0, b, l);
          const float sc = scv[ai][m];
          f32x4 v00 = acc[ai][0][m][0] * sc, v01 = acc[ai][0][m][1] * sc, v10 = acc[ai][1][m][0] * sc, v11 = acc[ai][1][m][1] * sc;
          float ss = 0.f;
#pragma unroll
          for (int j = 0; j < 4; ++j) ss += v00[j] * v00[j] + v01[j] * v01[j] + v10[j] * v10[j] + v11[j] * v11[j];
          ss += __shfl_xor(ss, 16); ss += __shfl_xor(ss, 32);
          const float rq = rsqrtf(ss * (1.0f / 64.f) + EPS) * qsc;
          v00 = v00 * g00 * rq; v01 = v01 * g01 * rq; v10 = v10 * g10 * rq; v11 = v11 * g11 * rq;
          const f32x4 c0 = *(const f32x4*)(rope + l * 16), c1 = *(const f32x4*)(rope + l * 16 + 4), s0 = *(const f32x4*)(rope + l * 16 + 8), s1 = *(const f32x4*)(rope + l * 16 + 12);
          f32x4 p0, p1;
#pragma unroll
          for (int j = 0; j < 4; ++j) { p0[j] = __shfl_xor(v00[j], 16); p1[j] = __shfl_xor(v01[j], 16); }
          if (fq == 0) { v00 = v00 * c0 - p0 * s0; v01 = v01 * c1 - p1 * s1; }
          else if (fq == 1) { v00 = v00 * c0 + p0 * s0; v01 = v01 * c1 + p1 * s1; }
          if (valid) {
            u16* dst = dbase + (((size_t)(b * NH + h)) * LP + l) * 128 + comp * 64 + 8 * fq;
            u32x4 w0 = {cvtpk(v00[0], v00[1]), cvtpk(v00[2], v00[3]), cvtpk(v01[0], v01[1]), cvtpk(v01[2], v01[3])};
            u32x4 w1 = {cvtpk(v10[0], v10[1]), cvtpk(v10[2], v10[3]), cvtpk(v11[0], v11[1]), cvtpk(v11[2], v11[3])};
            *(u32x4*)(dst) = w0; *(u32x4*)(dst + 32) = w1;
          }
          CBAR();
        }
    } else if (nt < 8) {
      const int cv = (nt - 6) * 256 + wc * 64;
      const int h = cv >> 7, dv = (cv & 127) + 8 * fq;
      u16* vt = (u16*)(ws + OFF_VN);
#pragma unroll
      for (int ai = 0; ai < 2; ++ai)
#pragma unroll
        for (int m = 0; m < 4; ++m) {
          const int row = rbase + ai * 128 + m * 16;
          if (row < R) {
            int b, l; row_bl(row, b0, b, l);
            const float sc = scv[ai][m];
            const int o = l & 15;
            const int pos = (l & ~15) + 8 * ((o >> 2) & 1) + 4 * (o >> 3) + (o & 3);
            u16* dst = vt + ((size_t)(b * NH + h) * 128 + dv) * LP + pos;
#pragma unroll
            for (int bj = 0; bj < 2; ++bj)
#pragma unroll
              for (int n = 0; n < 2; ++n)
#pragma unroll
                for (int j = 0; j < 4; ++j) dst[(size_t)(bj * 32 + n * 4 + j) * LP] = f2bf(acc[ai][bj][m][n][j] * sc);
          }
          CBAR();
        }
    } else {
      u16* gg = (u16*)(ws + OFF_GG);
      const int cgc = (nt - 8) * 256 + wc * 64 + 8 * fq;
#pragma unroll
      for (int ai = 0; ai < 2; ++ai)
#pragma unroll
        for (int m = 0; m < 4; ++m) {
          const int row = rbase + ai * 128 + m * 16;
          if (row < R) {
            const float sc = scv[ai][m];
            u16* dst = gg + (size_t)row * DM + cgc;
#pragma unroll
            for (int bj = 0; bj < 2; ++bj) {
              f32x4 a = acc[ai][bj][m][0] * sc, c = acc[ai][bj][m][1] * sc;
#pragma unroll
              for (int j = 0; j < 4; ++j) { a[j] = a[j] * __builtin_amdgcn_rcpf(1.0f + __expf(-a[j])); c[j] = c[j] * __builtin_amdgcn_rcpf(1.0f + __expf(-c[j])); }
              u32x4 w = {cvtpk(a[0], a[1]), cvtpk(a[2], a[3]), cvtpk(c[0], c[1]), cvtpk(c[2], c[3])};
              *(u32x4*)(dst + bj * 32) = w;
            }
          }
          CBAR();
        }
    }
  }
};
DI void phaseA(const P2& p, int li, char* smem, int mode, int pn, unsigned* sig) {
  pg8::Gemm g; g.A = (const u16*)(p.ws + OFF_XB); g.Bt = (const u16*)(p.ws + OFF_WIN) + (size_t)li * INW * DM; g.M = RP; g.N = INW; g.K = DM;
  pg8::Order S; S.mode = mode; S.st.init(RP - 256, INW, gridDim.x, blockIdx.x); S.pm = RP / 256 - 1; S.pn = pn; S.sig = sig; S.bready = nullptr;
  EpiA E; E.ws = p.ws; E.li = li;
  pg8::gemm_phase((PG8_LAS unsigned char*)smem, g, S, E);
}

struct EpiC {
  char* ws; float* out; const float* x; const float* meta; int li;
  DI void operator()(const f32x4 (&acc)[2][2][4][2], const pg8::Unit& u, int wr, int wc, int fr, int fq) const {
    const int mt = u.pm, nt = u.pn;
    const bool last = (li == DEPTH - 1), first = (li == 0);
    u16* xb = (u16*)(ws + OFF_XB);
    float* rsp = (float*)(ws + OFF_RSS);
    const int b0 = (mt * 256) / L;
    const int rbase = mt * 256 + wr * 64 + fr;
    const int cb = nt * 256 + wc * 32 + 8 * fq;
#pragma unroll
    for (int ai = 0; ai < 2; ++ai)
#pragma unroll
      for (int m = 0; m < 4; ++m) {
        const int row = rbase + ai * 128 + m * 16;
        const bool valid = row < R;
        float ss = 0.f;
        if (valid) {
          int b, l; row_bl(row, b0, b, l);
          u16* xr = xb + (size_t)row * DM + cb;
          const float* xin = (l < NMETA ? meta + (size_t)l * DM : x + ((size_t)b * SEQ + (l - NMETA)) * DM) + cb;
          float* orow = out + ((size_t)b * SEQ + (l - NMETA)) * DM + cb;
#pragma unroll
          for (int bj = 0; bj < 2; ++bj) {
            f32x4 a, c;
            if (first) { a = *(const f32x4*)(xin + bj * 128); c = *(const f32x4*)(xin + bj * 128 + 4); }
            else { const u32x4 w = *(const u32x4*)(xr + bj * 128);
              a = f32x4{__uint_as_float(w[0] << 16), __uint_as_float(w[0] & 0xffff0000u), __uint_as_float(w[1] << 16), __uint_as_float(w[1] & 0xffff0000u)};
              c = f32x4{__uint_as_float(w[2] << 16), __uint_as_float(w[2] & 0xffff0000u), __uint_as_float(w[3] << 16), __uint_as_float(w[3] & 0xffff0000u)}; }
            a += acc[ai][bj][m][0]; c += acc[ai][bj][m][1];
            if (last) { if (l >= NMETA) { *(f32x4*)(orow + bj * 128) = a; *(f32x4*)(orow + bj * 128 + 4) = c; } }
            else { u32x4 w = {cvtpk(a[0], a[1]), cvtpk(a[2], a[3]), cvtpk(c[0], c[1]), cvtpk(c[2], c[3])}; *(u32x4*)(xr + bj * 128) = w; }
#pragma unroll
            for (int j = 0; j < 4; ++j) ss += a[j] * a[j] + c[j] * c[j];
          }
        }
        ss += __shfl_xor(ss, 16); ss += __shfl_xor(ss, 32);
        if (valid && !last && fq == 0) rsp[(size_t)row * 16 + nt * 4 + wc] = ss;
        if (m == 1 || m == 3) CBAR();
      }
  }
};
DI void phaseC(const P2& p, int li, char* smem, int mode, int pn, unsigned* sig) {
  pg8::Gemm g; g.A = (const u16*)(p.ws + OFF_GY); g.Bt = (const u16*)(p.ws + OFF_WOUT) + (size_t)li * DM * DM; g.M = RP; g.N = DM; g.K = DM;
  pg8::Order S; S.mode = mode; S.st.init(li == DEPTH - 1 ? RP : RP - 256, DM, gridDim.x, blockIdx.x); S.pm = RP / 256 - 1; S.pn = pn; S.sig = sig;
  S.bready = nullptr;
  EpiC E; E.ws = p.ws; E.out = p.out; E.x = p.x; E.meta = p.meta; E.li = li;
  pg8::gemm_phase((PG8_LAS unsigned char*)smem, g, S, E);
}

#define KSWZ(row, colB) ((row) * 256 + ((colB) ^ (((row) & 15) << 4)))
DI int v_st(int k, int c) { const int kk = (k & ~0xC) | ((k & 4) << 1) | ((k & 8) >> 1); return ((kk >> 3) * 4 + (c >> 5)) * 512 + ((kk & 7) * 32 + (c & 31)) * 2; }
DI int v_rd_base(int lane) { return ((lane & 3) << 3) | (((lane >> 2) & 3) << 6) | (((lane >> 4) & 1) << 5) | (((lane >> 5) & 1) << 8); }
constexpr int v_rd_off(int d0, int ks, int half) { return d0 * 512 + ks * 4096 + half * 2048; }
template <int OFF> DI s16x4 tr_read(int vb) {
  s16x4 r; asm volatile("ds_read_b64_tr_b16 %0, %1 offset:%2" : "=&v"(r) : "v"(vb), "i"(OFF) : "memory"); return r;
}
template <int D0> DI void pv_one(f32x16& od, int vb, bf16x8 pa0, bf16x8 pa1, bf16x8 pa2, bf16x8 pa3) {
  const s16x4 l0 = tr_read<v_rd_off(D0, 0, 0)>(vb), h0 = tr_read<v_rd_off(D0, 0, 1)>(vb), l1 = tr_read<v_rd_off(D0, 1, 0)>(vb), h1 = tr_read<v_rd_off(D0, 1, 1)>(vb);
  const s16x4 l2 = tr_read<v_rd_off(D0, 2, 0)>(vb), h2 = tr_read<v_rd_off(D0, 2, 1)>(vb), l3 = tr_read<v_rd_off(D0, 3, 0)>(vb), h3 = tr_read<v_rd_off(D0, 3, 1)>(vb);
  asm volatile("s_waitcnt lgkmcnt(0)" ::: "memory"); __builtin_amdgcn_sched_barrier(0);
#define PKV(Lo, Hi) (bf16x8){Lo[0], Lo[1], Lo[2], Lo[3], Hi[0], Hi[1], Hi[2], Hi[3]}
  od = MFMA32(pa0, PKV(l0, h0), od);
  od = MFMA32(pa1, PKV(l1, h1), od);
  od = MFMA32(pa2, PKV(l2, h2), od);
  od = MFMA32(pa3, PKV(l3, h3), od);
#undef PKV
}

DI void attn_tile(const P2& p, int li, int item, char* smem) {
  const int tid = opaque_tid(), wid = tid >> 6, lane = tid & 63, r32 = lane & 31, hi = lane >> 5;
  const int cm = wid >> 2, rg = wid & 3;
  const int bh = item / 33, qb = item - bh * 33;
  const int b = bh >> 2, h = bh & 3;
  const u16* Qh = (const u16*)(p.ws + OFF_QN) + (size_t)bh * LP * 128;
  const u16* Kh = (const u16*)(p.ws + OFF_KN) + (size_t)bh * LP * 128;
  const u16* Vh = (const u16*)(p.ws + OFF_VN) + (size_t)bh * 128 * LP;
  const float* cst = (const float*)(p.ws + OFF_CST) + li * 8;
  const float lam = cst[0], oml = cst[1];
  const int lq = qb * 128 + rg * 32 + r32;
  bf16x8 qr[4];
#pragma unroll
  for (int d0 = 0; d0 < 4; ++d0) qr[d0] = *(const bf16x8*)(Qh + (size_t)lq * 128 + cm * 64 + d0 * 16 + hi * 8);
  const int sr = tid >> 4, sc = (tid & 15) * 8;
  const int kst0 = KSWZ(sr, sc * 2), kst1 = KSWZ(32 + sr, sc * 2);
  const int vrow = tid >> 3, vch = tid & 7;
  const int vst0 = 16384 + vrow * 128 + ((vch ^ ((vrow >> 1) & 7)) << 4), vst1 = vst0 + 64 * 128;
  int voff[4];
#pragma unroll
  for (int ks = 0; ks < 4; ++ks) voff[ks] = 16384 + r32 * 128 + (((2 * ks + hi) ^ ((r32 >> 1) & 7)) << 4);
  int koff[4];
#pragma unroll
  for (int d0 = 0; d0 < 4; ++d0) koff[d0] = r32 * 256 + ((cm * 128 + d0 * 32 + hi * 16) ^ ((r32 & 15) << 4));
  f32x16 o[4];
#pragma unroll
  for (int d = 0; d < 4; ++d)
#pragma unroll
    for (int r = 0; r < 16; ++r) o[d][r] = 0.f;
  float lsum = 0.f;
  u32x4 gk0, gk1, gv0, gv1;
  f32x16 pA0, pA1, pB0, pB1;
  bf16x8 pa0, pa1, pa2, pa3;
#define SBAR() __builtin_amdgcn_sched_barrier(0)
  const u16* kp_ = Kh + (size_t)sr * 128 + sc; const u16* vp_ = Vh + (size_t)vrow * LP + vch * 8;
#define LOADT(jt) do { gk0 = *(const u32x4*)(kp_); gk1 = *(const u32x4*)(kp_ + 32 * 128); \
    gv0 = *(const u32x4*)(vp_); gv1 = *(const u32x4*)(vp_ + (size_t)64 * LP); kp_ += 64 * 128; vp_ += 64; } while (0)
#define WRITET(ro) do { *(u32x4*)(smem + (ro) + kst0) = gk0; *(u32x4*)(smem + (ro) + kst1) = gk1; \
    *(u32x4*)(smem + (ro) + vst0) = gv0; *(u32x4*)(smem + (ro) + vst1) = gv1; } while (0)
#define QKMM(P0, P1, kb_) do { _Pragma("unroll") for (int d0 = 0; d0 < 4; ++d0) { \
      const bf16x8 b0_ = *(const bf16x8*)((kb_) + koff[d0]); const bf16x8 b1_ = *(const bf16x8*)((kb_) + koff[d0] + 8192); \
      P0 = MFMA32(b0_, qr[d0], P0); P1 = MFMA32(b1_, qr[d0], P1); } } while (0)
  \
  \
#define QKT(P0, P1, ro, MASKED) do { const char* kb_ = smem + (ro); \
    _Pragma("unroll") for (int r = 0; r < 16; ++r) { P0[r] = 0.f; P1[r] = 0.f; } \
    QKMM(P0, P1, kb_); \
    if (MASKED) { _Pragma("unroll") for (int r = 8; r < 16; ++r) P0[r] = -1e30f; _Pragma("unroll") for (int r = 0; r < 16; ++r) P1[r] = -1e30f; } } while (0)
#define EXPS(P0, P1) do { _Pragma("unroll") for (int r = 0; r < 16; ++r) { P0[r] = __builtin_amdgcn_exp2f(P0[r]); P1[r] = __builtin_amdgcn_exp2f(P1[r]); } } while (0)
#define EXPH(P, B0_) do { _Pragma("unroll") for (int r = 0; r < 8; ++r) P[(B0_) + r] = __builtin_amdgcn_exp2f(P[(B0_) + r]); } while (0)
#define PK4(P, BASE, OUT) do { u32x4 w = {cvtpk(P[BASE + 0], P[BASE + 1]), cvtpk(P[BASE + 2], P[BASE + 3]), cvtpk(P[BASE + 4], P[BASE + 5]), cvtpk(P[BASE + 6], P[BASE + 7])}; \
    OUT = *reinterpret_cast<bf16x8*>(&w); } while (0)
#define PACK(P0, P1) do { float s0_ = P0[0], s1_ = P0[1], s2_ = P0[2], s3_ = P0[3]; \
    _Pragma("unroll") for (int r = 4; r < 16; r += 4) { s0_ = addf(s0_, P0[r]); s1_ = addf(s1_, P0[r + 1]); s2_ = addf(s2_, P0[r + 2]); s3_ = addf(s3_, P0[r + 3]); } \
    _Pragma("unroll") for (int r = 0; r < 16; r += 4) { s0_ = addf(s0_, P1[r]); s1_ = addf(s1_, P1[r + 1]); s2_ = addf(s2_, P1[r + 2]); s3_ = addf(s3_, P1[r + 3]); } \
    lsum += (s0_ + s1_) + (s2_ + s3_); \
    PK4(P0, 0, pa0); PK4(P0, 8, pa1); PK4(P1, 0, pa2); PK4(P1, 8, pa3); } while (0)
#define PVD(D0, vb) do { const bf16x8 v0_ = *(const bf16x8*)((vb) + voff[0] + (D0) * 4096), v1_ = *(const bf16x8*)((vb) + voff[1] + (D0) * 4096); \
    const bf16x8 v2_ = *(const bf16x8*)((vb) + voff[2] + (D0) * 4096), v3_ = *(const bf16x8*)((vb) + voff[3] + (D0) * 4096); \
    o[D0] = MFMA32(pa0, v0_, o[D0]); o[D0] = MFMA32(pa1, v1_, o[D0]); o[D0] = MFMA32(pa2, v2_, o[D0]); o[D0] = MFMA32(pa3, v3_, o[D0]); } while (0)
#define STEP(C0, C1, N0, N1, jj, NX, MASKED) do { const int j_ = (jj); \
    if (j_ + 2 < NKT) WRITET(r2); \
    if (j_ + 3 < NKT) LOADT(j_ + 3); \
    SBAR(); \
    if (act) { if (NX) QKT(N0, N1, r1, MASKED); \
    PACK(C0, C1); } \
    SBAR(); \
    if (act) { const char* vb_ = smem + r0; \
      PVD(0, vb_); if (NX) EXPH(N0, 0); \
      PVD(1, vb_); if (NX) EXPH(N0, 8); \
      PVD(2, vb_); if (NX) EXPH(N1, 0); \
      PVD(3, vb_); if (NX) EXPH(N1, 8); } \
    SBAR(); \
    __syncthreads(); \
    { const int t_ = r0; r0 = r1; r1 = r2; r2 = t_; } } while (0)
  int r0 = 0, r1 = 32768, r2 = 65536;
  LOADT(0); WRITET(0); LOADT(1); WRITET(32768); LOADT(2);
  __syncthreads();
  const bool act = (qb < 32) || (rg == 0);
  QKT(pA0, pA1, 0, 0); EXPS(pA0, pA1);
  for (int j = 0; j < NKT - 3; j += 2) {
    STEP(pA0, pA1, pB0, pB1, j, 1, 0);
    STEP(pB0, pB1, pA0, pA1, j + 1, 1, 0);
  }
  STEP(pA0, pA1, pB0, pB1, NKT - 3, 1, 0);
  STEP(pB0, pB1, pA0, pA1, NKT - 2, 1, 1);
  STEP(pA0, pA1, pB0, pB1, NKT - 1, 0, 0);
#undef STEP
#undef PVD
#undef PACK
#undef PK4
#undef EXPS
#undef EXPH
#undef QKT
#undef QKMM
#undef LOADT
#undef WRITET
  lsum += __shfl_xor(lsum, 32);
  float inv = 1.0f / lsum; if (cm == 1) inv *= lam;
  float* li_l = (float*)(smem + 98304) + wid * 32;
  if (hi == 0) li_l[r32] = inv;
  __syncthreads();
  float rl[16];
#pragma unroll
  for (int r = 0; r < 16; ++r) rl[r] = li_l[crow(r, hi)];
#pragma unroll
  for (int d = 0; d < 4; ++d)
#pragma unroll
    for (int r = 0; r < 16; ++r) o[d][r] *= rl[r];
  float* xbuf = (float*)smem + rg * 4096;
  if (cm == 1) {
#pragma unroll
    for (int d = 0; d < 4; ++d)
#pragma unroll
      for (int r = 0; r < 16; ++r) xbuf[crow(r, hi) * 128 + d * 32 + r32] = o[d][r];
  }
  __syncthreads();
  if (cm == 0) {
    u16* gy = (u16*)(p.ws + OFF_GY); const u16* gg = (const u16*)(p.ws + OFF_GG);
    const float* sg = (const float*)(p.ws + OFF_SMALL) + 512 + li * 128;
    const float s0 = sg[r32], s1 = sg[32 + r32], s2 = sg[64 + r32], s3 = sg[96 + r32];
#pragma unroll
    for (int r = 0; r < 16; ++r) {
      const int rr = crow(r, hi);
      const float v0 = o[0][r] - xbuf[rr * 128 + r32], v1 = o[1][r] - xbuf[rr * 128 + 32 + r32];
      const float v2 = o[2][r] - xbuf[rr * 128 + 64 + r32], v3 = o[3][r] - xbuf[rr * 128 + 96 + r32];
      float ss = v0 * v0 + v1 * v1 + v2 * v2 + v3 * v3;
      ss += __shfl_xor(ss, 1); ss += __shfl_xor(ss, 2); ss += __shfl_xor(ss, 4); ss += __shfl_xor(ss, 8); ss += __shfl_xor(ss, 16);
      const float rinv = rsqrtf(ss * (1.0f / 128.f) + EPS) * oml;
      const int l = qb * 128 + rg * 32 + rr;
      if (l < L) {
        const size_t go = ((size_t)(b * L + l)) * DM + 512 + h * 128 + r32;
        u16* g = gy + go; const u16* gi = gg + go;
        g[0]  = f2bf(v0 * rinv * s0 * bf2f(gi[0]));
        g[32] = f2bf(v1 * rinv * s1 * bf2f(gi[32]));
        g[64] = f2bf(v2 * rinv * s2 * bf2f(gi[64]));
        g[96] = f2bf(v3 * rinv * s3 * bf2f(gi[96]));
      }
    }
  }
  __syncthreads();
}

DI void fourier_tile(const P2& p, int li, int item, char* smem) {
  const int tid = opaque_tid(), wid = tid >> 6, lane = tid & 63, fr = lane & 15, fq = lane >> 4;
  const int qd = wid >> 2, wq = wid & 3;
  const int b = item / 68, rem = item - b * 68, g = rem / 17, kt = rem - g * 17;
  const u16* Cm = (const u16*)(p.ws + OFF_CM); const u16* Sm = (const u16*)(p.ws + OFF_SM);
  const u16* uta = (const u16*)(p.ws + OFF_UTA); const u16* utb = (const u16*)(p.ws + OFF_UTB);
  char* As = smem; char* Bs = smem + 65536;
  const int srow = tid >> 3, scc = tid & 7;
  const int soff = srow * 128 + ((scc ^ ((srow >> 1) & 7)) << 4);
  const u16* cgp = Cm + (size_t)(kt * 128 + srow) * KP + scc * 8;
  const u16* sgp = Sm + (size_t)(kt * 128 + srow) * KP + scc * 8;
  const u16* uap = uta + ((size_t)(b * 512 + g * 128 + srow)) * KP + scc * 8;
  const u16* ubp = utb + ((size_t)(b * 512 + g * 128 + srow)) * KP + scc * 8;
  u32x4 raA[4], ruaA[2], rubA[2], raB[4], ruaB[2], rubB[2];
#define FLOAD(ra, rua, rub, k2) do { ra[0] = *(const u32x4*)(cgp + (k2) * 64); ra[1] = *(const u32x4*)(cgp + (size_t)64 * KP + (k2) * 64); \
    ra[2] = *(const u32x4*)(sgp + (k2) * 64); ra[3] = *(const u32x4*)(sgp + (size_t)64 * KP + (k2) * 64); \
    rua[0] = *(const u32x4*)(uap + (k2) * 64); rua[1] = *(const u32x4*)(uap + (size_t)64 * KP + (k2) * 64); \
    rub[0] = *(const u32x4*)(ubp + (k2) * 64); rub[1] = *(const u32x4*)(ubp + (size_t)64 * KP + (k2) * 64); } while (0)
#define FWRITE(ra, rua, rub, bf) do { _Pragma("unroll") for (int i = 0; i < 4; ++i) *(u32x4*)(As + (bf) * 32768 + soff + i * 8192) = ra[i]; \
    _Pragma("unroll") for (int i = 0; i < 2; ++i) { u32x4 ev, ov; \
      _Pragma("unroll") for (int d = 0; d < 4; ++d) { const unsigned ua_ = rua[i][d], ub_ = rub[i][d]; \
        const float al = __uint_as_float(ua_ << 16), ah = __uint_as_float(ua_ & 0xffff0000u); \
        const float bl = __uint_as_float(ub_ << 16), bh_ = __uint_as_float(ub_ & 0xffff0000u); \
        ev[d] = cvtpk(al + bl, ah + bh_); ov[d] = cvtpk(al - bl, ah - bh_); } \
      *(u32x4*)(Bs + (bf) * 32768 + soff + i * 8192) = ev; *(u32x4*)(Bs + (bf) * 32768 + 16384 + soff + i * 8192) = ov; } } while (0)
  f32x4 acc[8][2];
#pragma unroll
  for (int m = 0; m < 8; ++m) { acc[m][0] = f32x4{0.f, 0.f, 0.f, 0.f}; acc[m][1] = f32x4{0.f, 0.f, 0.f, 0.f}; }
  const int aoff0 = (qd * 128 + fr) * 128, boff0 = (qd * 128 + wq * 32 + fr) * 128, swz = fr >> 1;
  constexpr int NK2 = KP / 64;
#define FCOMP(buf) do { const char* Ab = As + (buf) * 32768; const char* Bb = Bs + (buf) * 32768; \
    _Pragma("unroll") for (int ks = 0; ks < 2; ++ks) { const int co = ((ks * 4 + fq) ^ swz) << 4; bf16x8 af[8], bfr[2]; \
      _Pragma("unroll") for (int m = 0; m < 8; ++m) af[m] = *(const bf16x8*)(Ab + aoff0 + m * 2048 + co); \
      _Pragma("unroll") for (int n = 0; n < 2; ++n) bfr[n] = *(const bf16x8*)(Bb + boff0 + n * 2048 + co); \
      _Pragma("unroll") for (int m = 0; m < 8; ++m) _Pragma("unroll") for (int n = 0; n < 2; ++n) acc[m][n] = MFMA16(af[m], bfr[n], acc[m][n]); } } while (0)
  FLOAD(raA, ruaA, rubA, 0); FWRITE(raA, ruaA, rubA, 0); FLOAD(raB, ruaB, rubB, 1); FLOAD(raA, ruaA, rubA, 2);
  __syncthreads();
  for (int k2 = 0; k2 < NK2; k2 += 2) {
    FCOMP(0);
    if (k2 + 1 < NK2) { FWRITE(raB, ruaB, rubB, 1); if (k2 + 3 < NK2) FLOAD(raB, ruaB, rubB, k2 + 3); }
    __syncthreads();
    if (k2 + 1 < NK2) {
      FCOMP(1);
      if (k2 + 2 < NK2) { FWRITE(raA, ruaA, rubA, 0); if (k2 + 4 < NK2) FLOAD(raA, ruaA, rubA, k2 + 4); }
      __syncthreads();
    }
  }
#undef FLOAD
#undef FWRITE
#undef FCOMP
#pragma unroll
  for (int m = 0; m < 8; ++m)
#pragma unroll
    for (int n = 0; n < 2; ++n)
#pragma unroll
      for (int j = 0; j < 4; ++j) {
        const int row = m * 16 + fq * 4 + j, col = qd * 128 + wq * 32 + n * 16 + fr;
        *(u16*)(smem + row * 512 + ((((col >> 3) ^ (row & 15))) << 4) + (col & 7) * 2) = f2bf(acc[m][n][j]);
      }
  __syncthreads();
  f32x4 accP[8], accQ[8];
#pragma unroll
  for (int n = 0; n < 8; ++n) { accP[n] = f32x4{0.f, 0.f, 0.f, 0.f}; accQ[n] = f32x4{0.f, 0.f, 0.f, 0.f}; }
  const u16* Mb = (const u16*)(p.ws + OFF_MCS) + ((size_t)(li * 4 + g) * 128) * 256;
  const int arow = wid * 16 + fr;
#pragma unroll
  for (int ks = 0; ks < 8; ++ks) {
    const bf16x8 a = *(const bf16x8*)(smem + arow * 512 + (((ks * 4 + fq) ^ fr) << 4));
#pragma unroll
    for (int n = 0; n < 8; ++n) {
      const bf16x8 bb = *(const bf16x8*)(Mb + (size_t)(n * 16 + fr) * 256 + ks * 32 + fq * 8);
      if (ks < 4) accP[n] = MFMA16(a, bb, accP[n]); else accQ[n] = MFMA16(a, bb, accQ[n]);
    }
  }
  u16* gy = (u16*)(p.ws + OFF_GY); const u16* gg = (const u16*)(p.ws + OFF_GG);
#pragma unroll
  for (int n = 0; n < 8; ++n)
#pragma unroll
    for (int j = 0; j < 4; ++j) {
      const int kk = kt * 128 + wid * 16 + fq * 4 + j;
      const int e = n * 16 + fr;
      const float P = accP[n][j], Q = accQ[n][j];
      if (kk <= LH) {
        const size_t o1 = ((size_t)(b * L + kk)) * DM + g * 128 + e;
        gy[o1] = f2bf((P + Q) * bf2f(gg[o1]));
        if (kk >= 1 && kk < LH) {
          const size_t o2 = ((size_t)(b * L + (L - kk))) * DM + g * 128 + e;
          gy[o2] = f2bf((P - Q) * bf2f(gg[o2]));
        }
      }
    }
  __syncthreads();
}

constexpr int N_ATT = NB * NH * 33;
constexpr int N_FOU = NB * 4 * 17;
#ifndef REPA
#define REPA 1
#endif
#ifndef REPB
#define REPB 1
#endif
#ifndef REPB_MODE
#define REPB_MODE 0
#endif
DI void phaseB(const P2& p, int li, char* smem, int rep) {
  int* qb_ = (int*)(p.ws + OFF_Q) + (li * 2 + rep) * 256;
  unsigned* bdone = (unsigned*)(p.ws + OFF_Q) + (li * 2) * 256 + 128;
  int* s_item = (int*)(smem + 131072);
  unsigned* sig1 = (unsigned*)(p.ws + OFF_CNT) + 40 + 2 * li + 1;
  const int myx = (int)(__builtin_amdgcn_s_getreg((3 << 11) | 20) & 7u);
  int d = 0;
  for (;;) {
    if (threadIdx.x == 0) {
      int dd = d, idx = -1, xq = 0;
      while (dd < 8) {
        xq = (myx + dd) & 7;
        idx = atomicAdd(qb_ + xq * 16, 1);
        if (idx < 200) break;
        idx = -1; ++dd;
      }
      s_item[0] = idx; s_item[1] = xq; s_item[3] = dd;
    }
    __syncthreads();
    const int idx = __builtin_amdgcn_readfirstlane(s_item[0]), xq = __builtin_amdgcn_readfirstlane(s_item[1]);
    d = __builtin_amdgcn_readfirstlane(s_item[3]);
    __syncthreads();
    if (idx < 0) break;
    const int grp = idx / 50, r = idx - grp * 50;
    int isf, sub;
    if (grp < 3) { const int f0 = (r * 17) / 50, f1 = ((r + 1) * 17) / 50; isf = f1 > f0; sub = isf ? f0 : r - f0; }
    else { isf = r >= 33; sub = isf ? r - 33 : r; }
    const int pair = xq + 8 * grp, bat = pair >> 2;
    if (bat == NB - 1) wait_sig(sig1, 96u);
    if (!isf) attn_tile(p, li, pair * 33 + sub, smem);
    else fourier_tile(p, li, bat * 68 + (pair & 3) * 17 + sub, smem);
  }
}

__global__ void __launch_bounds__(512) mega(Params p, int ph_begin, int ph_end) {
  __shared__ __attribute__((aligned(16))) char smem[131072 + 64 + 1024];
  if (ph_begin == 0) {
    phase0(p);
    if (ph_end > 1) cg::this_grid().sync();
  }
  P2 q; q.out = p.out; q.ws = p.ws; q.x = p.x; q.meta = p.meta;
  unsigned nbar = 0;
#pragma clang loop unroll(disable)
  for (int ph = (ph_begin < 1 ? 1 : ph_begin); ph < ph_end; ++ph) {
    const int li = (ph - 1) / 3, s = (ph - 1) % 3;
    unsigned* sig0 = (unsigned*)(q.ws + OFF_CNT) + 40 + 2 * li;
    unsigned* sig1 = sig0 + 1;
    const int bx = blockIdx.x;
    { int mode = -1, lc = li;
      if (s == 2) mode = 0; else if (s == 1 && li > 0 && bx < 4) { mode = 1; lc = li - 1; }
      if (mode >= 0) phaseC(q, lc, smem, mode, bx, sig0); }
    { int mode = -1;
      if (s == 0) mode = 0; else if (s == 1 && bx >= 4 && bx < 16) { mode = 1; wait_sig(sig0, li > 0 ? 32u : 0u); }
      if (mode >= 0) phaseA(q, li, smem, mode, bx - 4, sig1); }
    if (s == 1) { for (int rep = 0; rep < REPB; ++rep) phaseB(q, li, smem, rep); }
    if (ph + 1 < ph_end) { ++nbar; grid_barrier((unsigned*)(q.ws + OFF_CNT) + 32, nbar * gridDim.x); }
  }
}

extern "C" void kernel_launch(void* const* d_in, const int* in_sizes, int n_in, void* d_out, int out_size, void* d_ws, size_t ws_size, hipStream_t stream) {
  if (ws_size < WS_END) { fprintf(stderr, "workspace too small: %zu < %zu\n", ws_size, (size_t)WS_END); return; }
  Params p{};
  p.x = (const float*)d_in[0]; p.meta = (const float*)d_in[1]; p.norm_gain = (const float*)d_in[2]; p.w_in = (const float*)d_in[3];
  p.w_f = (const float*)d_in[4]; p.qg = (const float*)d_in[5]; p.kg = (const float*)d_in[6]; p.lq1 = (const float*)d_in[7];
  p.lk1 = (const float*)d_in[8]; p.lq2 = (const float*)d_in[9]; p.lk2 = (const float*)d_in[10]; p.subln = (const float*)d_in[11];
  p.w_out = (const float*)d_in[12]; p.out = (float*)d_out; p.ws = (char*)d_ws;
  constexpr int NPH = 1 + 3 * DEPTH;
#if MULTI_LAUNCH
  for (int ph = 0; ph < NPH; ++ph) hipLaunchKernelGGL(mega, dim3(256), dim3(512), 0, stream, p, ph, ph + 1);
#else
  static int grid_blocks = 0;
  if (!grid_blocks) {
    int dev = 0, cus = 0, per_cu = 0;
    hipGetDevice(&dev);
    hipDeviceGetAttribute(&cus, hipDeviceAttributeMultiprocessorCount, dev);
    hipOccupancyMaxActiveBlocksPerMultiprocessor(&per_cu, mega, 512, 0);
    if (per_cu < 1) per_cu = 1;
    grid_blocks = cus * 1;
  }
  int b0 = 0, b1 = NPH;
  void* args[] = {&p, &b0, &b1};
  hipError_t e = hipLaunchCooperativeKernel((void*)mega, dim3(grid_blocks), dim3(512), args, 0, stream);
  if (e != hipSuccess) fprintf(stderr, "cooperative launch failed: %s (grid %d)\n", hipGetErrorString(e), grid_blocks);
#endif
}
```

```cpp
#include <hip/hip_runtime.h>
#include <hip/hip_bf16.h>
#include <hip/hip_cooperative_groups.h>
#include <cstdio>
#include <cstdint>
namespace cg = cooperative_groups;

#ifndef MULTI_LAUNCH
#define MULTI_LAUNCH 0
#endif

typedef unsigned short u16;
using bf16x8 = __attribute__((ext_vector_type(8))) short;
using s16x4  = __attribute__((ext_vector_type(4))) short;
using f32x4  = __attribute__((ext_vector_type(4))) float;
using f32x16 = __attribute__((ext_vector_type(16))) float;
using u32x4  = __attribute__((ext_vector_type(4))) unsigned;
using u32x2  = __attribute__((ext_vector_type(2))) unsigned;

constexpr int NB = 8, SEQ = 4096, NMETA = 16, L = 4112, DM = 1024, DEPTH = 4;
constexpr int R = NB * L;
constexpr int RP = 33024;
constexpr int INW = 3072;
constexpr int NH = 4;
constexpr int LP = 4224;
constexpr int LH = 2056;
constexpr int KROWS = 2176;
constexpr int KP = 2112;
constexpr int NKT = 65;
constexpr float EPS = 1e-6f;

constexpr size_t al256(size_t x) { return (x + 255) / 256 * 256; }
constexpr size_t OFF_META = 0;
constexpr size_t OFF_XB   = al256(OFF_META + (size_t)NB * NMETA * DM * 4);
constexpr size_t OFF_GY   = al256(OFF_XB + (size_t)RP * DM * 2);
constexpr size_t OFF_QN   = al256(OFF_GY + (size_t)RP * DM * 2);
constexpr size_t QKV_BYTES = (size_t)NB * NH * LP * 128 * 2;
constexpr size_t OFF_KN   = al256(OFF_QN + QKV_BYTES);
constexpr size_t OFF_VN   = al256(OFF_KN + QKV_BYTES);
constexpr size_t OFF_WIN  = al256(OFF_VN + QKV_BYTES);
constexpr size_t OFF_WOUT = al256(OFF_WIN + (size_t)DEPTH * INW * DM * 2);
constexpr size_t OFF_CM   = al256(OFF_WOUT + (size_t)DEPTH * DM * DM * 2);
constexpr size_t OFF_SM   = al256(OFF_CM + (size_t)KROWS * KP * 2);
constexpr size_t OFF_MCS  = al256(OFF_SM + (size_t)KROWS * KP * 2);
constexpr size_t OFF_UTA  = al256(OFF_MCS + (size_t)DEPTH * 4 * 128 * 256 * 2);
constexpr size_t OFF_UTB  = al256(OFF_UTA + (size_t)NB * 512 * KP * 2);
constexpr size_t OFF_RSS  = al256(OFF_UTB + (size_t)NB * 512 * KP * 2);
constexpr size_t OFF_ROPE = al256(OFF_RSS + (size_t)RP * 16 * 4);
constexpr size_t OFF_CST  = al256(OFF_ROPE + (size_t)L * 16 * 4);
constexpr size_t OFF_SMALL = al256(OFF_CST + 256);
constexpr size_t OFF_CNT  = al256(OFF_SMALL + 4096);
constexpr size_t OFF_GG   = al256(OFF_CNT + 256);
constexpr size_t OFF_Q    = al256(OFF_GG + (size_t)RP * DM * 2);
constexpr size_t WS_END   = OFF_Q + 4 * 2 * 16 * 16 * 4;

struct Params {
  const float *x, *meta, *norm_gain, *w_in, *w_f, *qg, *kg, *lq1, *lk1, *lq2, *lk2, *subln, *w_out;
  float* out;
  char* ws;
};

struct P2 { float* out; char* ws; const float* x; const float* meta; };
__device__ __forceinline__ void grid_barrier(unsigned* bar, unsigned target) {
  asm volatile("s_waitcnt vmcnt(0) lgkmcnt(0)" ::: "memory");
  __syncthreads();
  if (threadIdx.x == 0) {
    __builtin_amdgcn_fence(__ATOMIC_RELEASE, "agent");
    asm volatile("s_waitcnt vmcnt(0)" ::: "memory");
    __hip_atomic_fetch_add(bar, 1u, __ATOMIC_RELAXED, __HIP_MEMORY_SCOPE_AGENT);
    while (__hip_atomic_load(bar, __ATOMIC_RELAXED, __HIP_MEMORY_SCOPE_AGENT) < target) __builtin_amdgcn_s_sleep(2);
    __builtin_amdgcn_fence(__ATOMIC_ACQUIRE, "agent");
    asm volatile("s_waitcnt vmcnt(0)" ::: "memory");
  }
  __syncthreads();
}
#define DI __device__ __forceinline__
#define MFMA16(a, b, c) __builtin_amdgcn_mfma_f32_16x16x32_bf16((a), (b), (c), 0, 0, 0)
#define MFMA32(a, b, c) __builtin_amdgcn_mfma_f32_32x32x16_bf16((a), (b), (c), 0, 0, 0)

using bf16v2 = __attribute__((ext_vector_type(2))) __bf16;
DI void wait_sig(unsigned* sig, unsigned target) {
  if (threadIdx.x == 0) {
    while (__hip_atomic_load(sig, __ATOMIC_RELAXED, __HIP_MEMORY_SCOPE_AGENT) < target) __builtin_amdgcn_s_sleep(2);
    __builtin_amdgcn_fence(__ATOMIC_ACQUIRE, "agent");
    asm volatile("s_waitcnt vmcnt(0)" ::: "memory");
  }
  __syncthreads();
}
DI unsigned cvtpk(float lo, float hi) { bf16v2 v; v[0] = (__bf16)lo; v[1] = (__bf16)hi; return __builtin_bit_cast(unsigned, v); }
DI u16 f2bf(float x) { return (u16)(cvtpk(x, x) & 0xffffu); }
DI float bf2f(u16 v) { return __uint_as_float(((unsigned)v) << 16); }
DI float wave_sum(float v) { for (int o = 32; o; o >>= 1) v += __shfl_xor(v, o); return v; }
DI float wave_max(float v) { for (int o = 32; o; o >>= 1) v = fmaxf(v, __shfl_xor(v, o)); return v; }
DI float addf(float a, float b) { float r; asm volatile("v_add_f32 %0, %1, %2" : "=v"(r) : "v"(a), "v"(b)); return r; }
DI int crow(int r, int hi) { return (r & 3) + 8 * (r >> 2) + 4 * hi; }

DI float* hres_row(const Params& p, int row) {
  const int b = row / L, l = row - b * L;
  return l < NMETA ? (float*)(p.ws + OFF_META) + (size_t)(b * NMETA + l) * DM
                   : p.out + ((size_t)b * SEQ + (l - NMETA)) * DM;
}

DI void row_bl(int row, int b0, int& b, int& l) { b = b0 + ((row >= (b0 + 1) * L) ? 1 : 0); l = row - b * L; }
#define CBAR() asm volatile("" ::: "memory")
DI int opaque_tid() { int t = threadIdx.x; asm volatile("" : "+v"(t)); return t; }

__device__ const double INVF[8] = {1.0, 0.19392274474868576, 0.03760603093086393, 0.007292664737217109, 0.001414213562373095, 0.0002742481756762073, 5.318295896944988e-05, 1.031338537721246e-05};

DI void phase0(const Params& p) {
  const int tid = threadIdx.x, gtid = blockIdx.x * 512 + tid, gsz = gridDim.x * 512;
  const int lane = tid & 63, gw = gtid >> 6, nw = gsz >> 6;
  u16* xb = (u16*)(p.ws + OFF_XB);
  float* rss = (float*)(p.ws + OFF_RSS);
  for (int row = gw; row < RP; row += nw) {
    if (row < R) {
      const int b = row / L, l = row - b * L;
      const float* src = l < NMETA ? p.meta + (size_t)l * DM : p.x + ((size_t)b * SEQ + (l - NMETA)) * DM;
      float ss = 0.f;
#pragma unroll
      for (int i = 0; i < 4; ++i) {
        const f32x4 v = *(const f32x4*)(src + i * 256 + lane * 4);
        ss += v[0] * v[0] + v[1] * v[1] + v[2] * v[2] + v[3] * v[3];
        u32x2 o = {cvtpk(v[0], v[1]), cvtpk(v[2], v[3])};
        *(u32x2*)(xb + (size_t)row * DM + i * 256 + lane * 4) = o;
      }
      ss = wave_sum(ss);
      if (lane == 0) rss[(size_t)row * 16] = ss;
    } else {
#pragma unroll
      for (int i = 0; i < 4; ++i) { u32x2 o = {0u, 0u}; *(u32x2*)(xb + (size_t)row * DM + i * 256 + lane * 4) = o; }
      if (lane == 0) rss[(size_t)row * 16] = 1024.f;
    }
    if (lane >= 1 && lane < 16) rss[(size_t)row * 16 + lane] = 0.f;
  }
  {
    u16* WinT = (u16*)(p.ws + OFF_WIN);
    for (long it = gtid; it < (long)DEPTH * 128 * INW; it += gsz) {
      const int nd = (int)(it % INW); const long t2 = it / INW; const int kc = (int)(t2 % 128), li = (int)(t2 / 128);
      const int c1 = nd & 255;
      const int n = (nd & ~255) + ((c1 >> 5) & 3) * 64 + (c1 >> 7) * 32 + (c1 & 31);
      const float* w = p.w_in + ((size_t)li * DM + kc * 8) * INW + n;
      const float* g = p.norm_gain + li * DM + kc * 8;
      float v[8];
#pragma unroll
      for (int j = 0; j < 8; ++j) v[j] = w[(size_t)j * INW] * g[j];
      u32x4 o = {cvtpk(v[0], v[1]), cvtpk(v[2], v[3]), cvtpk(v[4], v[5]), cvtpk(v[6], v[7])};
      *(u32x4*)(WinT + ((size_t)li * INW + nd) * DM + kc * 8) = o;
    }
  }
  {
    u16* WoutT = (u16*)(p.ws + OFF_WOUT);
    for (long it = gtid; it < (long)DEPTH * 128 * DM; it += gsz) {
      const int n = (int)(it % DM); const long t2 = it / DM; const int kc = (int)(t2 % 128), li = (int)(t2 / 128);
      const float* w = p.w_out + ((size_t)li * DM + kc * 8) * DM + n;
      float v[8];
#pragma unroll
      for (int j = 0; j < 8; ++j) v[j] = w[(size_t)j * DM];
      u32x4 o = {cvtpk(v[0], v[1]), cvtpk(v[2], v[3]), cvtpk(v[4], v[5]), cvtpk(v[6], v[7])};
      *(u32x4*)(WoutT + ((size_t)li * DM + n) * DM + kc * 8) = o;
    }
  }
  {
    u16* Cm = (u16*)(p.ws + OFF_CM); u16* Sm = (u16*)(p.ws + OFF_SM);
    for (int it = gtid; it < KROWS * (KP / 8); it += gsz) {
      const int k = it / (KP / 8), j0 = (it % (KP / 8)) * 8;
      float c[8], s[8];
#pragma unroll
      for (int jj = 0; jj < 8; ++jj) {
        const int j = j0 + jj;
        const bool valid = (k <= LH) && (j <= LH);
        const int m = valid ? (k * j) % L : 0;
        const float rev = (float)m / (float)L;
        c[jj] = valid ? __builtin_amdgcn_cosf(rev) : 0.f;
        s[jj] = valid ? __builtin_amdgcn_sinf(rev) : 0.f;
      }
      u32x4 oc = {cvtpk(c[0], c[1]), cvtpk(c[2], c[3]), cvtpk(c[4], c[5]), cvtpk(c[6], c[7])};
      u32x4 os = {cvtpk(s[0], s[1]), cvtpk(s[2], s[3]), cvtpk(s[4], s[5]), cvtpk(s[6], s[7])};
      *(u32x4*)(Cm + (size_t)k * KP + j0) = oc;
      *(u32x4*)(Sm + (size_t)k * KP + j0) = os;
    }
  }
  {
    u16* Mcs = (u16*)(p.ws + OFF_MCS);
    const float norm = 1.0f / sqrtf((float)L * 128.f);
    for (int it = gtid; it < DEPTH * 4 * 256 * 128; it += gsz) {
      const int e = it & 127, cc = (it >> 7) & 255, lg = it >> 15;
      const int c = cc & 127; const bool isS = cc >= 128;
      const float* wf = p.w_f + (size_t)lg * 128 * 128 + e;
      float acc = 0.f;
      for (int m = 0; m < 128; ++m) {
        const float rev = (float)((m * c) & 127) * (1.0f / 128.f);
        const float t = isS ? __builtin_amdgcn_sinf(rev) : __builtin_amdgcn_cosf(rev);
        acc += t * wf[m * 128];
      }
      acc *= isS ? -norm : norm;
      Mcs[((size_t)lg * 128 + e) * 256 + cc] = f2bf(acc);
    }
  }
  {
    u16* uta = (u16*)(p.ws + OFF_UTA); u16* utb = (u16*)(p.ws + OFF_UTB);
    for (int it = gtid; it < NB * 512 * 64; it += gsz) {
      const int row = it >> 6, i = it & 63;
      if (i < 55) { uta[(size_t)row * KP + 2057 + i] = 0; utb[(size_t)row * KP + 2057 + i] = 0; }
      else if (i == 55) utb[(size_t)row * KP] = 0;
      else if (i == 56) utb[(size_t)row * KP + LH] = 0;
    }
  }
  {
    u16* qn = (u16*)(p.ws + OFF_QN); u16* kn = (u16*)(p.ws + OFF_KN); u16* vt = (u16*)(p.ws + OFF_VN);
    for (int it = gtid; it < NB * NH * (LP - L) * 16; it += gsz) {
      const int ch = it & 15, rr = (it >> 4) % (LP - L), bh = (it >> 4) / (LP - L);
      const size_t off = ((size_t)bh * LP + L + rr) * 128 + ch * 8;
      u32x4 z = {0u, 0u, 0u, 0u};
      *(u32x4*)(qn + off) = z; *(u32x4*)(kn + off) = z;
    }
    for (int it = gtid; it < NB * NH * 128 * ((LP - L) / 8); it += gsz) {
      const int ch = it % ((LP - L) / 8), row = it / ((LP - L) / 8);
      u32x4 z = {0u, 0u, 0u, 0u};
      *(u32x4*)(vt + (size_t)row * LP + L + ch * 8) = z;
    }
  }
  {
    float* rope = (float*)(p.ws + OFF_ROPE);
    for (int it = gtid; it < L * 8; it += gsz) {
      const int l = it >> 3, i = it & 7;
      double rv = (double)l * INVF[i] * 0.15915494309189535;
      rv -= floor(rv);
      const float r = (float)rv;
      rope[l * 16 + i] = __builtin_amdgcn_cosf(r);
      rope[l * 16 + 8 + i] = __builtin_amdgcn_sinf(r);
    }
  }
  if (blockIdx.x == 0) {
    const int wid = tid >> 6;
    if (wid < DEPTH) {
      const int li = wid;
      float a = p.lq1[li * 64 + lane] * p.lk1[li * 64 + lane];
      float bq = p.lq2[li * 64 + lane] * p.lk2[li * 64 + lane];
      a = wave_sum(a); bq = wave_sum(bq);
      const float gq = wave_max(fabsf(p.qg[li * 64 + lane]));
      const float gk = wave_max(fabsf(p.kg[li * 64 + lane]));
      if (lane == 0) {
        float* cst = (float*)(p.ws + OFF_CST) + li * 8;
        const float lam_init = 0.8f - 0.6f * expf(-0.3f * (float)li);
        cst[0] = expf(a) - expf(bq) + lam_init;
        cst[1] = 1.0f - lam_init;
        cst[2] = (8.0f * gq * gk * 1.01f + 0.05f) * 1.4426950408889634f;
      }
    }
    if (tid < 64) ((int*)(p.ws + OFF_CNT))[tid] = 0;
    for (int i = tid; i < 4 * 2 * 16 * 16; i += 512) ((int*)(p.ws + OFF_Q))[i] = 0;
    float* sm = (float*)(p.ws + OFF_SMALL);
    if (tid < 256) { sm[tid] = p.qg[tid]; sm[256 + tid] = p.kg[tid]; }
    sm[512 + tid] = p.subln[tid];
  }
}

namespace pg8 {
#define PG8_LAS __attribute__((address_space(3)))
constexpr int BM = 256, BK = 64, HALF = 128, HTB = HALF * BK * 2, NXCD = 8, WGM = 8;
DI int lds_byte(int r, int c) { const int st = (r >> 4) * 2 + (c >> 5), rr = r & 15, cc = c & 31, ob = rr * 64 + cc * 2; return st * 1024 + (ob ^ (((ob >> 9) & 1) << 5)); }
DI void stage_rc(int b, int& R, int& C) { const int st = b / 1024, sb = b % 1024, swz = sb ^ (((sb >> 9) & 1) << 5); R = (st >> 1) * 16 + swz / 64; C = (st & 1) * 32 + (swz % 64) / 2; }
DI int perm32(int rho) { const int n = rho >> 4, i = rho & 15; return 8 * (i >> 2) + 4 * n + (i & 3); }
struct Unit { int pm, pn; };
struct Gemm { const u16* A; const u16* Bt; int M, N, K; };
struct StaticOrder {
  int nM, nN, nwg, G, c;
  DI void init(int M, int N, int G_, int c_) { nM = M / BM; nN = N / BM; nwg = nM * nN; G = G_; c = c_; }
  DI bool next(int i, Unit& u) const {
    const long Lx = (long)i * G + c; if (Lx >= nwg) return false;
    int wgid = (int)Lx; { const int q = nwg / NXCD, r = nwg % NXCD, xcd = wgid % NXCD, off = wgid / NXCD; wgid = (xcd < r ? xcd * (q + 1) : r * (q + 1) + (xcd - r) * q) + off; }
    const int nig = WGM * nN, gid = wgid / nig, fm = gid * WGM, gsz = (nM - fm) < WGM ? (nM - fm) : WGM;
    u.pm = fm + ((wgid % nig) % gsz); u.pn = (wgid % nig) / gsz; return true;
  }
  DI void done(int) const {}
};
struct Order {
  int mode; StaticOrder st; int pm, pn; unsigned* sig;
  const unsigned* bready;
  DI void a_ready(const Unit& u) const {
    if (bready == nullptr) return;
    if (threadIdx.x < 64) {
      const int b1 = (u.pm * 256) / L; int b2 = (u.pm * 256 + 255) / L; if (b2 > NB - 1) b2 = NB - 1;
      while ((unsigned)__builtin_amdgcn_readfirstlane(__hip_atomic_load(bready + b1 * 16, __ATOMIC_RELAXED, __HIP_MEMORY_SCOPE_AGENT)) < 200u ||
             (unsigned)__builtin_amdgcn_readfirstlane(__hip_atomic_load(bready + b2 * 16, __ATOMIC_RELAXED, __HIP_MEMORY_SCOPE_AGENT)) < 200u) __builtin_amdgcn_s_sleep(2);
      __builtin_amdgcn_fence(__ATOMIC_ACQUIRE, "agent");
      asm volatile("s_waitcnt vmcnt(0)" ::: "memory");
    }
    asm volatile("" ::: "memory"); __builtin_amdgcn_s_barrier(); asm volatile("" ::: "memory");
  }
  DI bool next(int i, Unit& u) const { if (mode == 0) return st.next(i, u); if (i != 0) return false; u.pm = pm; u.pn = pn; return true; }
  DI void done(int lane) const {
    if (mode == 1) {
      asm volatile("s_waitcnt vmcnt(0)" ::: "memory");
      __builtin_amdgcn_fence(__ATOMIC_RELEASE, "agent");
      asm volatile("s_waitcnt vmcnt(0)" ::: "memory");
      if (lane == 0) __hip_atomic_fetch_add(sig, 1u, __ATOMIC_RELAXED, __HIP_MEMORY_SCOPE_AGENT);
    }
  }
};
template <class Epi, class Sched>
DI void gemm_phase(PG8_LAS unsigned char* lds, const Gemm g, const Sched& S, const Epi& E) {
  const int tid = opaque_tid(), wid = __builtin_amdgcn_readfirstlane(tid >> 6), lane = tid & 63, wr = wid >> 2, wc = wid & 3, fr = lane & 15, fq = lane >> 4;
  const int K = g.K, nt = K / BK;
  unsigned voffA[2], voffB[2];
#pragma unroll
  for (int i = 0; i < 2; ++i) { int R_, C_; stage_rc(tid * 16 + i * 8192, R_, C_); const int Rb = (R_ & ~31) + perm32(R_ & 31);
    voffA[i] = (unsigned)(R_ * K + C_) * 2u; voffB[i] = (unsigned)(Rb * K + C_) * 2u; }
  const size_t kstep = (size_t)(BK * 2);
  const size_t hstep = (size_t)HALF * K * 2;
  const size_t tstep = 2 * hstep;
  const unsigned ldsw = (unsigned)wid * 1024u;
  const int aoff = lds_byte(wr * 64 + fr, fq * 8), boff = lds_byte(wc * 32 + fr, fq * 8);
#define PG8_SA(b, h) (((b) * 2 + (h)) * HTB)
#define PG8_SB(b, h) ((4 + (b) * 2 + (h)) * HTB)
#define PG8_STAGE(bufoff, gbase, voff) do { _Pragma("unroll") for (int _i = 0; _i < 2; ++_i) \
    __builtin_amdgcn_global_load_lds((const unsigned*)((const char*)(gbase) + (voff)[_i]), (PG8_LAS unsigned*)(lds + (bufoff) + ldsw + _i * 8192), 16, 0, 0); } while (0)
#define PG8_LDA(dst, b, h) do { _Pragma("unroll") for (int m = 0; m < 4; ++m) _Pragma("unroll") for (int k = 0; k < 2; ++k) dst[m][k] = *(const PG8_LAS bf16x8*)(lds + PG8_SA(b, h) + aoff + m * 2048 + k * 1024); } while (0)
#define PG8_LDB(dst, b, h) do { _Pragma("unroll") for (int n = 0; n < 2; ++n) _Pragma("unroll") for (int k = 0; k < 2; ++k) dst[n][k] = *(const PG8_LAS bf16x8*)(lds + PG8_SB(b, h) + boff + n * 2048 + k * 1024); } while (0)
#define PG8_MMA(ai, bj, At, Bt) do { __builtin_amdgcn_s_setprio(1); _Pragma("unroll") for (int m = 0; m < 4; ++m) _Pragma("unroll") for (int n = 0; n < 2; ++n) _Pragma("unroll") for (int k = 0; k < 2; ++k) \
    acc[ai][bj][m][n] = __builtin_amdgcn_mfma_f32_16x16x32_bf16(Bt[n][k], At[m][k], acc[ai][bj][m][n], 0, 0, 0); __builtin_amdgcn_s_setprio(0); } while (0)
#define PG8_WAIT_V(n) asm volatile("s_waitcnt vmcnt(" #n ")" ::: "memory")
#define PG8_WAIT_L(n) asm volatile("s_waitcnt lgkmcnt(" #n ")" ::: "memory")
#define PG8_BAR __builtin_amdgcn_s_barrier()
#define PG8_SCHED __builtin_amdgcn_sched_barrier(0)
  Unit cur, nxt; int ui = 0;
  if (!S.next(0, cur)) return;
  f32x4 acc[2][2][4][2];
#pragma unroll
  for (int a = 0; a < 2; ++a)
#pragma unroll
    for (int b = 0; b < 2; ++b)
#pragma unroll
      for (int m = 0; m < 4; ++m)
#pragma unroll
        for (int n = 0; n < 2; ++n) acc[a][b][m][n] = (f32x4){0.f, 0.f, 0.f, 0.f};
  bf16x8 At[4][2], B0[2][2], B1[2][2];
  const char* cA = (const char*)g.A + (size_t)cur.pm * tstep; const char* cB = (const char*)g.Bt + (size_t)cur.pn * tstep;
  S.a_ready(cur);
  PG8_STAGE(PG8_SB(0, 0), cB, voffB); PG8_STAGE(PG8_SA(0, 0), cA, voffA); PG8_STAGE(PG8_SB(0, 1), cB + hstep, voffB); PG8_STAGE(PG8_SA(0, 1), cA + hstep, voffA);
  if (wr == 1) PG8_BAR;
  PG8_WAIT_V(4); PG8_BAR;
  PG8_STAGE(PG8_SB(1, 0), cB + kstep, voffB); PG8_STAGE(PG8_SA(1, 0), cA + kstep, voffA); PG8_STAGE(PG8_SB(1, 1), cB + hstep + kstep, voffB);
  PG8_WAIT_V(6); PG8_BAR;
  for (;;) {
    const bool has_next = S.next(ui + 1, nxt);
    const char* nA = has_next ? (const char*)g.A + (size_t)nxt.pm * tstep : cA; const char* nB = has_next ? (const char*)g.Bt + (size_t)nxt.pn * tstep : cB;
    for (int t = 0; t < nt; t += 2) {
      const bool last = (t == nt - 2);
      const char* a1 = cA + (size_t)(t + 1) * kstep;
      const char* a2 = last ? nA : cA + (size_t)(t + 2) * kstep; const char* b2 = last ? nB : cB + (size_t)(t + 2) * kstep;
      const char* a3 = a2 + kstep; const char* b3 = b2 + kstep;
      if (last && has_next) S.a_ready(nxt);
      PG8_LDB(B0, 0, 0); PG8_SCHED; PG8_LDA(At, 0, 0); PG8_STAGE(PG8_SA(1, 1), a1 + hstep, voffA);
      PG8_WAIT_L(8); PG8_BAR; PG8_WAIT_L(0); PG8_MMA(0, 0, At, B0); PG8_BAR; PG8_SCHED;
      PG8_LDB(B1, 0, 1); PG8_STAGE(PG8_SB(0, 0), b2, voffB);
      PG8_BAR; PG8_WAIT_L(0); PG8_MMA(0, 1, At, B1); PG8_BAR;
      PG8_LDA(At, 0, 1); PG8_STAGE(PG8_SA(0, 0), a2, voffA);
      PG8_BAR; PG8_WAIT_L(0); PG8_MMA(1, 0, At, B0); PG8_BAR; PG8_SCHED;
      PG8_STAGE(PG8_SB(0, 1), b2 + hstep, voffB);
      PG8_WAIT_V(6); PG8_BAR; PG8_MMA(1, 1, At, B1); PG8_BAR;
      PG8_LDB(B0, 1, 0); PG8_SCHED; PG8_LDA(At, 1, 0); PG8_STAGE(PG8_SA(0, 1), a2 + hstep, voffA);
      PG8_WAIT_L(8); PG8_BAR; PG8_WAIT_L(0); PG8_MMA(0, 0, At, B0); PG8_BAR; PG8_SCHED;
      PG8_LDB(B1, 1, 1); PG8_STAGE(PG8_SB(1, 0), b3, voffB);
      PG8_BAR; PG8_WAIT_L(0); PG8_MMA(0, 1, At, B1); PG8_BAR;
      PG8_LDA(At, 1, 1); PG8_STAGE(PG8_SA(1, 0), a3, voffA);
      PG8_BAR; PG8_WAIT_L(0); PG8_MMA(1, 0, At, B0); PG8_BAR; PG8_SCHED;
      PG8_STAGE(PG8_SB(1, 1), b3 + hstep, voffB);
      PG8_WAIT_V(6); PG8_BAR; PG8_MMA(1, 1, At, B1); PG8_BAR;
    }
    E(acc, cur, wr, wc, fr, fq);
    S.done(lane);
    if (!has_next) break;
#pragma unroll
    for (int a = 0; a < 2; ++a)
#pragma unroll
      for (int b = 0; b < 2; ++b)
#pragma unroll
        for (int m = 0; m < 4; ++m)
#pragma unroll
          for (int n = 0; n < 2; ++n) acc[a][b][m][n] = (f32x4){0.f, 0.f, 0.f, 0.f};
    cur = nxt; cA = nA; cB = nB; ++ui;
  }
  PG8_WAIT_V(0);
  if (wr == 0) PG8_BAR;
  PG8_BAR;
#undef PG8_SA
#undef PG8_SB
#undef PG8_STAGE
#undef PG8_LDA
#undef PG8_LDB
#undef PG8_MMA
#undef PG8_WAIT_V
#undef PG8_WAIT_L
#undef PG8_BAR
#undef PG8_SCHED
}
}

DI float row_scale(const float* rsp, int row) {
  const f32x4* rp = (const f32x4*)(rsp + (size_t)row * 16);
  const f32x4 a0 = rp[0], a1 = rp[1], a2 = rp[2], a3 = rp[3];
  const float s = ((a0[0] + a0[1]) + (a0[2] + a0[3])) + ((a1[0] + a1[1]) + (a1[2] + a1[3])) + ((a2[0] + a2[1]) + (a2[2] + a2[3])) + ((a3[0] + a3[1]) + (a3[2] + a3[3]));
  return rsqrtf(s * (1.0f / DM) + EPS);
}

struct EpiA {
  char* ws; int li;
  DI void operator()(const f32x4 (&acc)[2][2][4][2], const pg8::Unit& u, int wr, int wc, int fr, int fq) const {
    const int mt = u.pm, nt = u.pn;
    const float* rsp = (const float*)(ws + OFF_RSS);
    const int b0 = (mt * 256) / L;
    const int rbase = mt * 256 + wr * 64 + fr;
    float scv[2][4];
    {
      const int lane_ = fq * 16 + fr, r0_ = mt * 256 + wr * 64 + lane_;
      const float so0 = row_scale(rsp, r0_ < R ? r0_ : 0), so1 = row_scale(rsp, r0_ + 128 < R ? r0_ + 128 : 0);
#pragma unroll
      for (int m = 0; m < 4; ++m) { scv[0][m] = __shfl(so0, m * 16 + fr); scv[1][m] = __shfl(so1, m * 16 + fr); }
    }
    if (nt < 2) {
      u16* uta = (u16*)(ws + OFF_UTA); u16* utb = (u16*)(ws + OFF_UTB);
      const int chb = nt * 256 + wc * 64 + 8 * fq;
#pragma unroll
      for (int ai = 0; ai < 2; ++ai)
#pragma unroll
        for (int m = 0; m < 4; ++m) {
          const int row = rbase + ai * 128 + m * 16;
          if (row < R) {
            int b, l; row_bl(row, b0, b, l);
            const float sc = scv[ai][m];
            u16* dst = (l <= LH) ? uta + (size_t)b * 512 * KP + l : utb + (size_t)b * 512 * KP + (L - l);
#pragma unroll
            for (int bj = 0; bj < 2; ++bj)
#pragma unroll
              for (int n = 0; n < 2; ++n)
#pragma unroll
                for (int j = 0; j < 4; ++j) dst[(size_t)(chb + bj * 32 + n * 4 + j) * KP] = f2bf(acc[ai][bj][m][n][j] * sc);
          }
          CBAR();
        }
    } else if (nt < 6) {
      const bool isq = nt < 4;
      const int gi = (isq ? nt - 2 : nt - 4) * 4 + wc;
      const int h = gi >> 1, comp = gi & 1;
      const float* gain = (const float*)(ws + OFF_SMALL) + (isq ? 0 : 256) + li * 64 + 8 * fq;
      const f32x4 g00 = *(const f32x4*)(gain), g01 = *(const f32x4*)(gain + 4), g10 = *(const f32x4*)(gain + 32), g11 = *(const f32x4*)(gain + 36);
      const float qsc = isq ? 0.125f * 1.4426950408889634f : 1.0f;
      const float* rope = (const float*)(ws + OFF_ROPE);
      u16* dbase = (u16*)(ws + (isq ? OFF_QN : OFF_KN));
#pragma unroll
      for (int ai = 0; ai < 2; ++ai)
#pragma unroll
        for (int m = 0; m < 4; ++m) {
          const int row = rbase + ai * 128 + m * 16;
          const bool valid = row < R;
          const int rowc = valid ? row : 0;
          int b, l; row_bl(rowc, valid ? b0 : 0, b, l);
          const float sc = scv[ai][m];
          f32x4 v00 = acc[ai][0][m][0] * sc, v01 = acc[ai][0][m][1] * sc, v10 = acc[ai][1][m][0] * sc, v11 = acc[ai][1][m][1] * sc;
          float ss = 0.f;
#pragma unroll
          for (int j = 0; j < 4; ++j) ss += v00[j] * v00[j] + v01[j] * v01[j] + v10[j] * v10[j] + v11[j] * v11[j];
          ss += __shfl_xor(ss, 16); ss += __shfl_xor(ss, 32);
          const float rq = rsqrtf(ss * (1.0f / 64.f) + EPS) * qsc;
          v00 = v00 * g00 * rq; v01 = v01 * g01 * rq; v10 = v10 * g10 * rq; v11 = v11 * g11 * rq;
          const f32x4 c0 = *(const f32x4*)(rope + l * 16), c1 = *(const f32x4*)(rope + l * 16 + 4), s0 = *(const f32x4*)(rope + l * 16 + 8), s1 = *(const f32x4*)(rope + l * 16 + 12);
          f32x4 p0, p1;
#pragma unroll
          for (int j = 0; j < 4; ++j) { p0[j] = __shfl_xor(v00[j], 16); p1[j] = __shfl_xor(v01[j], 16); }
          if (fq == 0) { v00 = v00 * c0 - p0 * s0; v01 = v01 * c1 - p1 * s1; }
          else if (fq == 1) { v00 = v00 * c0 + p0 * s0; v01 = v01 * c1 + p1 * s1; }
          if (valid) {
            u16* dst = dbase + (((size_t)(b * NH + h)) * LP + l) * 128 + comp * 64 + 8 * fq;
            u32x4 w0 = {cvtpk(v00[0], v00[1]), cvtpk(v00[2], v00[3]), cvtpk(v01[0], v01[1]), cvtpk(v01[2], v01[3])};
            u32x4 w1 = {cvtpk(v10[0], v10[1]), cvtpk(v10[2], v10[3]), cvtpk(v11[0], v11[1]), cvtpk(v11[2], v11[3])};
            *(u32x4*)(dst) = w0; *(u32x4*)(dst + 32) = w1;
          }
          CBAR();
        }
    } else if (nt < 8) {
      const int cv = (nt - 6) * 256 + wc * 64;
      const int h = cv >> 7, dv = (cv & 127) + 8 * fq;
      u16* vt = (u16*)(ws + OFF_VN);
#pragma unroll
      for (int ai = 0; ai < 2; ++ai)
#pragma unroll
        for (int m = 0; m < 4; ++m) {
          const int row = rbase + ai * 128 + m * 16;
          if (row < R) {
            int b, l; row_bl(row, b0, b, l);
            const float sc = scv[ai][m];
            const int o = l & 15;
            const int pos = (l & ~15) + 8 * ((o >> 2) & 1) + 4 * (o >> 3) + (o & 3);
            u16* dst = vt + ((size_t)(b * NH + h) * 128 + dv) * LP + pos;
#pragma unroll
            for (int bj = 0; bj < 2; ++bj)
#pragma unroll
              for (int n = 0; n < 2; ++n)
#pragma unroll
                for (int j = 0; j < 4; ++j) dst[(size_t)(bj * 32 + n * 4 + j) * LP] = f2bf(acc[ai][bj][m][n][j] * sc);
          }
          CBAR();
        }
    } else {
      u16* gg = (u16*)(ws + OFF_GG);
      const int cgc = (nt - 8) * 256 + wc * 64 + 8 * fq;
#pragma unroll
      for (int ai = 0; ai < 2; ++ai)
#pragma unroll
        for (int m = 0; m < 4; ++m) {
          const int row = rbase + ai * 128 + m * 16;
          if (row < R) {
            const float sc = scv[ai][m];
            u16* dst = gg + (size_t)row * DM + cgc;
#pragma unroll
            for (int bj = 0; bj < 2; ++bj) {
              f32x4 a = acc[ai][bj][m][0] * sc, c = acc[ai][bj][m][1] * sc;
#pragma unroll
              for (int j = 0; j < 4; ++j) { a[j] = a[j] * __builtin_amdgcn_rcpf(1.0f + __expf(-a[j])); c[j] = c[j] * __builtin_amdgcn_rcpf(1.0f + __expf(-c[j])); }
              u32x4 w = {cvtpk(a[0], a[1]), cvtpk(a[2], a[3]), cvtpk(c[0], c[1]), cvtpk(c[2], c[3])};
              *(u32x4*)(dst + bj * 32) = w;
            }
          }
          CBAR();
        }
    }
  }
};
DI void phaseA(const P2& p, int li, char* smem, int mode, int pn, unsigned* sig) {
  pg8::Gemm g; g.A = (const u16*)(p.ws + OFF_XB); g.Bt = (const u16*)(p.ws + OFF_WIN) + (size_t)li * INW * DM; g.M = RP; g.N = INW; g.K = DM;
  pg8::Order S; S.mode = mode; S.st.init(RP - 256, INW, gridDim.x, blockIdx.x); S.pm = RP / 256 - 1; S.pn = pn; S.sig = sig; S.bready = nullptr;
  EpiA E; E.ws = p.ws; E.li = li;
  pg8::gemm_phase((PG8_LAS unsigned char*)smem, g, S, E);
}

struct EpiC {
  char* ws; float* out; const float* x; const float* meta; int li;
  DI void operator()(const f32x4 (&acc)[2][2][4][2], const pg8::Unit& u, int wr, int wc, int fr, int fq) const {
    const int mt = u.pm, nt = u.pn;
    const bool last = (li == DEPTH - 1), first = (li == 0);
    u16* xb = (u16*)(ws + OFF_XB);
    float* rsp = (float*)(ws + OFF_RSS);
    const int b0 = (mt * 256) / L;
    const int rbase = mt * 256 + wr * 64 + fr;
    const int cb = nt * 256 + wc * 32 + 8 * fq;
#pragma unroll
    for (int ai = 0; ai < 2; ++ai)
#pragma unroll
      for (int m = 0; m < 4; ++m) {
        const int row = rbase + ai * 128 + m * 16;
        const bool valid = row < R;
        float ss = 0.f;
        if (valid) {
          int b, l; row_bl(row, b0, b, l);
          u16* xr = xb + (size_t)row * DM + cb;
          const float* xin = (l < NMETA ? meta + (size_t)l * DM : x + ((size_t)b * SEQ + (l - NMETA)) * DM) + cb;
          float* orow = out + ((size_t)b * SEQ + (l - NMETA)) * DM + cb;
#pragma unroll
          for (int bj = 0; bj < 2; ++bj) {
            f32x4 a, c;
            if (first) { a = *(const f32x4*)(xin + bj * 128); c = *(const f32x4*)(xin + bj * 128 + 4); }
            else { const u32x4 w = *(const u32x4*)(xr + bj * 128);
              a = f32x4{__uint_as_float(w[0] << 16), __uint_as_float(w[0] & 0xffff0000u), __uint_as_float(w[1] << 16), __uint_as_float(w[1] & 0xffff0000u)};
              c = f32x4{__uint_as_float(w[2] << 16), __uint_as_float(w[2] & 0xffff0000u), __uint_as_float(w[3] << 16), __uint_as_float(w[3] & 0xffff0000u)}; }
            a += acc[ai][bj][m][0]; c += acc[ai][bj][m][1];
            if (last) { if (l >= NMETA) { *(f32x4*)(orow + bj * 128) = a; *(f32x4*)(orow + bj * 128 + 4) = c; } }
            else { u32x4 w = {cvtpk(a[0], a[1]), cvtpk(a[2], a[3]), cvtpk(c[0], c[1]), cvtpk(c[2], c[3])}; *(u32x4*)(xr + bj * 128) = w; }
#pragma unroll
            for (int j = 0; j < 4; ++j) ss += a[j] * a[j] + c[j] * c[j];
          }
        }
        ss += __shfl_xor(ss, 16); ss += __shfl_xor(ss, 32);
        if (valid && !last && fq == 0) rsp[(size_t)row * 16 + nt * 4 + wc] = ss;
        if (m == 1 || m == 3) CBAR();
      }
  }
};
DI void phaseC(const P2& p, int li, char* smem, int mode, int pn, unsigned* sig) {
  pg8::Gemm g; g.A = (const u16*)(p.ws + OFF_GY); g.Bt = (const u16*)(p.ws + OFF_WOUT) + (size_t)li * DM * DM; g.M = RP; g.N = DM; g.K = DM;
  pg8::Order S; S.mode = mode; S.st.init(li == DEPTH - 1 ? RP : RP - 256, DM, gridDim.x, blockIdx.x); S.pm = RP / 256 - 1; S.pn = pn; S.sig = sig;
  S.bready = nullptr;
  EpiC E; E.ws = p.ws; E.out = p.out; E.x = p.x; E.meta = p.meta; E.li = li;
  pg8::gemm_phase((PG8_LAS unsigned char*)smem, g, S, E);
}

#define KSWZ(row, colB) ((row) * 256 + ((colB) ^ (((row) & 15) << 4)))
DI int v_st(int k, int c) { const int kk = (k & ~0xC) | ((k & 4) << 1) | ((k & 8) >> 1); return ((kk >> 3) * 4 + (c >> 5)) * 512 + ((kk & 7) * 32 + (c & 31)) * 2; }
DI int v_rd_base(int lane) { return ((lane & 3) << 3) | (((lane >> 2) & 3) << 6) | (((lane >> 4) & 1) << 5) | (((lane >> 5) & 1) << 8); }
constexpr int v_rd_off(int d0, int ks, int half) { return d0 * 512 + ks * 4096 + half * 2048; }
template <int OFF> DI s16x4 tr_read(int vb) {
  s16x4 r; asm volatile("ds_read_b64_tr_b16 %0, %1 offset:%2" : "=&v"(r) : "v"(vb), "i"(OFF) : "memory"); return r;
}
template <int D0> DI void pv_one(f32x16& od, int vb, bf16x8 pa0, bf16x8 pa1, bf16x8 pa2, bf16x8 pa3) {
  const s16x4 l0 = tr_read<v_rd_off(D0, 0, 0)>(vb), h0 = tr_read<v_rd_off(D0, 0, 1)>(vb), l1 = tr_read<v_rd_off(D0, 1, 0)>(vb), h1 = tr_read<v_rd_off(D0, 1, 1)>(vb);
  const s16x4 l2 = tr_read<v_rd_off(D0, 2, 0)>(vb), h2 = tr_read<v_rd_off(D0, 2, 1)>(vb), l3 = tr_read<v_rd_off(D0, 3, 0)>(vb), h3 = tr_read<v_rd_off(D0, 3, 1)>(vb);
  asm volatile("s_waitcnt lgkmcnt(0)" ::: "memory"); __builtin_amdgcn_sched_barrier(0);
#define PKV(Lo, Hi) (bf16x8){Lo[0], Lo[1], Lo[2], Lo[3], Hi[0], Hi[1], Hi[2], Hi[3]}
  od = MFMA32(pa0, PKV(l0, h0), od);
  od = MFMA32(pa1, PKV(l1, h1), od);
  od = MFMA32(pa2, PKV(l2, h2), od);
  od = MFMA32(pa3, PKV(l3, h3), od);
#undef PKV
}

DI void attn_tile(const P2& p, int li, int item, char* smem) {
  const int tid = opaque_tid(), wid = tid >> 6, lane = tid & 63, r32 = lane & 31, hi = lane >> 5;
  const int cm = wid >> 2, rg = wid & 3;
  const int bh = item / 33, qb = item - bh * 33;
  const int b = bh >> 2, h = bh & 3;
  const u16* Qh = (const u16*)(p.ws + OFF_QN) + (size_t)bh * LP * 128;
  const u16* Kh = (const u16*)(p.ws + OFF_KN) + (size_t)bh * LP * 128;
  const u16* Vh = (const u16*)(p.ws + OFF_VN) + (size_t)bh * 128 * LP;
  const float* cst = (const float*)(p.ws + OFF_CST) + li * 8;
  const float lam = cst[0], oml = cst[1];
  const int lq = qb * 128 + rg * 32 + r32;
  bf16x8 qr[4];
#pragma unroll
  for (int d0 = 0; d0 < 4; ++d0) qr[d0] = *(const bf16x8*)(Qh + (size_t)lq * 128 + cm * 64 + d0 * 16 + hi * 8);
  const int sr = tid >> 4, sc = (tid & 15) * 8;
  const int kst0 = KSWZ(sr, sc * 2), kst1 = KSWZ(32 + sr, sc * 2);
  const int vrow = tid >> 3, vch = tid & 7;
  const int vst0 = 16384 + vrow * 128 + ((vch ^ ((vrow >> 1) & 7)) << 4), vst1 = vst0 + 64 * 128;
  int voff[4];
#pragma unroll
  for (int ks = 0; ks < 4; ++ks) voff[ks] = 16384 + r32 * 128 + (((2 * ks + hi) ^ ((r32 >> 1) & 7)) << 4);
  int koff[4];
#pragma unroll
  for (int d0 = 0; d0 < 4; ++d0) koff[d0] = r32 * 256 + ((cm * 128 + d0 * 32 + hi * 16) ^ ((r32 & 15) << 4));
  f32x16 o[4];
#pragma unroll
  for (int d = 0; d < 4; ++d)
#pragma unroll
    for (int r = 0; r < 16; ++r) o[d][r] = 0.f;
  float lsum = 0.f;
  u32x4 gk0, gk1, gv0, gv1;
  f32x16 pA0, pA1, pB0, pB1;
  bf16x8 pa0, pa1, pa2, pa3;
#define SBAR() __builtin_amdgcn_sched_barrier(0)
  const u16* kp_ = Kh + (size_t)sr * 128 + sc; const u16* vp_ = Vh + (size_t)vrow * LP + vch * 8;
#define LOADT(jt) do { gk0 = *(const u32x4*)(kp_); gk1 = *(const u32x4*)(kp_ + 32 * 128); \
    gv0 = *(const u32x4*)(vp_); gv1 = *(const u32x4*)(vp_ + (size_t)64 * LP); kp_ += 64 * 128; vp_ += 64; } while (0)
#define WRITET(ro) do { *(u32x4*)(smem + (ro) + kst0) = gk0; *(u32x4*)(smem + (ro) + kst1) = gk1; \
    *(u32x4*)(smem + (ro) + vst0) = gv0; *(u32x4*)(smem + (ro) + vst1) = gv1; } while (0)
#define QKMM(P0, P1, kb_) do { _Pragma("unroll") for (int d0 = 0; d0 < 4; ++d0) { \
      const bf16x8 b0_ = *(const bf16x8*)((kb_) + koff[d0]); const bf16x8 b1_ = *(const bf16x8*)((kb_) + koff[d0] + 8192); \
      P0 = MFMA32(b0_, qr[d0], P0); P1 = MFMA32(b1_, qr[d0], P1); } } while (0)
  \
  \
#define QKT(P0, P1, ro, MASKED) do { const char* kb_ = smem + (ro); \
    _Pragma("unroll") for (int r = 0; r < 16; ++r) { P0[r] = 0.f; P1[r] = 0.f; } \
    QKMM(P0, P1, kb_); \
    if (MASKED) { _Pragma("unroll") for (int r = 8; r < 16; ++r) P0[r] = -1e30f; _Pragma("unroll") for (int r = 0; r < 16; ++r) P1[r] = -1e30f; } } while (0)
#define EXPS(P0, P1) do { _Pragma("unroll") for (int r = 0; r < 16; ++r) { P0[r] = __builtin_amdgcn_exp2f(P0[r]); P1[r] = __builtin_amdgcn_exp2f(P1[r]); } } while (0)
#define EXPH(P, B0_) do { _Pragma("unroll") for (int r = 0; r < 8; ++r) P[(B0_) + r] = __builtin_amdgcn_exp2f(P[(B0_) + r]); } while (0)
#define PK4(P, BASE, OUT) do { u32x4 w = {cvtpk(P[BASE + 0], P[BASE + 1]), cvtpk(P[BASE + 2], P[BASE + 3]), cvtpk(P[BASE + 4], P[BASE + 5]), cvtpk(P[BASE + 6], P[BASE + 7])}; \
    OUT = *reinterpret_cast<bf16x8*>(&w); } while (0)
#define PACK(P0, P1) do { float s0_ = P0[0], s1_ = P0[1], s2_ = P0[2], s3_ = P0[3]; \
    _Pragma("unroll") for (int r = 4; r < 16; r += 4) { s0_ = addf(s0_, P0[r]); s1_ = addf(s1_, P0[r + 1]); s2_ = addf(s2_, P0[r + 2]); s3_ = addf(s3_, P0[r + 3]); } \
    _Pragma("unroll") for (int r = 0; r < 16; r += 4) { s0_ = addf(s0_, P1[r]); s1_ = addf(s1_, P1[r + 1]); s2_ = addf(s2_, P1[r + 2]); s3_ = addf(s3_, P1[r + 3]); } \
    lsum += (s0_ + s1_) + (s2_ + s3_); \
    PK4(P0, 0, pa0); PK4(P0, 8, pa1); PK4(P1, 0, pa2); PK4(P1, 8, pa3); } while (0)
#define PVD(D0, vb) do { const bf16x8 v0_ = *(const bf16x8*)((vb) + voff[0] + (D0) * 4096), v1_ = *(const bf16x8*)((vb) + voff[1] + (D0) * 4096); \
    const bf16x8 v2_ = *(const bf16x8*)((vb) + voff[2] + (D0) * 4096), v3_ = *(const bf16x8*)((vb) + voff[3] + (D0) * 4096); \
    o[D0] = MFMA32(pa0, v0_, o[D0]); o[D0] = MFMA32(pa1, v1_, o[D0]); o[D0] = MFMA32(pa2, v2_, o[D0]); o[D0] = MFMA32(pa3, v3_, o[D0]); } while (0)
#define STEP(C0, C1, N0, N1, jj, NX, MASKED) do { const int j_ = (jj); \
    if (j_ + 2 < NKT) WRITET(r2); \
    if (j_ + 3 < NKT) LOADT(j_ + 3); \
    SBAR(); \
    if (act) { if (NX) QKT(N0, N1, r1, MASKED); \
    PACK(C0, C1); } \
    SBAR(); \
    if (act) { const char* vb_ = smem + r0; \
      PVD(0, vb_); if (NX) EXPH(N0, 0); \
      PVD(1, vb_); if (NX) EXPH(N0, 8); \
      PVD(2, vb_); if (NX) EXPH(N1, 0); \
      PVD(3, vb_); if (NX) EXPH(N1, 8); } \
    SBAR(); \
    __syncthreads(); \
    { const int t_ = r0; r0 = r1; r1 = r2; r2 = t_; } } while (0)
  int r0 = 0, r1 = 32768, r2 = 65536;
  LOADT(0); WRITET(0); LOADT(1); WRITET(32768); LOADT(2);
  __syncthreads();
  const bool act = (qb < 32) || (rg == 0);
  QKT(pA0, pA1, 0, 0); EXPS(pA0, pA1);
  for (int j = 0; j < NKT - 3; j += 2) {
    STEP(pA0, pA1, pB0, pB1, j, 1, 0);
    STEP(pB0, pB1, pA0, pA1, j + 1, 1, 0);
  }
  STEP(pA0, pA1, pB0, pB1, NKT - 3, 1, 0);
  STEP(pB0, pB1, pA0, pA1, NKT - 2, 1, 1);
  STEP(pA0, pA1, pB0, pB1, NKT - 1, 0, 0);
#undef STEP
#undef PVD
#undef PACK
#undef PK4
#undef EXPS
#undef EXPH
#undef QKT
#undef QKMM
#undef LOADT
#undef WRITET
  lsum += __shfl_xor(lsum, 32);
  float inv = 1.0f / lsum; if (cm == 1) inv *= lam;
  float* li_l = (float*)(smem + 98304) + wid * 32;
  if (hi == 0) li_l[r32] = inv;
  __syncthreads();
  float rl[16];
#pragma unroll
  for (int r = 0; r < 16; ++r) rl[r] = li_l[crow(r, hi)];
#pragma unroll
  for (int d = 0; d < 4; ++d)
#pragma unroll
    for (int r = 0; r < 16; ++r) o[d][r] *= rl[r];
  float* xbuf = (float*)smem + rg * 4096;
  if (cm == 1) {
#pragma unroll
    for (int d = 0; d < 4; ++d)
#pragma unroll
      for (int r = 0; r < 16; ++r) xbuf[crow(r, hi) * 128 + d * 32 + r32] = o[d][r];
  }
  __syncthreads();
  if (cm == 0) {
    u16* gy = (u16*)(p.ws + OFF_GY); const u16* gg = (const u16*)(p.ws + OFF_GG);
    const float* sg = (const float*)(p.ws + OFF_SMALL) + 512 + li * 128;
    const float s0 = sg[r32], s1 = sg[32 + r32], s2 = sg[64 + r32], s3 = sg[96 + r32];
#pragma unroll
    for (int r = 0; r < 16; ++r) {
      const int rr = crow(r, hi);
      const float v0 = o[0][r] - xbuf[rr * 128 + r32], v1 = o[1][r] - xbuf[rr * 128 + 32 + r32];
      const float v2 = o[2][r] - xbuf[rr * 128 + 64 + r32], v3 = o[3][r] - xbuf[rr * 128 + 96 + r32];
      float ss = v0 * v0 + v1 * v1 + v2 * v2 + v3 * v3;
      ss += __shfl_xor(ss, 1); ss += __shfl_xor(ss, 2); ss += __shfl_xor(ss, 4); ss += __shfl_xor(ss, 8); ss += __shfl_xor(ss, 16);
      const float rinv = rsqrtf(ss * (1.0f / 128.f) + EPS) * oml;
      const int l = qb * 128 + rg * 32 + rr;
      if (l < L) {
        const size_t go = ((size_t)(b * L + l)) * DM + 512 + h * 128 + r32;
        u16* g = gy + go; const u16* gi = gg + go;
        g[0]  = f2bf(v0 * rinv * s0 * bf2f(gi[0]));
        g[32] = f2bf(v1 * rinv * s1 * bf2f(gi[32]));
        g[64] = f2bf(v2 * rinv * s2 * bf2f(gi[64]));
        g[96] = f2bf(v3 * rinv * s3 * bf2f(gi[96]));
      }
    }
  }
  __syncthreads();
}

DI void fourier_tile(const P2& p, int li, int item, char* smem) {
  const int tid = opaque_tid(), wid = tid >> 6, lane = tid & 63, fr = lane & 15, fq = lane >> 4;
  const int qd = wid >> 2, wq = wid & 3;
  const int b = item / 36, rem = item - b * 36, g = rem / 9, kt = rem - g * 9;
  const u16* Cm = (const u16*)(p.ws + OFF_CM); const u16* Sm = (const u16*)(p.ws + OFF_SM);
  const u16* uta = (const u16*)(p.ws + OFF_UTA); const u16* utb = (const u16*)(p.ws + OFF_UTB);
  char* As = smem; char* Bs = smem + 65536;
  const int srow = tid >> 3, scc = tid & 7;
  const int soff = srow * 128 + ((scc ^ ((srow >> 1) & 7)) << 4);
  const u16* cgp = Cm + (size_t)(kt * 128 + srow) * KP + scc * 8;
  const u16* sgp = Sm + (size_t)(kt * 128 + srow) * KP + scc * 8;
  const u16* uap = uta + ((size_t)(b * 512 + g * 128 + srow)) * KP + scc * 8;
  const u16* ubp = utb + ((size_t)(b * 512 + g * 128 + srow)) * KP + scc * 8;
  u32x4 raA[4], ruaA[2], rubA[2];
#define FLOAD(ra, rua, rub, k2) do { ra[0] = *(const u32x4*)(cgp + (k2) * 64); ra[1] = *(const u32x4*)(cgp + (size_t)64 * KP + (k2) * 64); \
    ra[2] = *(const u32x4*)(sgp + (k2) * 64); ra[3] = *(const u32x4*)(sgp + (size_t)64 * KP + (k2) * 64); \
    rua[0] = *(const u32x4*)(uap + (k2) * 64); rua[1] = *(const u32x4*)(uap + (size_t)64 * KP + (k2) * 64); \
    rub[0] = *(const u32x4*)(ubp + (k2) * 64); rub[1] = *(const u32x4*)(ubp + (size_t)64 * KP + (k2) * 64); } while (0)
#define FWRITE(ra, rua, rub, bf) do { _Pragma("unroll") for (int i = 0; i < 4; ++i) *(u32x4*)(As + (bf) * 32768 + soff + i * 8192) = ra[i]; \
    _Pragma("unroll") for (int i = 0; i < 2; ++i) { u32x4 ev, ov; \
      _Pragma("unroll") for (int d = 0; d < 4; ++d) { const unsigned ua_ = rua[i][d], ub_ = rub[i][d]; \
        const float al = __uint_as_float(ua_ << 16), ah = __uint_as_float(ua_ & 0xffff0000u); \
        const float bl = __uint_as_float(ub_ << 16), bh_ = __uint_as_float(ub_ & 0xffff0000u); \
        ev[d] = cvtpk(al + bl, ah + bh_); ov[d] = cvtpk(al - bl, ah - bh_); } \
      *(u32x4*)(Bs + (bf) * 32768 + soff + i * 8192) = ev; *(u32x4*)(Bs + (bf) * 32768 + 16384 + soff + i * 8192) = ov; } } while (0)
  f32x4 acc[8][2], acc2[8][2];
#pragma unroll
  for (int m = 0; m < 8; ++m) { acc[m][0] = f32x4{0.f, 0.f, 0.f, 0.f}; acc[m][1] = f32x4{0.f, 0.f, 0.f, 0.f}; acc2[m][0] = f32x4{0.f, 0.f, 0.f, 0.f}; acc2[m][1] = f32x4{0.f, 0.f, 0.f, 0.f}; }
  const bf16x8 sgn = {0, (short)0x8000, 0, (short)0x8000, 0, (short)0x8000, 0, (short)0x8000};
  const int aoff0 = (qd * 128 + fr) * 128, boff0 = (qd * 128 + wq * 32 + fr) * 128, swz = fr >> 1;
  constexpr int NK2 = KP / 64;
#define FCOMP(buf) do { const char* Ab = As + (buf) * 32768; const char* Bb = Bs + (buf) * 32768; \
    _Pragma("unroll") for (int ks = 0; ks < 2; ++ks) { const int co = ((ks * 4 + fq) ^ swz) << 4; \
      const bf16x8 bf0 = *(const bf16x8*)(Bb + boff0 + co), bf1 = *(const bf16x8*)(Bb + boff0 + 2048 + co); \
      const bf16x8 bal0 = bf0 ^ sgn, bal1 = bf1 ^ sgn; \
      _Pragma("unroll") for (int mh = 0; mh < 2; ++mh) { bf16x8 af[4]; \
        _Pragma("unroll") for (int m = 0; m < 4; ++m) af[m] = *(const bf16x8*)(Ab + aoff0 + (mh * 4 + m) * 2048 + co); \
        _Pragma("unroll") for (int m = 0; m < 4; ++m) { acc[mh * 4 + m][0] = MFMA16(af[m], bf0, acc[mh * 4 + m][0]); acc[mh * 4 + m][1] = MFMA16(af[m], bf1, acc[mh * 4 + m][1]); \
          acc2[mh * 4 + m][0] = MFMA16(af[m], bal0, acc2[mh * 4 + m][0]); acc2[mh * 4 + m][1] = MFMA16(af[m], bal1, acc2[mh * 4 + m][1]); } } } } while (0)
  FLOAD(raA, ruaA, rubA, 0); FWRITE(raA, ruaA, rubA, 0);
  __syncthreads();
  for (int k2 = 0; k2 < NK2; ++k2) {
    const int buf = k2 & 1;
    if (k2 + 1 < NK2) FLOAD(raA, ruaA, rubA, k2 + 1);
    FCOMP(buf);
    if (k2 + 1 < NK2) FWRITE(raA, ruaA, rubA, buf ^ 1);
    __syncthreads();
  }
#undef FLOAD
#undef FWRITE
#undef FCOMP
  u16* gy = (u16*)(p.ws + OFF_GY); const u16* gg = (const u16*)(p.ws + OFF_GG);
  const u16* Mb = (const u16*)(p.ws + OFF_MCS) + ((size_t)(li * 4 + g) * 128) * 256;
  const int arow = wid * 16 + fr;
#pragma clang loop unroll(disable)
  for (int pass = 0; pass < 2; ++pass) {
#pragma unroll
    for (int m = 0; m < 8; ++m)
#pragma unroll
      for (int n = 0; n < 2; ++n)
#pragma unroll
        for (int j = 0; j < 4; ++j) {
          const int row = m * 16 + fq * 4 + j, col = qd * 128 + wq * 32 + n * 16 + fr;
          *(u16*)(smem + row * 512 + ((((col >> 3) ^ (row & 15))) << 4) + (col & 7) * 2) = f2bf(acc[m][n][j]);
        }
    __syncthreads();
    f32x4 accP[8], accQ[8];
#pragma unroll
    for (int n = 0; n < 8; ++n) { accP[n] = f32x4{0.f, 0.f, 0.f, 0.f}; accQ[n] = f32x4{0.f, 0.f, 0.f, 0.f}; }
#pragma clang loop unroll(disable)
    for (int ks = 0; ks < 4; ++ks) {
      const bf16x8 a = *(const bf16x8*)(smem + arow * 512 + (((ks * 4 + fq) ^ fr) << 4));
#pragma unroll
      for (int n = 0; n < 8; ++n) {
        const bf16x8 bb = *(const bf16x8*)(Mb + (size_t)(n * 16 + fr) * 256 + ks * 32 + fq * 8);
        accP[n] = MFMA16(a, bb, accP[n]);
      }
    }
#pragma clang loop unroll(disable)
    for (int ks = 4; ks < 8; ++ks) {
      const bf16x8 a = *(const bf16x8*)(smem + arow * 512 + (((ks * 4 + fq) ^ fr) << 4));
#pragma unroll
      for (int n = 0; n < 8; ++n) {
        const bf16x8 bb = *(const bf16x8*)(Mb + (size_t)(n * 16 + fr) * 256 + ks * 32 + fq * 8);
        accQ[n] = MFMA16(a, bb, accQ[n]);
      }
    }
    const float sq = pass ? -1.f : 1.f;
#pragma unroll
    for (int n = 0; n < 8; ++n)
#pragma unroll
      for (int j = 0; j < 4; ++j) {
        const int k0 = kt * 128 + wid * 16 + fq * 4 + j;
        const int kk = pass ? LH - k0 : k0;
        const bool ok = (k0 <= LH / 2) && !(pass && k0 == LH / 2);
        const int e = n * 16 + fr;
        const float P = accP[n][j], Q = accQ[n][j] * sq;
        if (ok) {
          const size_t o1 = ((size_t)(b * L + kk)) * DM + g * 128 + e;
          gy[o1] = f2bf((P + Q) * bf2f(gg[o1]));
          if (kk >= 1 && kk < LH) {
            const size_t o2 = ((size_t)(b * L + (L - kk))) * DM + g * 128 + e;
            gy[o2] = f2bf((P - Q) * bf2f(gg[o2]));
          }
        }
      }
    __syncthreads();
#pragma unroll
    for (int m = 0; m < 8; ++m) { acc[m][0] = acc2[m][0]; acc[m][1] = acc2[m][1]; }
  }
}

constexpr int N_ATT = NB * NH * 33;
constexpr int N_FOU = NB * 4 * 9;
#ifndef REPA
#define REPA 1
#endif
#ifndef REPB
#define REPB 1
#endif
#ifndef REPB_MODE
#define REPB_MODE 0
#endif
DI void phaseB(const P2& p, int li, char* smem, int rep) {
  int* qb_ = (int*)(p.ws + OFF_Q) + (li * 2 + rep) * 256;
  unsigned* bdone = (unsigned*)(p.ws + OFF_Q) + (li * 2) * 256 + 128;
  int* s_item = (int*)(smem + 131072);
  unsigned* sig1 = (unsigned*)(p.ws + OFF_CNT) + 40 + 2 * li + 1;
  const int myx = (int)(__builtin_amdgcn_s_getreg((3 << 11) | 20) & 7u);
  int d = 0;
  for (;;) {
    if (threadIdx.x == 0) {
      int dd = d, idx = -1, xq = 0;
      while (dd < 8) {
        xq = (myx + dd) & 7;
        idx = atomicAdd(qb_ + xq * 16, 1);
        if (idx < 168) break;
        idx = -1; ++dd;
      }
      s_item[0] = idx; s_item[1] = xq; s_item[3] = dd;
    }
    __syncthreads();
    const int idx = __builtin_amdgcn_readfirstlane(s_item[0]), xq = __builtin_amdgcn_readfirstlane(s_item[1]);
    d = __builtin_amdgcn_readfirstlane(s_item[3]);
    __syncthreads();
    if (idx < 0) break;
    const int grp = idx / 42, r = idx - grp * 42;
    int isf, sub;
    if (grp < 3) { const int f0 = (r * 9) / 42, f1 = ((r + 1) * 9) / 42; isf = f1 > f0; sub = isf ? f0 : r - f0; }
    else { isf = r >= 33; sub = isf ? r - 33 : r; }
    const int pair = xq + 8 * grp, bat = pair >> 2;
    if (bat == NB - 1) wait_sig(sig1, 96u);
    if (!isf) attn_tile(p, li, pair * 33 + sub, smem);
    else fourier_tile(p, li, bat * 36 + (pair & 3) * 9 + sub, smem);
  }
}

__global__ void __launch_bounds__(512) mega(Params p, int ph_begin, int ph_end) {
  __shared__ __attribute__((aligned(16))) char smem[131072 + 64 + 1024];
  if (ph_begin == 0) {
    phase0(p);
    if (ph_end > 1) cg::this_grid().sync();
  }
  P2 q; q.out = p.out; q.ws = p.ws; q.x = p.x; q.meta = p.meta;
  unsigned nbar = 0;
#pragma clang loop unroll(disable)
  for (int ph = (ph_begin < 1 ? 1 : ph_begin); ph < ph_end; ++ph) {
    const int li = (ph - 1) / 3, s = (ph - 1) % 3;
    unsigned* sig0 = (unsigned*)(q.ws + OFF_CNT) + 40 + 2 * li;
    unsigned* sig1 = sig0 + 1;
    const int bx = blockIdx.x;
    { int mode = -1, lc = li;
      if (s == 2) mode = 0; else if (s == 1 && li > 0 && bx < 4) { mode = 1; lc = li - 1; }
      if (mode >= 0) phaseC(q, lc, smem, mode, bx, sig0); }
    { int mode = -1;
      if (s == 0) mode = 0; else if (s == 1 && bx >= 4 && bx < 16) { mode = 1; wait_sig(sig0, li > 0 ? 32u : 0u); }
      if (mode >= 0) phaseA(q, li, smem, mode, bx - 4, sig1); }
    if (s == 1) { for (int rep = 0; rep < REPB; ++rep) phaseB(q, li, smem, rep); }
    if (ph + 1 < ph_end) { ++nbar; grid_barrier((unsigned*)(q.ws + OFF_CNT) + 32, nbar * gridDim.x); }
  }
}

extern "C" void kernel_launch(void* const* d_in, const int* in_sizes, int n_in, void* d_out, int out_size, void* d_ws, size_t ws_size, hipStream_t stream) {
  if (ws_size < WS_END) { fprintf(stderr, "workspace too small: %zu < %zu\n", ws_size, (size_t)WS_END); return; }
  Params p{};
  p.x = (const float*)d_in[0]; p.meta = (const float*)d_in[1]; p.norm_gain = (const float*)d_in[2]; p.w_in = (const float*)d_in[3];
  p.w_f = (const float*)d_in[4]; p.qg = (const float*)d_in[5]; p.kg = (const float*)d_in[6]; p.lq1 = (const float*)d_in[7];
  p.lk1 = (const float*)d_in[8]; p.lq2 = (const float*)d_in[9]; p.lk2 = (const float*)d_in[10]; p.subln = (const float*)d_in[11];
  p.w_out = (const float*)d_in[12]; p.out = (float*)d_out; p.ws = (char*)d_ws;
  constexpr int NPH = 1 + 3 * DEPTH;
#if MULTI_LAUNCH
  for (int ph = 0; ph < NPH; ++ph) hipLaunchKernelGGL(mega, dim3(256), dim3(512), 0, stream, p, ph, ph + 1);
#else
  static int grid_blocks = 0;
  if (!grid_blocks) {
    int dev = 0, cus = 0, per_cu = 0;
    hipGetDevice(&dev);
    hipDeviceGetAttribute(&cus, hipDeviceAttributeMultiprocessorCount, dev);
    hipOccupancyMaxActiveBlocksPerMultiprocessor(&per_cu, mega, 512, 0);
    if (per_cu < 1) per_cu = 1;
    grid_blocks = cus * 1;
  }
  int b0 = 0, b1 = NPH;
  void* args[] = {&p, &b0, &b1};
  hipError_t e = hipLaunchCooperativeKernel((void*)mega, dim3(grid_blocks), dim3(512), args, 0, stream);
  if (e != hipSuccess) fprintf(stderr, "cooperative launch failed: %s (grid %d)\n", hipGetErrorString(e), grid_blocks);
#endif
}
```

```cpp
#include <hip/hip_runtime.h>
#include <hip/hip_bf16.h>
#include <hip/hip_cooperative_groups.h>
#include <cstdio>
#include <cstdint>
namespace cg = cooperative_groups;

#ifndef MULTI_LAUNCH
#define MULTI_LAUNCH 0
#endif

typedef unsigned short u16;
using bf16x8 = __attribute__((ext_vector_type(8))) short;
using s16x4  = __attribute__((ext_vector_type(4))) short;
using f32x4  = __attribute__((ext_vector_type(4))) float;
using f32x16 = __attribute__((ext_vector_type(16))) float;
using u32x4  = __attribute__((ext_vector_type(4))) unsigned;
using u32x2  = __attribute__((ext_vector_type(2))) unsigned;

constexpr int NB = 8, SEQ = 4096, NMETA = 16, L = 4112, DM = 1024, DEPTH = 4;
constexpr int R = NB * L;
constexpr int RP = 33024;
constexpr int INW = 3072;
constexpr int NH = 4;
constexpr int LP = 4224;
constexpr int LH = 2056;
constexpr int KROWS = 2176;
constexpr int KP = 2112;
constexpr int NKT = 65;
constexpr float EPS = 1e-6f;

constexpr size_t al256(size_t x) { return (x + 255) / 256 * 256; }
constexpr size_t OFF_META = 0;
constexpr size_t OFF_XB   = al256(OFF_META + (size_t)NB * NMETA * DM * 4);
constexpr size_t OFF_GY   = al256(OFF_XB + (size_t)RP * DM * 2);
constexpr size_t OFF_QN   = al256(OFF_GY + (size_t)RP * DM * 2);
constexpr size_t QKV_BYTES = (size_t)NB * NH * LP * 128 * 2;
constexpr size_t OFF_KN   = al256(OFF_QN + QKV_BYTES);
constexpr size_t OFF_VN   = al256(OFF_KN + QKV_BYTES);
constexpr size_t OFF_WIN  = al256(OFF_VN + QKV_BYTES);
constexpr size_t OFF_WOUT = al256(OFF_WIN + (size_t)DEPTH * INW * DM * 2);
constexpr size_t OFF_CM   = al256(OFF_WOUT + (size_t)DEPTH * DM * DM * 2);
constexpr size_t OFF_SM   = al256(OFF_CM + (size_t)KROWS * KP * 2);
constexpr size_t OFF_MCS  = al256(OFF_SM + (size_t)KROWS * KP * 2);
constexpr size_t OFF_UTA  = al256(OFF_MCS + (size_t)DEPTH * 4 * 128 * 256 * 2);
constexpr size_t OFF_UTB  = al256(OFF_UTA + (size_t)NB * 512 * KP * 2);
constexpr size_t OFF_RSS  = al256(OFF_UTB + (size_t)NB * 512 * KP * 2);
constexpr size_t OFF_ROPE = al256(OFF_RSS + (size_t)RP * 16 * 4);
constexpr size_t OFF_CST  = al256(OFF_ROPE + (size_t)L * 16 * 4);
constexpr size_t OFF_SMALL = al256(OFF_CST + 256);
constexpr size_t OFF_CNT  = al256(OFF_SMALL + 4096);
constexpr size_t OFF_GG   = al256(OFF_CNT + 256);
constexpr size_t OFF_Q    = al256(OFF_GG + (size_t)RP * DM * 2);
constexpr size_t WS_END   = OFF_Q + 4 * 2 * 16 * 16 * 4;

struct Params {
  const float *x, *meta, *norm_gain, *w_in, *w_f, *qg, *kg, *lq1, *lk1, *lq2, *lk2, *subln, *w_out;
  float* out;
  char* ws;
};

struct P2 { float* out; char* ws; const float* x; const float* meta; };
__device__ __forceinline__ void grid_barrier(unsigned* bar, unsigned target) {
  asm volatile("s_waitcnt vmcnt(0) lgkmcnt(0)" ::: "memory");
  __syncthreads();
  if (threadIdx.x == 0) {
    __builtin_amdgcn_fence(__ATOMIC_RELEASE, "agent");
    asm volatile("s_waitcnt vmcnt(0)" ::: "memory");
    __hip_atomic_fetch_add(bar, 1u, __ATOMIC_RELAXED, __HIP_MEMORY_SCOPE_AGENT);
    while (__hip_atomic_load(bar, __ATOMIC_RELAXED, __HIP_MEMORY_SCOPE_AGENT) < target) __builtin_amdgcn_s_sleep(2);
    __builtin_amdgcn_fence(__ATOMIC_ACQUIRE, "agent");
    asm volatile("s_waitcnt vmcnt(0)" ::: "memory");
  }
  __syncthreads();
}
#define DI __device__ __forceinline__
#define MFMA16(a, b, c) __builtin_amdgcn_mfma_f32_16x16x32_bf16((a), (b), (c), 0, 0, 0)
#define MFMA32(a, b, c) __builtin_amdgcn_mfma_f32_32x32x16_bf16((a), (b), (c), 0, 0, 0)

using bf16v2 = __attribute__((ext_vector_type(2))) __bf16;
DI void wait_sig(unsigned* sig, unsigned target) {
  if (threadIdx.x == 0) {
    while (__hip_atomic_load(sig, __ATOMIC_RELAXED, __HIP_MEMORY_SCOPE_AGENT) < target) __builtin_amdgcn_s_sleep(2);
    __builtin_amdgcn_fence(__ATOMIC_ACQUIRE, "agent");
    asm volatile("s_waitcnt vmcnt(0)" ::: "memory");
  }
  __syncthreads();
}
DI unsigned cvtpk(float lo, float hi) { bf16v2 v; v[0] = (__bf16)lo; v[1] = (__bf16)hi; return __builtin_bit_cast(unsigned, v); }
DI u16 f2bf(float x) { return (u16)(cvtpk(x, x) & 0xffffu); }
DI float bf2f(u16 v) { return __uint_as_float(((unsigned)v) << 16); }
DI float wave_sum(float v) { for (int o = 32; o; o >>= 1) v += __shfl_xor(v, o); return v; }
DI float wave_max(float v) { for (int o = 32; o; o >>= 1) v = fmaxf(v, __shfl_xor(v, o)); return v; }
DI float addf(float a, float b) { float r; asm volatile("v_add_f32 %0, %1, %2" : "=v"(r) : "v"(a), "v"(b)); return r; }
DI int crow(int r, int hi) { return (r & 3) + 8 * (r >> 2) + 4 * hi; }

DI float* hres_row(const Params& p, int row) {
  const int b = row / L, l = row - b * L;
  return l < NMETA ? (float*)(p.ws + OFF_META) + (size_t)(b * NMETA + l) * DM
                   : p.out + ((size_t)b * SEQ + (l - NMETA)) * DM;
}

DI void row_bl(int row, int b0, int& b, int& l) { b = b0 + ((row >= (b0 + 1) * L) ? 1 : 0); l = row - b * L; }
#define CBAR() asm volatile("" ::: "memory")
DI int opaque_tid() { int t = threadIdx.x; asm volatile("" : "+v"(t)); return t; }

__device__ const double INVF[8] = {1.0, 0.19392274474868576, 0.03760603093086393, 0.007292664737217109, 0.001414213562373095, 0.0002742481756762073, 5.318295896944988e-05, 1.031338537721246e-05};

DI void phase0(const Params& p) {
  const int tid = threadIdx.x, gtid = blockIdx.x * 512 + tid, gsz = gridDim.x * 512;
  const int lane = tid & 63, gw = gtid >> 6, nw = gsz >> 6;
  u16* xb = (u16*)(p.ws + OFF_XB);
  float* rss = (float*)(p.ws + OFF_RSS);
  for (int row = gw; row < RP; row += nw) {
    if (row < R) {
      const int b = row / L, l = row - b * L;
      const float* src = l < NMETA ? p.meta + (size_t)l * DM : p.x + ((size_t)b * SEQ + (l - NMETA)) * DM;
      float ss = 0.f;
#pragma unroll
      for (int i = 0; i < 4; ++i) {
        const f32x4 v = *(const f32x4*)(src + i * 256 + lane * 4);
        ss += v[0] * v[0] + v[1] * v[1] + v[2] * v[2] + v[3] * v[3];
        u32x2 o = {cvtpk(v[0], v[1]), cvtpk(v[2], v[3])};
        *(u32x2*)(xb + (size_t)row * DM + i * 256 + lane * 4) = o;
      }
      ss = wave_sum(ss);
      if (lane == 0) rss[(size_t)row * 16] = ss;
    } else {
#pragma unroll
      for (int i = 0; i < 4; ++i) { u32x2 o = {0u, 0u}; *(u32x2*)(xb + (size_t)row * DM + i * 256 + lane * 4) = o; }
      if (lane == 0) rss[(size_t)row * 16] = 1024.f;
    }
    if (lane >= 1 && lane < 16) rss[(size_t)row * 16 + lane] = 0.f;
  }
  {
    u16* WinT = (u16*)(p.ws + OFF_WIN);
    for (long it = gtid; it < (long)DEPTH * 128 * INW; it += gsz) {
      const int nd = (int)(it % INW); const long t2 = it / INW; const int kc = (int)(t2 % 128), li = (int)(t2 / 128);
      const int c1 = nd & 255;
      const int n = (nd & ~255) + ((c1 >> 5) & 3) * 64 + (c1 >> 7) * 32 + (c1 & 31);
      const float* w = p.w_in + ((size_t)li * DM + kc * 8) * INW + n;
      const float* g = p.norm_gain + li * DM + kc * 8;
      float v[8];
#pragma unroll
      for (int j = 0; j < 8; ++j) v[j] = w[(size_t)j * INW] * g[j];
      u32x4 o = {cvtpk(v[0], v[1]), cvtpk(v[2], v[3]), cvtpk(v[4], v[5]), cvtpk(v[6], v[7])};
      *(u32x4*)(WinT + ((size_t)li * INW + nd) * DM + kc * 8) = o;
    }
  }
  {
    u16* WoutT = (u16*)(p.ws + OFF_WOUT);
    for (long it = gtid; it < (long)DEPTH * 128 * DM; it += gsz) {
      const int n = (int)(it % DM); const long t2 = it / DM; const int kc = (int)(t2 % 128), li = (int)(t2 / 128);
      const float* w = p.w_out + ((size_t)li * DM + kc * 8) * DM + n;
      float v[8];
#pragma unroll
      for (int j = 0; j < 8; ++j) v[j] = w[(size_t)j * DM];
      u32x4 o = {cvtpk(v[0], v[1]), cvtpk(v[2], v[3]), cvtpk(v[4], v[5]), cvtpk(v[6], v[7])};
      *(u32x4*)(WoutT + ((size_t)li * DM + n) * DM + kc * 8) = o;
    }
  }
  {
    u16* Cm = (u16*)(p.ws + OFF_CM); u16* Sm = (u16*)(p.ws + OFF_SM);
    for (int it = gtid; it < KROWS * (KP / 8); it += gsz) {
      const int k = it / (KP / 8), j0 = (it % (KP / 8)) * 8;
      float c[8], s[8];
#pragma unroll
      for (int jj = 0; jj < 8; ++jj) {
        const int j = j0 + jj;
        const bool valid = (k <= LH) && (j <= LH);
        const int m = valid ? (k * j) % L : 0;
        const float rev = (float)m / (float)L;
        c[jj] = valid ? __builtin_amdgcn_cosf(rev) : 0.f;
        s[jj] = valid ? __builtin_amdgcn_sinf(rev) : 0.f;
      }
      u32x4 oc = {cvtpk(c[0], c[1]), cvtpk(c[2], c[3]), cvtpk(c[4], c[5]), cvtpk(c[6], c[7])};
      u32x4 os = {cvtpk(s[0], s[1]), cvtpk(s[2], s[3]), cvtpk(s[4], s[5]), cvtpk(s[6], s[7])};
      *(u32x4*)(Cm + (size_t)k * KP + j0) = oc;
      *(u32x4*)(Sm + (size_t)k * KP + j0) = os;
    }
  }
  {
    u16* Mcs = (u16*)(p.ws + OFF_MCS);
    const float norm = 1.0f / sqrtf((float)L * 128.f);
    for (int it = gtid; it < DEPTH * 4 * 256 * 128; it += gsz) {
      const int e = it & 127, cc = (it >> 7) & 255, lg = it >> 15;
      const int c = cc & 127; const bool isS = cc >= 128;
      const float* wf = p.w_f + (size_t)lg * 128 * 128 + e;
      float acc = 0.f;
      for (int m = 0; m < 128; ++m) {
        const float rev = (float)((m * c) & 127) * (1.0f / 128.f);
        const float t = isS ? __builtin_amdgcn_sinf(rev) : __builtin_amdgcn_cosf(rev);
        acc += t * wf[m * 128];
      }
      acc *= isS ? -norm : norm;
      Mcs[((size_t)lg * 128 + e) * 256 + cc] = f2bf(acc);
    }
  }
  {
    u16* uta = (u16*)(p.ws + OFF_UTA); u16* utb = (u16*)(p.ws + OFF_UTB);
    for (int it = gtid; it < NB * 512 * 64; it += gsz) {
      const int row = it >> 6, i = it & 63;
      if (i < 55) { uta[(size_t)row * KP + 2057 + i] = 0; utb[(size_t)row * KP + 2057 + i] = 0; }
      else if (i == 55) utb[(size_t)row * KP] = 0;
      else if (i == 56) utb[(size_t)row * KP + LH] = 0;
    }
  }
  {
    u16* qn = (u16*)(p.ws + OFF_QN); u16* kn = (u16*)(p.ws + OFF_KN); u16* vt = (u16*)(p.ws + OFF_VN);
    for (int it = gtid; it < NB * NH * (LP - L) * 16; it += gsz) {
      const int ch = it & 15, rr = (it >> 4) % (LP - L), bh = (it >> 4) / (LP - L);
      const size_t off = ((size_t)bh * LP + L + rr) * 128 + ch * 8;
      u32x4 z = {0u, 0u, 0u, 0u};
      *(u32x4*)(qn + off) = z; *(u32x4*)(kn + off) = z;
    }
    for (int it = gtid; it < NB * NH * 128 * ((LP - L) / 8); it += gsz) {
      const int ch = it % ((LP - L) / 8), row = it / ((LP - L) / 8);
      u32x4 z = {0u, 0u, 0u, 0u};
      *(u32x4*)(vt + (size_t)row * LP + L + ch * 8) = z;
    }
  }
  {
    float* rope = (float*)(p.ws + OFF_ROPE);
    for (int it = gtid; it < L * 8; it += gsz) {
      const int l = it >> 3, i = it & 7;
      double rv = (double)l * INVF[i] * 0.15915494309189535;
      rv -= floor(rv);
      const float r = (float)rv;
      rope[l * 16 + i] = __builtin_amdgcn_cosf(r);
      rope[l * 16 + 8 + i] = __builtin_amdgcn_sinf(r);
    }
  }
  if (blockIdx.x == 0) {
    const int wid = tid >> 6;
    if (wid < DEPTH) {
      const int li = wid;
      float a = p.lq1[li * 64 + lane] * p.lk1[li * 64 + lane];
      float bq = p.lq2[li * 64 + lane] * p.lk2[li * 64 + lane];
      a = wave_sum(a); bq = wave_sum(bq);
      const float gq = wave_max(fabsf(p.qg[li * 64 + lane]));
      const float gk = wave_max(fabsf(p.kg[li * 64 + lane]));
      if (lane == 0) {
        float* cst = (float*)(p.ws + OFF_CST) + li * 8;
        const float lam_init = 0.8f - 0.6f * expf(-0.3f * (float)li);
        cst[0] = expf(a) - expf(bq) + lam_init;
        cst[1] = 1.0f - lam_init;
        cst[2] = (8.0f * gq * gk * 1.01f + 0.05f) * 1.4426950408889634f;
      }
    }
    if (tid < 64) ((int*)(p.ws + OFF_CNT))[tid] = 0;
    for (int i = tid; i < 4 * 2 * 16 * 16; i += 512) ((int*)(p.ws + OFF_Q))[i] = 0;
    float* sm = (float*)(p.ws + OFF_SMALL);
    if (tid < 256) { sm[tid] = p.qg[tid]; sm[256 + tid] = p.kg[tid]; }
    sm[512 + tid] = p.subln[tid];
  }
}

namespace pg8 {
#define PG8_LAS __attribute__((address_space(3)))
constexpr int BM = 256, BK = 64, HALF = 128, HTB = HALF * BK * 2, NXCD = 8, WGM = 8;
DI int lds_byte(int r, int c) { const int st = (r >> 4) * 2 + (c >> 5), rr = r & 15, cc = c & 31, ob = rr * 64 + cc * 2; return st * 1024 + (ob ^ (((ob >> 9) & 1) << 5)); }
DI void stage_rc(int b, int& R, int& C) { const int st = b / 1024, sb = b % 1024, swz = sb ^ (((sb >> 9) & 1) << 5); R = (st >> 1) * 16 + swz / 64; C = (st & 1) * 32 + (swz % 64) / 2; }
DI int perm32(int rho) { const int n = rho >> 4, i = rho & 15; return 8 * (i >> 2) + 4 * n + (i & 3); }
struct Unit { int pm, pn; };
struct Gemm { const u16* A; const u16* Bt; int M, N, K; };
struct StaticOrder {
  int nM, nN, nwg, G, c;
  DI void init(int M, int N, int G_, int c_) { nM = M / BM; nN = N / BM; nwg = nM * nN; G = G_; c = c_; }
  DI bool next(int i, Unit& u) const {
    const long Lx = (long)i * G + c; if (Lx >= nwg) return false;
    int wgid = (int)Lx; { const int q = nwg / NXCD, r = nwg % NXCD, xcd = wgid % NXCD, off = wgid / NXCD; wgid = (xcd < r ? xcd * (q + 1) : r * (q + 1) + (xcd - r) * q) + off; }
    const int nig = WGM * nN, gid = wgid / nig, fm = gid * WGM, gsz = (nM - fm) < WGM ? (nM - fm) : WGM;
    u.pm = fm + ((wgid % nig) % gsz); u.pn = (wgid % nig) / gsz; return true;
  }
  DI void done(int) const {}
};
struct Order {
  int mode; StaticOrder st; int pm, pn; unsigned* sig;
  const unsigned* bready;
  DI void a_ready(const Unit& u) const {
    if (bready == nullptr) return;
    if (threadIdx.x < 64) {
      const int b1 = (u.pm * 256) / L; int b2 = (u.pm * 256 + 255) / L; if (b2 > NB - 1) b2 = NB - 1;
      while ((unsigned)__builtin_amdgcn_readfirstlane(__hip_atomic_load(bready + b1 * 16, __ATOMIC_RELAXED, __HIP_MEMORY_SCOPE_AGENT)) < 200u ||
             (unsigned)__builtin_amdgcn_readfirstlane(__hip_atomic_load(bready + b2 * 16, __ATOMIC_RELAXED, __HIP_MEMORY_SCOPE_AGENT)) < 200u) __builtin_amdgcn_s_sleep(2);
      __builtin_amdgcn_fence(__ATOMIC_ACQUIRE, "agent");
      asm volatile("s_waitcnt vmcnt(0)" ::: "memory");
    }
    asm volatile("" ::: "memory"); __builtin_amdgcn_s_barrier(); asm volatile("" ::: "memory");
  }
  DI bool next(int i, Unit& u) const { if (mode == 0) return st.next(i, u); if (i != 0) return false; u.pm = pm; u.pn = pn; return true; }
  DI void done(int lane) const {
    if (mode == 1) {
      asm volatile("s_waitcnt vmcnt(0)" ::: "memory");
      __builtin_amdgcn_fence(__ATOMIC_RELEASE, "agent");
      asm volatile("s_waitcnt vmcnt(0)" ::: "memory");
      if (lane == 0) __hip_atomic_fetch_add(sig, 1u, __ATOMIC_RELAXED, __HIP_MEMORY_SCOPE_AGENT);
    }
  }
};
template <class Epi, class Sched>
DI void gemm_phase(PG8_LAS unsigned char* lds, const Gemm g, const Sched& S, const Epi& E) {
  const int tid = opaque_tid(), wid = __builtin_amdgcn_readfirstlane(tid >> 6), lane = tid & 63, wr = wid >> 2, wc = wid & 3, fr = lane & 15, fq = lane >> 4;
  const int K = g.K, nt = K / BK;
  unsigned voffA[2], voffB[2];
#pragma unroll
  for (int i = 0; i < 2; ++i) { int R_, C_; stage_rc(tid * 16 + i * 8192, R_, C_); const int Rb = (R_ & ~31) + perm32(R_ & 31);
    voffA[i] = (unsigned)(R_ * K + C_) * 2u; voffB[i] = (unsigned)(Rb * K + C_) * 2u; }
  const size_t kstep = (size_t)(BK * 2);
  const size_t hstep = (size_t)HALF * K * 2;
  const size_t tstep = 2 * hstep;
  const unsigned ldsw = (unsigned)wid * 1024u;
  const int aoff = lds_byte(wr * 64 + fr, fq * 8), boff = lds_byte(wc * 32 + fr, fq * 8);
#define PG8_SA(b, h) (((b) * 2 + (h)) * HTB)
#define PG8_SB(b, h) ((4 + (b) * 2 + (h)) * HTB)
#define PG8_STAGE(bufoff, gbase, voff) do { _Pragma("unroll") for (int _i = 0; _i < 2; ++_i) \
    __builtin_amdgcn_global_load_lds((const unsigned*)((const char*)(gbase) + (voff)[_i]), (PG8_LAS unsigned*)(lds + (bufoff) + ldsw + _i * 8192), 16, 0, 0); } while (0)
#define PG8_LDA(dst, b, h) do { _Pragma("unroll") for (int m = 0; m < 4; ++m) _Pragma("unroll") for (int k = 0; k < 2; ++k) dst[m][k] = *(const PG8_LAS bf16x8*)(lds + PG8_SA(b, h) + aoff + m * 2048 + k * 1024); } while (0)
#define PG8_LDB(dst, b, h) do { _Pragma("unroll") for (int n = 0; n < 2; ++n) _Pragma("unroll") for (int k = 0; k < 2; ++k) dst[n][k] = *(const PG8_LAS bf16x8*)(lds + PG8_SB(b, h) + boff + n * 2048 + k * 1024); } while (0)
#define PG8_MMA(ai, bj, At, Bt) do { __builtin_amdgcn_s_setprio(1); _Pragma("unroll") for (int m = 0; m < 4; ++m) _Pragma("unroll") for (int n = 0; n < 2; ++n) _Pragma("unroll") for (int k = 0; k < 2; ++k) \
    acc[ai][bj][m][n] = __builtin_amdgcn_mfma_f32_16x16x32_bf16(Bt[n][k], At[m][k], acc[ai][bj][m][n], 0, 0, 0); __builtin_amdgcn_s_setprio(0); } while (0)
#define PG8_WAIT_V(n) asm volatile("s_waitcnt vmcnt(" #n ")" ::: "memory")
#define PG8_WAIT_L(n) asm volatile("s_waitcnt lgkmcnt(" #n ")" ::: "memory")
#define PG8_BAR __builtin_amdgcn_s_barrier()
#define PG8_SCHED __builtin_amdgcn_sched_barrier(0)
  Unit cur, nxt; int ui = 0;
  if (!S.next(0, cur)) return;
  f32x4 acc[2][2][4][2];
#pragma unroll
  for (int a = 0; a < 2; ++a)
#pragma unroll
    for (int b = 0; b < 2; ++b)
#pragma unroll
      for (int m = 0; m < 4; ++m)
#pragma unroll
        for (int n = 0; n < 2; ++n) acc[a][b][m][n] = (f32x4){0.f, 0.f, 0.f, 0.f};
  bf16x8 At[4][2], B0[2][2], B1[2][2];
  const char* cA = (const char*)g.A + (size_t)cur.pm * tstep; const char* cB = (const char*)g.Bt + (size_t)cur.pn * tstep;
  S.a_ready(cur);
  PG8_STAGE(PG8_SB(0, 0), cB, voffB); PG8_STAGE(PG8_SA(0, 0), cA, voffA); PG8_STAGE(PG8_SB(0, 1), cB + hstep, voffB); PG8_STAGE(PG8_SA(0, 1), cA + hstep, voffA);
  if (wr == 1) PG8_BAR;
  PG8_WAIT_V(4); PG8_BAR;
  PG8_STAGE(PG8_SB(1, 0), cB + kstep, voffB); PG8_STAGE(PG8_SA(1, 0), cA + kstep, voffA); PG8_STAGE(PG8_SB(1, 1), cB + hstep + kstep, voffB);
  PG8_WAIT_V(6); PG8_BAR;
  for (;;) {
    const bool has_next = S.next(ui + 1, nxt);
    const char* nA = has_next ? (const char*)g.A + (size_t)nxt.pm * tstep : cA; const char* nB = has_next ? (const char*)g.Bt + (size_t)nxt.pn * tstep : cB;
    for (int t = 0; t < nt; t += 2) {
      const bool last = (t == nt - 2);
      const char* a1 = cA + (size_t)(t + 1) * kstep;
      const char* a2 = last ? nA : cA + (size_t)(t + 2) * kstep; const char* b2 = last ? nB : cB + (size_t)(t + 2) * kstep;
      const char* a3 = a2 + kstep; const char* b3 = b2 + kstep;
      if (last && has_next) S.a_ready(nxt);
      PG8_LDB(B0, 0, 0); PG8_SCHED; PG8_LDA(At, 0, 0); PG8_STAGE(PG8_SA(1, 1), a1 + hstep, voffA);
      PG8_WAIT_L(8); PG8_BAR; PG8_WAIT_L(0); PG8_MMA(0, 0, At, B0); PG8_BAR; PG8_SCHED;
      PG8_LDB(B1, 0, 1); PG8_STAGE(PG8_SB(0, 0), b2, voffB);
      PG8_BAR; PG8_WAIT_L(0); PG8_MMA(0, 1, At, B1); PG8_BAR;
      PG8_LDA(At, 0, 1); PG8_STAGE(PG8_SA(0, 0), a2, voffA);
      PG8_BAR; PG8_WAIT_L(0); PG8_MMA(1, 0, At, B0); PG8_BAR; PG8_SCHED;
      PG8_STAGE(PG8_SB(0, 1), b2 + hstep, voffB);
      PG8_WAIT_V(6); PG8_BAR; PG8_MMA(1, 1, At, B1); PG8_BAR;
      PG8_LDB(B0, 1, 0); PG8_SCHED; PG8_LDA(At, 1, 0); PG8_STAGE(PG8_SA(0, 1), a2 + hstep, voffA);
      PG8_WAIT_L(8); PG8_BAR; PG8_WAIT_L(0); PG8_MMA(0, 0, At, B0); PG8_BAR; PG8_SCHED;
      PG8_LDB(B1, 1, 1); PG8_STAGE(PG8_SB(1, 0), b3, voffB);
      PG8_BAR; PG8_WAIT_L(0); PG8_MMA(0, 1, At, B1); PG8_BAR;
      PG8_LDA(At, 1, 1); PG8_STAGE(PG8_SA(1, 0), a3, voffA);
      PG8_BAR; PG8_WAIT_L(0); PG8_MMA(1, 0, At, B0); PG8_BAR; PG8_SCHED;
      PG8_STAGE(PG8_SB(1, 1), b3 + hstep, voffB);
      PG8_WAIT_V(6); PG8_BAR; PG8_MMA(1, 1, At, B1); PG8_BAR;
    }
    E(acc, cur, wr, wc, fr, fq);
    S.done(lane);
    if (!has_next) break;
#pragma unroll
    for (int a = 0; a < 2; ++a)
#pragma unroll
      for (int b = 0; b < 2; ++b)
#pragma unroll
        for (int m = 0; m < 4; ++m)
#pragma unroll
          for (int n = 0; n < 2; ++n) acc[a][b][m][n] = (f32x4){0.f, 0.f, 0.f, 0.f};
    cur = nxt; cA = nA; cB = nB; ++ui;
  }
  PG8_WAIT_V(0);
  if (wr == 0) PG8_BAR;
  PG8_BAR;
#undef PG8_SA
#undef PG8_SB
#undef PG8_STAGE
#undef PG8_LDA
#undef PG8_LDB
#undef PG8_MMA
#undef PG8_WAIT_V
#undef PG8_WAIT_L
#undef PG8_BAR
#undef PG8_SCHED
}
}

DI float row_scale(const float* rsp, int row) {
  const f32x4* rp = (const f32x4*)(rsp + (size_t)row * 16);
  const f32x4 a0 = rp[0], a1 = rp[1], a2 = rp[2], a3 = rp[3];
  const float s = ((a0[0] + a0[1]) + (a0[2] + a0[3])) + ((a1[0] + a1[1]) + (a1[2] + a1[3])) + ((a2[0] + a2[1]) + (a2[2] + a2[3])) + ((a3[0] + a3[1]) + (a3[2] + a3[3]));
  return rsqrtf(s * (1.0f / DM) + EPS);
}

struct EpiA {
  char* ws; int li;
  DI void operator()(const f32x4 (&acc)[2][2][4][2], const pg8::Unit& u, int wr, int wc, int fr, int fq) const {
    const int mt = u.pm, nt = u.pn;
    const float* rsp = (const float*)(ws + OFF_RSS);
    const int b0 = (mt * 256) / L;
    const int rbase = mt * 256 + wr * 64 + fr;
    float scv[2][4];
    {
      const int lane_ = fq * 16 + fr, r0_ = mt * 256 + wr * 64 + lane_;
      const float so0 = row_scale(rsp, r0_ < R ? r0_ : 0), so1 = row_scale(rsp, r0_ + 128 < R ? r0_ + 128 : 0);
#pragma unroll
      for (int m = 0; m < 4; ++m) { scv[0][m] = __shfl(so0, m * 16 + fr); scv[1][m] = __shfl(so1, m * 16 + fr); }
    }
    if (nt < 2) {
      u16* uta = (u16*)(ws + OFF_UTA); u16* utb = (u16*)(ws + OFF_UTB);
      const int chb = nt * 256 + wc * 64 + 8 * fq;
#pragma unroll
      for (int ai = 0; ai < 2; ++ai)
#pragma unroll
        for (int m = 0; m < 4; ++m) {
          const int row = rbase + ai * 128 + m * 16;
          if (row < R) {
            int b, l; row_bl(row, b0, b, l);
            const float sc = scv[ai][m];
            u16* dst = (l <= LH) ? uta + (size_t)b * 512 * KP + l : utb + (size_t)b * 512 * KP + (L - l);
#pragma unroll
            for (int bj = 0; bj < 2; ++bj)
#pragma unroll
              for (int n = 0; n < 2; ++n)
#pragma unroll
                for (int j = 0; j < 4; ++j) dst[(size_t)(chb + bj * 32 + n * 4 + j) * KP] = f2bf(acc[ai][bj][m][n][j] * sc);
          }
          CBAR();
        }
    } else if (nt < 6) {
      const bool isq = nt < 4;
      const int gi = (isq ? nt - 2 : nt - 4) * 4 + wc;
      const int h = gi >> 1, comp = gi & 1;
      const float* gain = (const float*)(ws + OFF_SMALL) + (isq ? 0 : 256) + li * 64 + 8 * fq;
      const f32x4 g00 = *(const f32x4*)(gain), g01 = *(const f32x4*)(gain + 4), g10 = *(const f32x4*)(gain + 32), g11 = *(const f32x4*)(gain + 36);
      const float qsc = isq ? 0.125f * 1.4426950408889634f : 1.0f;
      const float* rope = (const float*)(ws + OFF_ROPE);
      u16* dbase = (u16*)(ws + (isq ? OFF_QN : OFF_KN));
#pragma unroll
      for (int ai = 0; ai < 2; ++ai)
#pragma unroll
        for (int m = 0; m < 4; ++m) {
          const int row = rbase + ai * 128 + m * 16;
          const bool valid = row < R;
          const int rowc = valid ? row : 0;
          int b, l; row_bl(rowc, valid ? b0 : 0, b, l);
          const float sc = scv[ai][m];
          f32x4 v00 = acc[ai][0][m][0] * sc, v01 = acc[ai][0][m][1] * sc, v10 = acc[ai][1][m][0] * sc, v11 = acc[ai][1][m][1] * sc;
          float ss = 0.f;
#pragma unroll
          for (int j = 0; j < 4; ++j) ss += v00[j] * v00[j] + v01[j] * v01[j] + v10[j] * v10[j] + v11[j] * v11[j];
          ss += __shfl_xor(ss, 16); ss += __shfl_xor(ss, 32);
          const float rq = rsqrtf(ss * (1.0f / 64.f) + EPS) * qsc;
          v00 = v00 * g00 * rq; v01 = v01 * g01 * rq; v10 = v10 * g10 * rq; v11 = v11 * g11 * rq;
          const f32x4 c0 = *(const f32x4*)(rope + l * 16), c1 = *(const f32x4*)(rope + l * 16 + 4), s0 = *(const f32x4*)(rope + l * 16 + 8), s1 = *(const f32x4*)(rope + l * 16 + 12);
          f32x4 p0, p1;
#pragma unroll
          for (int j = 0; j < 4; ++j) { p0[j] = __shfl_xor(v00[j], 16); p1[j] = __shfl_xor(v01[j], 16); }
          if (fq == 0) { v00 = v00 * c0 - p0 * s0; v01 = v01 * c1 - p1 * s1; }
          else if (fq == 1) { v00 = v00 * c0 + p0 * s0; v01 = v01 * c1 + p1 * s1; }
          if (valid) {
            u16* dst = dbase + (((size_t)(b * NH + h)) * LP + l) * 128 + comp * 64 + 8 * fq;
            u32x4 w0 = {cvtpk(v00[0], v00[1]), cvtpk(v00[2], v00[3]), cvtpk(v01[0], v01[1]), cvtpk(v01[2], v01[3])};
            u32x4 w1 = {cvtpk(v10[0], v10[1]), cvtpk(v10[2], v10[3]), cvtpk(v11[0], v11[1]), cvtpk(v11[2], v11[3])};
            *(u32x4*)(dst) = w0; *(u32x4*)(dst + 32) = w1;
          }
          CBAR();
        }
    } else if (nt < 8) {
      const int cv = (nt - 6) * 256 + wc * 64;
      const int h = cv >> 7, dv = (cv & 127) + 8 * fq;
      u16* vt = (u16*)(ws + OFF_VN);
#pragma unroll
      for (int ai = 0; ai < 2; ++ai)
#pragma unroll
        for (int m = 0; m < 4; ++m) {
          const int row = rbase + ai * 128 + m * 16;
          if (row < R) {
            int b, l; row_bl(row, b0, b, l);
            const float sc = scv[ai][m];
            const int o = l & 15;
            const int pos = (l & ~15) + 8 * ((o >> 2) & 1) + 4 * (o >> 3) + (o & 3);
            u16* dst = vt + ((size_t)(b * NH + h) * 128 + dv) * LP + pos;
#pragma unroll
            for (int bj = 0; bj < 2; ++bj)
#pragma unroll
              for (int n = 0; n < 2; ++n)
#pragma unroll
                for (int j = 0; j < 4; ++j) dst[(size_t)(bj * 32 + n * 4 + j) * LP] = f2bf(acc[ai][bj][m][n][j] * sc);
          }
          CBAR();
        }
    } else {
      u16* gg = (u16*)(ws + OFF_GG);
      const int cgc = (nt - 8) * 256 + wc * 64 + 8 * fq;
#pragma unroll
      for (int ai = 0; ai < 2; ++ai)
#pragma unroll
        for (int m = 0; m < 4; ++m) {
          const int row = rbase + ai * 128 + m * 16;
          if (row < R) {
            const float sc = scv[ai][m];
            u16* dst = gg + (size_t)row * DM + cgc;
#pragma unroll
            for (int bj = 0; bj < 2; ++bj) {
              f32x4 a = acc[ai][bj][m][0] * sc, c = acc[ai][bj][m][1] * sc;
#pragma unroll
              for (int j = 0; j < 4; ++j) { a[j] = a[j] * __builtin_amdgcn_rcpf(1.0f + __expf(-a[j])); c[j] = c[j] * __builtin_amdgcn_rcpf(1.0f + __expf(-c[j])); }
              u32x4 w = {cvtpk(a[0], a[1]), cvtpk(a[2], a[3]), cvtpk(c[0], c[1]), cvtpk(c[2], c[3])};
              *(u32x4*)(dst + bj * 32) = w;
            }
          }
          CBAR();
        }
    }
  }
};
DI void phaseA(const P2& p, int li, char* smem, int mode, int pn, unsigned* sig) {
  pg8::Gemm g; g.A = (const u16*)(p.ws + OFF_XB); g.Bt = (const u16*)(p.ws + OFF_WIN) + (size_t)li * INW * DM; g.M = RP; g.N = INW; g.K = DM;
  pg8::Order S; S.mode = mode; S.st.init(RP - 256, INW, gridDim.x, blockIdx.x); S.pm = RP / 256 - 1; S.pn = pn; S.sig = sig; S.bready = nullptr;
  EpiA E; E.ws = p.ws; E.li = li;
  pg8::gemm_phase((PG8_LAS unsigned char*)smem, g, S, E);
}

struct EpiC {
  char* ws; float* out; const float* x; const float* meta; int li;
  DI void operator()(const f32x4 (&acc)[2][2][4][2], const pg8::Unit& u, int wr, int wc, int fr, int fq) const {
    const int mt = u.pm, nt = u.pn;
    const bool last = (li == DEPTH - 1), first = (li == 0);
    u16* xb = (u16*)(ws + OFF_XB);
    float* rsp = (float*)(ws + OFF_RSS);
    const int b0 = (mt * 256) / L;
    const int rbase = mt * 256 + wr * 64 + fr;
    const int cb = nt * 256 + wc * 32 + 8 * fq;
#pragma unroll
    for (int ai = 0; ai < 2; ++ai)
#pragma unroll
      for (int m = 0; m < 4; ++m) {
        const int row = rbase + ai * 128 + m * 16;
        const bool valid = row < R;
        float ss = 0.f;
        if (valid) {
          int b, l; row_bl(row, b0, b, l);
          u16* xr = xb + (size_t)row * DM + cb;
          const float* xin = (l < NMETA ? meta + (size_t)l * DM : x + ((size_t)b * SEQ + (l - NMETA)) * DM) + cb;
          float* orow = out + ((size_t)b * SEQ + (l - NMETA)) * DM + cb;
#pragma unroll
          for (int bj = 0; bj < 2; ++bj) {
            f32x4 a, c;
            if (first) { a = *(const f32x4*)(xin + bj * 128); c = *(const f32x4*)(xin + bj * 128 + 4); }
            else { const u32x4 w = *(const u32x4*)(xr + bj * 128);
              a = f32x4{__uint_as_float(w[0] << 16), __uint_as_float(w[0] & 0xffff0000u), __uint_as_float(w[1] << 16), __uint_as_float(w[1] & 0xffff0000u)};
              c = f32x4{__uint_as_float(w[2] << 16), __uint_as_float(w[2] & 0xffff0000u), __uint_as_float(w[3] << 16), __uint_as_float(w[3] & 0xffff0000u)}; }
            a += acc[ai][bj][m][0]; c += acc[ai][bj][m][1];
            if (last) { if (l >= NMETA) { *(f32x4*)(orow + bj * 128) = a; *(f32x4*)(orow + bj * 128 + 4) = c; } }
            else { u32x4 w = {cvtpk(a[0], a[1]), cvtpk(a[2], a[3]), cvtpk(c[0], c[1]), cvtpk(c[2], c[3])}; *(u32x4*)(xr + bj * 128) = w; }
#pragma unroll
            for (int j = 0; j < 4; ++j) ss += a[j] * a[j] + c[j] * c[j];
          }
        }
        ss += __shfl_xor(ss, 16); ss += __shfl_xor(ss, 32);
        if (valid && !last && fq == 0) rsp[(size_t)row * 16 + nt * 4 + wc] = ss;
        if (m == 1 || m == 3) CBAR();
      }
  }
};
DI void phaseC(const P2& p, int li, char* smem, int mode, int pn, unsigned* sig) {
  pg8::Gemm g; g.A = (const u16*)(p.ws + OFF_GY); g.Bt = (const u16*)(p.ws + OFF_WOUT) + (size_t)li * DM * DM; g.M = RP; g.N = DM; g.K = DM;
  pg8::Order S; S.mode = mode; S.st.init(li == DEPTH - 1 ? RP : RP - 256, DM, gridDim.x, blockIdx.x); S.pm = RP / 256 - 1; S.pn = pn; S.sig = sig;
  S.bready = nullptr;
  EpiC E; E.ws = p.ws; E.out = p.out; E.x = p.x; E.meta = p.meta; E.li = li;
  pg8::gemm_phase((PG8_LAS unsigned char*)smem, g, S, E);
}

#define KSWZ(row, colB) ((row) * 256 + ((colB) ^ (((row) & 15) << 4)))
DI int v_st(int k, int c) { const int kk = (k & ~0xC) | ((k & 4) << 1) | ((k & 8) >> 1); return ((kk >> 3) * 4 + (c >> 5)) * 512 + ((kk & 7) * 32 + (c & 31)) * 2; }
DI int v_rd_base(int lane) { return ((lane & 3) << 3) | (((lane >> 2) & 3) << 6) | (((lane >> 4) & 1) << 5) | (((lane >> 5) & 1) << 8); }
constexpr int v_rd_off(int d0, int ks, int half) { return d0 * 512 + ks * 4096 + half * 2048; }
template <int OFF> DI s16x4 tr_read(int vb) {
  s16x4 r; asm volatile("ds_read_b64_tr_b16 %0, %1 offset:%2" : "=&v"(r) : "v"(vb), "i"(OFF) : "memory"); return r;
}
template <int D0> DI void pv_one(f32x16& od, int vb, bf16x8 pa0, bf16x8 pa1, bf16x8 pa2, bf16x8 pa3) {
  const s16x4 l0 = tr_read<v_rd_off(D0, 0, 0)>(vb), h0 = tr_read<v_rd_off(D0, 0, 1)>(vb), l1 = tr_read<v_rd_off(D0, 1, 0)>(vb), h1 = tr_read<v_rd_off(D0, 1, 1)>(vb);
  const s16x4 l2 = tr_read<v_rd_off(D0, 2, 0)>(vb), h2 = tr_read<v_rd_off(D0, 2, 1)>(vb), l3 = tr_read<v_rd_off(D0, 3, 0)>(vb), h3 = tr_read<v_rd_off(D0, 3, 1)>(vb);
  asm volatile("s_waitcnt lgkmcnt(0)" ::: "memory"); __builtin_amdgcn_sched_barrier(0);
#define PKV(Lo, Hi) (bf16x8){Lo[0], Lo[1], Lo[2], Lo[3], Hi[0], Hi[1], Hi[2], Hi[3]}
  od = MFMA32(pa0, PKV(l0, h0), od);
  od = MFMA32(pa1, PKV(l1, h1), od);
  od = MFMA32(pa2, PKV(l2, h2), od);
  od = MFMA32(pa3, PKV(l3, h3), od);
#undef PKV
}

DI void attn_tile(const P2& p, int li, int item, char* smem) {
  const int tid = opaque_tid(), wid = tid >> 6, lane = tid & 63, r32 = lane & 31, hi = lane >> 5;
  const int cm = wid >> 2, rg = wid & 3;
  const int bh = item / 33, qb = item - bh * 33;
  const int b = bh >> 2, h = bh & 3;
  const u16* Qh = (const u16*)(p.ws + OFF_QN) + (size_t)bh * LP * 128;
  const u16* Kh = (const u16*)(p.ws + OFF_KN) + (size_t)bh * LP * 128;
  const u16* Vh = (const u16*)(p.ws + OFF_VN) + (size_t)bh * 128 * LP;
  const float* cst = (const float*)(p.ws + OFF_CST) + li * 8;
  const float lam = cst[0], oml = cst[1];
  const int lq = qb * 128 + rg * 32 + r32;
  bf16x8 qr[4];
#pragma unroll
  for (int d0 = 0; d0 < 4; ++d0) qr[d0] = *(const bf16x8*)(Qh + (size_t)lq * 128 + cm * 64 + d0 * 16 + hi * 8);
  const int sr = tid >> 4, sc = (tid & 15) * 8;
  const int kst0 = KSWZ(sr, sc * 2), kst1 = KSWZ(32 + sr, sc * 2);
  const int vrow = tid >> 3, vch = tid & 7;
  const int vst0 = 16384 + vrow * 128 + ((vch ^ ((vrow >> 1) & 7)) << 4), vst1 = vst0 + 64 * 128;
  int voff[4];
#pragma unroll
  for (int ks = 0; ks < 4; ++ks) voff[ks] = 16384 + r32 * 128 + (((2 * ks + hi) ^ ((r32 >> 1) & 7)) << 4);
  int koff[4];
#pragma unroll
  for (int d0 = 0; d0 < 4; ++d0) koff[d0] = r32 * 256 + ((cm * 128 + d0 * 32 + hi * 16) ^ ((r32 & 15) << 4));
  f32x16 o[4];
#pragma unroll
  for (int d = 0; d < 4; ++d)
#pragma unroll
    for (int r = 0; r < 16; ++r) o[d][r] = 0.f;
  float lsum = 0.f;
  u32x4 gk0, gk1, gv0, gv1;
  f32x16 pA0, pA1, pB0, pB1;
  bf16x8 pa0, pa1, pa2, pa3;
#define SBAR() __builtin_amdgcn_sched_barrier(0)
  const u16* kp_ = Kh + (size_t)sr * 128 + sc; const u16* vp_ = Vh + (size_t)vrow * LP + vch * 8;
#define LOADT(jt) do { gk0 = *(const u32x4*)(kp_); gk1 = *(const u32x4*)(kp_ + 32 * 128); \
    gv0 = *(const u32x4*)(vp_); gv1 = *(const u32x4*)(vp_ + (size_t)64 * LP); kp_ += 64 * 128; vp_ += 64; } while (0)
#define WRITET(ro) do { *(u32x4*)(smem + (ro) + kst0) = gk0; *(u32x4*)(smem + (ro) + kst1) = gk1; \
    *(u32x4*)(smem + (ro) + vst0) = gv0; *(u32x4*)(smem + (ro) + vst1) = gv1; } while (0)
#define QKMM(P0, P1, kb_) do { _Pragma("unroll") for (int d0 = 0; d0 < 4; ++d0) { \
      const bf16x8 b0_ = *(const bf16x8*)((kb_) + koff[d0]); const bf16x8 b1_ = *(const bf16x8*)((kb_) + koff[d0] + 8192); \
      P0 = MFMA32(b0_, qr[d0], P0); P1 = MFMA32(b1_, qr[d0], P1); } } while (0)
  \
  \
#define QKT(P0, P1, ro, MASKED) do { const char* kb_ = smem + (ro); \
    _Pragma("unroll") for (int r = 0; r < 16; ++r) { P0[r] = 0.f; P1[r] = 0.f; } \
    QKMM(P0, P1, kb_); \
    if (MASKED) { _Pragma("unroll") for (int r = 8; r < 16; ++r) P0[r] = -1e30f; _Pragma("unroll") for (int r = 0; r < 16; ++r) P1[r] = -1e30f; } } while (0)
#define EXPS(P0, P1) do { _Pragma("unroll") for (int r = 0; r < 16; ++r) { P0[r] = __builtin_amdgcn_exp2f(P0[r]); P1[r] = __builtin_amdgcn_exp2f(P1[r]); } } while (0)
#define EXPH(P, B0_) do { _Pragma("unroll") for (int r = 0; r < 8; ++r) P[(B0_) + r] = __builtin_amdgcn_exp2f(P[(B0_) + r]); } while (0)
#define PK4(P, BASE, OUT) do { u32x4 w = {cvtpk(P[BASE + 0], P[BASE + 1]), cvtpk(P[BASE + 2], P[BASE + 3]), cvtpk(P[BASE + 4], P[BASE + 5]), cvtpk(P[BASE + 6], P[BASE + 7])}; \
    OUT = *reinterpret_cast<bf16x8*>(&w); } while (0)
#define PACK(P0, P1) do { float s0_ = P0[0], s1_ = P0[1], s2_ = P0[2], s3_ = P0[3]; \
    _Pragma("unroll") for (int r = 4; r < 16; r += 4) { s0_ = addf(s0_, P0[r]); s1_ = addf(s1_, P0[r + 1]); s2_ = addf(s2_, P0[r + 2]); s3_ = addf(s3_, P0[r + 3]); } \
    _Pragma("unroll") for (int r = 0; r < 16; r += 4) { s0_ = addf(s0_, P1[r]); s1_ = addf(s1_, P1[r + 1]); s2_ = addf(s2_, P1[r + 2]); s3_ = addf(s3_, P1[r + 3]); } \
    lsum += (s0_ + s1_) + (s2_ + s3_); \
    PK4(P0, 0, pa0); PK4(P0, 8, pa1); PK4(P1, 0, pa2); PK4(P1, 8, pa3); } while (0)
#define PVD(D0, vb) do { const bf16x8 v0_ = *(const bf16x8*)((vb) + voff[0] + (D0) * 4096), v1_ = *(const bf16x8*)((vb) + voff[1] + (D0) * 4096); \
    const bf16x8 v2_ = *(const bf16x8*)((vb) + voff[2] + (D0) * 4096), v3_ = *(const bf16x8*)((vb) + voff[3] + (D0) * 4096); \
    o[D0] = MFMA32(pa0, v0_, o[D0]); o[D0] = MFMA32(pa1, v1_, o[D0]); o[D0] = MFMA32(pa2, v2_, o[D0]); o[D0] = MFMA32(pa3, v3_, o[D0]); } while (0)
#define STEP(C0, C1, N0, N1, jj, NX, MASKED) do { const int j_ = (jj); \
    if (j_ + 2 < NKT) WRITET(r2); \
    if (j_ + 3 < NKT) LOADT(j_ + 3); \
    SBAR(); \
    if (act) { if (NX) QKT(N0, N1, r1, MASKED); \
    PACK(C0, C1); } \
    SBAR(); \
    if (act) { const char* vb_ = smem + r0; \
      PVD(0, vb_); if (NX) EXPH(N0, 0); \
      PVD(1, vb_); if (NX) EXPH(N0, 8); \
      PVD(2, vb_); if (NX) EXPH(N1, 0); \
      PVD(3, vb_); if (NX) EXPH(N1, 8); } \
    SBAR(); \
    __syncthreads(); \
    { const int t_ = r0; r0 = r1; r1 = r2; r2 = t_; } } while (0)
  int r0 = 0, r1 = 32768, r2 = 65536;
  LOADT(0); WRITET(0); LOADT(1); WRITET(32768); LOADT(2);
  __syncthreads();
  const bool act = (qb < 32) || (rg == 0);
  QKT(pA0, pA1, 0, 0); EXPS(pA0, pA1);
  for (int j = 0; j < NKT - 3; j += 2) {
    STEP(pA0, pA1, pB0, pB1, j, 1, 0);
    STEP(pB0, pB1, pA0, pA1, j + 1, 1, 0);
  }
  STEP(pA0, pA1, pB0, pB1, NKT - 3, 1, 0);
  STEP(pB0, pB1, pA0, pA1, NKT - 2, 1, 1);
  STEP(pA0, pA1, pB0, pB1, NKT - 1, 0, 0);
#undef STEP
#undef PVD
#undef PACK
#undef PK4
#undef EXPS
#undef EXPH
#undef QKT
#undef QKMM
#undef LOADT
#undef WRITET
  lsum += __shfl_xor(lsum, 32);
  float inv = 1.0f / lsum; if (cm == 1) inv *= lam;
  float* li_l = (float*)(smem + 98304) + wid * 32;
  if (hi == 0) li_l[r32] = inv;
  __syncthreads();
  float rl[16];
#pragma unroll
  for (int r = 0; r < 16; ++r) rl[r] = li_l[crow(r, hi)];
#pragma unroll
  for (int d = 0; d < 4; ++d)
#pragma unroll
    for (int r = 0; r < 16; ++r) o[d][r] *= rl[r];
  float* xbuf = (float*)smem + rg * 4096;
  if (cm == 1) {
#pragma unroll
    for (int d = 0; d < 4; ++d)
#pragma unroll
      for (int r = 0; r < 16; ++r) xbuf[crow(r, hi) * 128 + d * 32 + r32] = o[d][r];
  }
  __syncthreads();
  if (cm == 0) {
    u16* gy = (u16*)(p.ws + OFF_GY); const u16* gg = (const u16*)(p.ws + OFF_GG);
    const float* sg = (const float*)(p.ws + OFF_SMALL) + 512 + li * 128;
    const float s0 = sg[r32], s1 = sg[32 + r32], s2 = sg[64 + r32], s3 = sg[96 + r32];
#pragma unroll
    for (int r = 0; r < 16; ++r) {
      const int rr = crow(r, hi);
      const float v0 = o[0][r] - xbuf[rr * 128 + r32], v1 = o[1][r] - xbuf[rr * 128 + 32 + r32];
      const float v2 = o[2][r] - xbuf[rr * 128 + 64 + r32], v3 = o[3][r] - xbuf[rr * 128 + 96 + r32];
      float ss = v0 * v0 + v1 * v1 + v2 * v2 + v3 * v3;
      ss += __shfl_xor(ss, 1); ss += __shfl_xor(ss, 2); ss += __shfl_xor(ss, 4); ss += __shfl_xor(ss, 8); ss += __shfl_xor(ss, 16);
      const float rinv = rsqrtf(ss * (1.0f / 128.f) + EPS) * oml;
      xbuf[rr * 128 + r32] = v0 * rinv * s0; xbuf[rr * 128 + 32 + r32] = v1 * rinv * s1;
      xbuf[rr * 128 + 64 + r32] = v2 * rinv * s2; xbuf[rr * 128 + 96 + r32] = v3 * rinv * s3;
    }
    asm volatile("s_waitcnt lgkmcnt(0)" ::: "memory");
#pragma unroll
    for (int it = 0; it < 8; ++it) {
      const int rw = it * 4 + (lane >> 4), c8 = (lane & 15) * 8;
      const int l = qb * 128 + rg * 32 + rw;
      const f32x4 a = *(const f32x4*)(xbuf + rw * 128 + c8), c = *(const f32x4*)(xbuf + rw * 128 + c8 + 4);
      if (l < L) {
        const size_t go = ((size_t)(b * L + l)) * DM + 512 + h * 128 + c8;
        const u32x4 gt = *(const u32x4*)(gg + go);
        u32x4 w;
        w[0] = cvtpk(a[0] * __uint_as_float(gt[0] << 16), a[1] * __uint_as_float(gt[0] & 0xffff0000u));
        w[1] = cvtpk(a[2] * __uint_as_float(gt[1] << 16), a[3] * __uint_as_float(gt[1] & 0xffff0000u));
        w[2] = cvtpk(c[0] * __uint_as_float(gt[2] << 16), c[1] * __uint_as_float(gt[2] & 0xffff0000u));
        w[3] = cvtpk(c[2] * __uint_as_float(gt[3] << 16), c[3] * __uint_as_float(gt[3] & 0xffff0000u));
        *(u32x4*)(gy + go) = w;
      }
    }
  }
  __syncthreads();
}

DI void fourier_tile(const P2& p, int li, int item, char* smem) {
  const int tid = opaque_tid(), wid = tid >> 6, lane = tid & 63, fr = lane & 15, fq = lane >> 4;
  const int qd = wid >> 2, wq = wid & 3;
  const int b = item / 36, rem = item - b * 36, g = rem / 9, kt = rem - g * 9;
  const u16* Cm = (const u16*)(p.ws + OFF_CM); const u16* Sm = (const u16*)(p.ws + OFF_SM);
  const u16* uta = (const u16*)(p.ws + OFF_UTA); const u16* utb = (const u16*)(p.ws + OFF_UTB);
  char* As = smem; char* Bs = smem + 65536;
  const int srow = tid >> 3, scc = tid & 7;
  const int soff = srow * 128 + ((scc ^ ((srow >> 1) & 7)) << 4);
  const u16* cgp = Cm + (size_t)(kt * 128 + srow) * KP + scc * 8;
  const u16* sgp = Sm + (size_t)(kt * 128 + srow) * KP + scc * 8;
  const u16* uap = uta + ((size_t)(b * 512 + g * 128 + srow)) * KP + scc * 8;
  const u16* ubp = utb + ((size_t)(b * 512 + g * 128 + srow)) * KP + scc * 8;
  u32x4 raA[4], ruaA[2], rubA[2];
#define FLOAD(ra, rua, rub, k2) do { ra[0] = *(const u32x4*)(cgp + (k2) * 64); ra[1] = *(const u32x4*)(cgp + (size_t)64 * KP + (k2) * 64); \
    ra[2] = *(const u32x4*)(sgp + (k2) * 64); ra[3] = *(const u32x4*)(sgp + (size_t)64 * KP + (k2) * 64); \
    rua[0] = *(const u32x4*)(uap + (k2) * 64); rua[1] = *(const u32x4*)(uap + (size_t)64 * KP + (k2) * 64); \
    rub[0] = *(const u32x4*)(ubp + (k2) * 64); rub[1] = *(const u32x4*)(ubp + (size_t)64 * KP + (k2) * 64); } while (0)
#define FWRITE(ra, rua, rub, bf) do { _Pragma("unroll") for (int i = 0; i < 4; ++i) *(u32x4*)(As + (bf) * 32768 + soff + i * 8192) = ra[i]; \
    _Pragma("unroll") for (int i = 0; i < 2; ++i) { u32x4 ev, ov; \
      _Pragma("unroll") for (int d = 0; d < 4; ++d) { const unsigned ua_ = rua[i][d], ub_ = rub[i][d]; \
        const float al = __uint_as_float(ua_ << 16), ah = __uint_as_float(ua_ & 0xffff0000u); \
        const float bl = __uint_as_float(ub_ << 16), bh_ = __uint_as_float(ub_ & 0xffff0000u); \
        ev[d] = cvtpk(al + bl, ah + bh_); ov[d] = cvtpk(al - bl, ah - bh_); } \
      *(u32x4*)(Bs + (bf) * 32768 + soff + i * 8192) = ev; *(u32x4*)(Bs + (bf) * 32768 + 16384 + soff + i * 8192) = ov; } } while (0)
  f32x4 acc[8][2], acc2[8][2];
#pragma unroll
  for (int m = 0; m < 8; ++m) { acc[m][0] = f32x4{0.f, 0.f, 0.f, 0.f}; acc[m][1] = f32x4{0.f, 0.f, 0.f, 0.f}; acc2[m][0] = f32x4{0.f, 0.f, 0.f, 0.f}; acc2[m][1] = f32x4{0.f, 0.f, 0.f, 0.f}; }
  const bf16x8 sgn = {0, (short)0x8000, 0, (short)0x8000, 0, (short)0x8000, 0, (short)0x8000};
  const int aoff0 = (qd * 128 + fr) * 128, boff0 = (qd * 128 + wq * 32 + fr) * 128, swz = fr >> 1;
  constexpr int NK2 = KP / 64;
#define FCOMP(buf) do { const char* Ab = As + (buf) * 32768; const char* Bb = Bs + (buf) * 32768; \
    _Pragma("unroll") for (int ks = 0; ks < 2; ++ks) { const int co = ((ks * 4 + fq) ^ swz) << 4; \
      const bf16x8 bf0 = *(const bf16x8*)(Bb + boff0 + co), bf1 = *(const bf16x8*)(Bb + boff0 + 2048 + co); \
      const bf16x8 bal0 = bf0 ^ sgn, bal1 = bf1 ^ sgn; \
      _Pragma("unroll") for (int mh = 0; mh < 2; ++mh) { bf16x8 af[4]; \
        _Pragma("unroll") for (int m = 0; m < 4; ++m) af[m] = *(const bf16x8*)(Ab + aoff0 + (mh * 4 + m) * 2048 + co); \
        _Pragma("unroll") for (int m = 0; m < 4; ++m) { acc[mh * 4 + m][0] = MFMA16(af[m], bf0, acc[mh * 4 + m][0]); acc[mh * 4 + m][1] = MFMA16(af[m], bf1, acc[mh * 4 + m][1]); \
          acc2[mh * 4 + m][0] = MFMA16(af[m], bal0, acc2[mh * 4 + m][0]); acc2[mh * 4 + m][1] = MFMA16(af[m], bal1, acc2[mh * 4 + m][1]); } } } } while (0)
  FLOAD(raA, ruaA, rubA, 0); FWRITE(raA, ruaA, rubA, 0);
  __syncthreads();
  for (int k2 = 0; k2 < NK2; ++k2) {
    const int buf = k2 & 1;
    if (k2 + 1 < NK2) FLOAD(raA, ruaA, rubA, k2 + 1);
    FCOMP(buf);
    if (k2 + 1 < NK2) FWRITE(raA, ruaA, rubA, buf ^ 1);
    __syncthreads();
  }
#undef FLOAD
#undef FWRITE
#undef FCOMP
  u16* gy = (u16*)(p.ws + OFF_GY); const u16* gg = (const u16*)(p.ws + OFF_GG);
  const u16* Mb = (const u16*)(p.ws + OFF_MCS) + ((size_t)(li * 4 + g) * 128) * 256;
  const int arow = wid * 16 + fr;
#pragma clang loop unroll(disable)
  for (int pass = 0; pass < 2; ++pass) {
#pragma unroll
    for (int m = 0; m < 8; ++m)
#pragma unroll
      for (int n = 0; n < 2; ++n)
#pragma unroll
        for (int j = 0; j < 4; ++j) {
          const int row = m * 16 + fq * 4 + j, col = qd * 128 + wq * 32 + n * 16 + fr;
          *(u16*)(smem + row * 512 + ((((col >> 3) ^ (row & 15))) << 4) + (col & 7) * 2) = f2bf(acc[m][n][j]);
        }
    __syncthreads();
    f32x4 accP[8], accQ[8];
#pragma unroll
    for (int n = 0; n < 8; ++n) { accP[n] = f32x4{0.f, 0.f, 0.f, 0.f}; accQ[n] = f32x4{0.f, 0.f, 0.f, 0.f}; }
#pragma clang loop unroll(disable)
    for (int ks = 0; ks < 4; ++ks) {
      const bf16x8 a = *(const bf16x8*)(smem + arow * 512 + (((ks * 4 + fq) ^ fr) << 4));
#pragma unroll
      for (int n = 0; n < 8; ++n) {
        const bf16x8 bb = *(const bf16x8*)(Mb + (size_t)(n * 16 + fr) * 256 + ks * 32 + fq * 8);
        accP[n] = MFMA16(a, bb, accP[n]);
      }
    }
#pragma clang loop unroll(disable)
    for (int ks = 4; ks < 8; ++ks) {
      const bf16x8 a = *(const bf16x8*)(smem + arow * 512 + (((ks * 4 + fq) ^ fr) << 4));
#pragma unroll
      for (int n = 0; n < 8; ++n) {
        const bf16x8 bb = *(const bf16x8*)(Mb + (size_t)(n * 16 + fr) * 256 + ks * 32 + fq * 8);
        accQ[n] = MFMA16(a, bb, accQ[n]);
      }
    }
    const float sq = pass ? -1.f : 1.f;
    float* stg = (float*)(smem + 65536 + wid * 8192);
#pragma unroll
    for (int half = 0; half < 2; ++half) {
      const float sh = half ? -sq : sq;
#pragma unroll
      for (int n = 0; n < 8; ++n)
#pragma unroll
        for (int j = 0; j < 4; ++j) stg[(fq * 4 + j) * 128 + n * 16 + fr] = accP[n][j] + sh * accQ[n][j];
      asm volatile("s_waitcnt lgkmcnt(0)" ::: "memory");
#pragma unroll
      for (int it = 0; it < 4; ++it) {
        const int rw = it * 4 + (lane >> 4), c8 = (lane & 15) * 8;
        const int k0 = kt * 128 + wid * 16 + rw;
        const int kk = pass ? LH - k0 : k0;
        bool ok = (k0 <= LH / 2) && !(pass && k0 == LH / 2);
        if (half) ok = ok && (kk >= 1) && (kk < LH);
        const int orow = half ? L - kk : kk;
        const f32x4 a = *(const f32x4*)(stg + rw * 128 + c8), c = *(const f32x4*)(stg + rw * 128 + c8 + 4);
        if (ok) {
          const size_t o1 = ((size_t)(b * L + orow)) * DM + g * 128 + c8;
          const u32x4 gt = *(const u32x4*)(gg + o1);
          u32x4 w;
          w[0] = cvtpk(a[0] * __uint_as_float(gt[0] << 16), a[1] * __uint_as_float(gt[0] & 0xffff0000u));
          w[1] = cvtpk(a[2] * __uint_as_float(gt[1] << 16), a[3] * __uint_as_float(gt[1] & 0xffff0000u));
          w[2] = cvtpk(c[0] * __uint_as_float(gt[2] << 16), c[1] * __uint_as_float(gt[2] & 0xffff0000u));
          w[3] = cvtpk(c[2] * __uint_as_float(gt[3] << 16), c[3] * __uint_as_float(gt[3] & 0xffff0000u));
          *(u32x4*)(gy + o1) = w;
        }
      }
      asm volatile("s_waitcnt lgkmcnt(0)" ::: "memory");
    }
    __syncthreads();
#pragma unroll
    for (int m = 0; m < 8; ++m) { acc[m][0] = acc2[m][0]; acc[m][1] = acc2[m][1]; }
  }
}

constexpr int N_ATT = NB * NH * 33;
constexpr int N_FOU = NB * 4 * 9;
#ifndef REPA
#define REPA 1
#endif
#ifndef REPB
#define REPB 1
#endif
#ifndef REPB_MODE
#define REPB_MODE 0
#endif
DI void phaseB(const P2& p, int li, char* smem, int rep) {
  int* qb_ = (int*)(p.ws + OFF_Q) + (li * 2 + rep) * 256;
  unsigned* bdone = (unsigned*)(p.ws + OFF_Q) + (li * 2) * 256 + 128;
  int* s_item = (int*)(smem + 131072);
  unsigned* sig1 = (unsigned*)(p.ws + OFF_CNT) + 40 + 2 * li + 1;
  const int myx = (int)(__builtin_amdgcn_s_getreg((3 << 11) | 20) & 7u);
  int d = 0;
  for (;;) {
    if (threadIdx.x == 0) {
      int dd = d, idx = -1, xq = 0;
      while (dd < 8) {
        xq = (myx + dd) & 7;
        idx = atomicAdd(qb_ + xq * 16, 1);
        if (idx < 168) break;
        idx = -1; ++dd;
      }
      s_item[0] = idx; s_item[1] = xq; s_item[3] = dd;
    }
    __syncthreads();
    const int idx = __builtin_amdgcn_readfirstlane(s_item[0]), xq = __builtin_amdgcn_readfirstlane(s_item[1]);
    d = __builtin_amdgcn_readfirstlane(s_item[3]);
    __syncthreads();
    if (idx < 0) break;
    const int grp = idx / 42, r = idx - grp * 42;
    int isf, sub;
    if (grp < 3) { const int f0 = (r * 9) / 42, f1 = ((r + 1) * 9) / 42; isf = f1 > f0; sub = isf ? f0 : r - f0; }
    else { isf = r >= 33; sub = isf ? r - 33 : r; }
    const int pair = xq + 8 * grp, bat = pair >> 2;
    if (bat == NB - 1) wait_sig(sig1, 96u);
    if (!isf) attn_tile(p, li, pair * 33 + sub, smem);
    else fourier_tile(p, li, bat * 36 + (pair & 3) * 9 + sub, smem);
  }
}

__global__ void __launch_bounds__(512) mega(Params p, int ph_begin, int ph_end) {
  __shared__ __attribute__((aligned(16))) char smem[131072 + 64 + 1024];
  if (ph_begin == 0) {
    phase0(p);
    if (ph_end > 1) cg::this_grid().sync();
  }
  P2 q; q.out = p.out; q.ws = p.ws; q.x = p.x; q.meta = p.meta;
  unsigned nbar = 0;
#pragma clang loop unroll(disable)
  for (int ph = (ph_begin < 1 ? 1 : ph_begin); ph < ph_end; ++ph) {
    const int li = (ph - 1) / 3, s = (ph - 1) % 3;
    unsigned* sig0 = (unsigned*)(q.ws + OFF_CNT) + 40 + 2 * li;
    unsigned* sig1 = sig0 + 1;
    const int bx = blockIdx.x;
    { int mode = -1, lc = li;
      if (s == 2) mode = 0; else if (s == 1 && li > 0 && bx < 4) { mode = 1; lc = li - 1; }
      if (mode >= 0) phaseC(q, lc, smem, mode, bx, sig0); }
    { int mode = -1;
      if (s == 0) mode = 0; else if (s == 1 && bx >= 4 && bx < 16) { mode = 1; wait_sig(sig0, li > 0 ? 32u : 0u); }
      if (mode >= 0) phaseA(q, li, smem, mode, bx - 4, sig1); }
    if (s == 1) { for (int rep = 0; rep < REPB; ++rep) phaseB(q, li, smem, rep); }
    if (ph + 1 < ph_end) { ++nbar; grid_barrier((unsigned*)(q.ws + OFF_CNT) + 32, nbar * gridDim.x); }
  }
}

extern "C" void kernel_launch(void* const* d_in, const int* in_sizes, int n_in, void* d_out, int out_size, void* d_ws, size_t ws_size, hipStream_t stream) {
  if (ws_size < WS_END) { fprintf(stderr, "workspace too small: %zu < %zu\n", ws_size, (size_t)WS_END); return; }
  Params p{};
  p.x = (const float*)d_in[0]; p.meta = (const float*)d_in[1]; p.norm_gain = (const float*)d_in[2]; p.w_in = (const float*)d_in[3];
  p.w_f = (const float*)d_in[4]; p.qg = (const float*)d_in[5]; p.kg = (const float*)d_in[6]; p.lq1 = (const float*)d_in[7];
  p.lk1 = (const float*)d_in[8]; p.lq2 = (const float*)d_in[9]; p.lk2 = (const float*)d_in[10]; p.subln = (const float*)d_in[11];
  p.w_out = (const float*)d_in[12]; p.out = (float*)d_out; p.ws = (char*)d_ws;
  constexpr int NPH = 1 + 3 * DEPTH;
#if MULTI_LAUNCH
  for (int ph = 0; ph < NPH; ++ph) hipLaunchKernelGGL(mega, dim3(256), dim3(512), 0, stream, p, ph, ph + 1);
#else
  static int grid_blocks = 0;
  if (!grid_blocks) {
    int dev = 0, cus = 0, per_cu = 0;
    hipGetDevice(&dev);
    hipDeviceGetAttribute(&cus, hipDeviceAttributeMultiprocessorCount, dev);
    hipOccupancyMaxActiveBlocksPerMultiprocessor(&per_cu, mega, 512, 0);
    if (per_cu < 1) per_cu = 1;
    grid_blocks = cus * 1;
  }
  int b0 = 0, b1 = NPH;
  void* args[] = {&p, &b0, &b1};
  hipError_t e = hipLaunchCooperativeKernel((void*)mega, dim3(grid_blocks), dim3(512), args, 0, stream);
  if (e != hipSuccess) fprintf(stderr, "cooperative launch failed: %s (grid %d)\n", hipGetErrorString(e), grid_blocks);
#endif
}
```

```cpp
#include <hip/hip_runtime.h>
#include <hip/hip_bf16.h>
#include <hip/hip_cooperative_groups.h>
#include <cstdio>
#include <cstdint>
namespace cg = cooperative_groups;

#ifndef MULTI_LAUNCH
#define MULTI_LAUNCH 0
#endif

typedef unsigned short u16;
using bf16x8 = __attribute__((ext_vector_type(8))) short;
using s16x4  = __attribute__((ext_vector_type(4))) short;
using f32x4  = __attribute__((ext_vector_type(4))) float;
using f32x16 = __attribute__((ext_vector_type(16))) float;
using u32x4  = __attribute__((ext_vector_type(4))) unsigned;
using u32x2  = __attribute__((ext_vector_type(2))) unsigned;

constexpr int NB = 8, SEQ = 4096, NMETA = 16, L = 4112, DM = 1024, DEPTH = 4;
constexpr int R = NB * L;
constexpr int RP = 33024;
constexpr int INW = 3072;
constexpr int NH = 4;
constexpr int LP = 4224;
constexpr int LH = 2056;
constexpr int KROWS = 2176;
constexpr int KP = 2112;
constexpr int NKT = 65;
constexpr float EPS = 1e-6f;

constexpr size_t al256(size_t x) { return (x + 255) / 256 * 256; }
constexpr size_t OFF_META = 0;
constexpr size_t OFF_XB   = al256(OFF_META + (size_t)NB * NMETA * DM * 4);
constexpr size_t OFF_GY   = al256(OFF_XB + (size_t)RP * DM * 2);
constexpr size_t OFF_QN   = al256(OFF_GY + (size_t)RP * DM * 2);
constexpr size_t QKV_BYTES = (size_t)NB * NH * LP * 128 * 2;
constexpr size_t OFF_KN   = al256(OFF_QN + QKV_BYTES);
constexpr size_t OFF_VN   = al256(OFF_KN + QKV_BYTES);
constexpr size_t OFF_WIN  = al256(OFF_VN + QKV_BYTES);
constexpr size_t OFF_WOUT = al256(OFF_WIN + (size_t)DEPTH * INW * DM * 2);
constexpr size_t OFF_CM   = al256(OFF_WOUT + (size_t)DEPTH * DM * DM * 2);
constexpr size_t OFF_SM   = al256(OFF_CM + (size_t)KROWS * KP * 2);
constexpr size_t OFF_MCS  = al256(OFF_SM + (size_t)KROWS * KP * 2);
constexpr size_t OFF_UTA  = al256(OFF_MCS + (size_t)DEPTH * 4 * 128 * 256 * 2);
constexpr size_t OFF_UTB  = al256(OFF_UTA + (size_t)NB * 512 * KP * 2);
constexpr size_t OFF_RSS  = al256(OFF_UTB + (size_t)NB * 512 * KP * 2);
constexpr size_t OFF_ROPE = al256(OFF_RSS + (size_t)RP * 16 * 4);
constexpr size_t OFF_CST  = al256(OFF_ROPE + (size_t)L * 16 * 4);
constexpr size_t OFF_SMALL = al256(OFF_CST + 256);
constexpr size_t OFF_CNT  = al256(OFF_SMALL + 4096);
constexpr size_t OFF_GG   = al256(OFF_CNT + 256);
constexpr size_t OFF_Q    = al256(OFF_GG + (size_t)RP * DM * 2);
constexpr size_t WS_END   = OFF_Q + 4 * 2 * 16 * 16 * 4;

struct Params {
  const float *x, *meta, *norm_gain, *w_in, *w_f, *qg, *kg, *lq1, *lk1, *lq2, *lk2, *subln, *w_out;
  float* out;
  char* ws;
};

struct P2 { float* out; char* ws; const float* x; const float* meta; };
__device__ __forceinline__ void grid_barrier(unsigned* bar, unsigned target) {
  asm volatile("s_waitcnt vmcnt(0) lgkmcnt(0)" ::: "memory");
  __syncthreads();
  if (threadIdx.x == 0) {
    __builtin_amdgcn_fence(__ATOMIC_RELEASE, "agent");
    asm volatile("s_waitcnt vmcnt(0)" ::: "memory");
    __hip_atomic_fetch_add(bar, 1u, __ATOMIC_RELAXED, __HIP_MEMORY_SCOPE_AGENT);
    while (__hip_atomic_load(bar, __ATOMIC_RELAXED, __HIP_MEMORY_SCOPE_AGENT) < target) __builtin_amdgcn_s_sleep(2);
    __builtin_amdgcn_fence(__ATOMIC_ACQUIRE, "agent");
    asm volatile("s_waitcnt vmcnt(0)" ::: "memory");
  }
  __syncthreads();
}
#define DI __device__ __forceinline__
#define MFMA16(a, b, c) __builtin_amdgcn_mfma_f32_16x16x32_bf16((a), (b), (c), 0, 0, 0)
#define MFMA32(a, b, c) __builtin_amdgcn_mfma_f32_32x32x16_bf16((a), (b), (c), 0, 0, 0)

using bf16v2 = __attribute__((ext_vector_type(2))) __bf16;
DI void wait_sig(unsigned* sig, unsigned target) {
  if (threadIdx.x == 0) {
    while (__hip_atomic_load(sig, __ATOMIC_RELAXED, __HIP_MEMORY_SCOPE_AGENT) < target) __builtin_amdgcn_s_sleep(2);
    __builtin_amdgcn_fence(__ATOMIC_ACQUIRE, "agent");
    asm volatile("s_waitcnt vmcnt(0)" ::: "memory");
  }
  __syncthreads();
}
DI unsigned cvtpk(float lo, float hi) { bf16v2 v; v[0] = (__bf16)lo; v[1] = (__bf16)hi; return __builtin_bit_cast(unsigned, v); }
DI u16 f2bf(float x) { return (u16)(cvtpk(x, x) & 0xffffu); }
DI float bf2f(u16 v) { return __uint_as_float(((unsigned)v) << 16); }
DI float wave_sum(float v) { for (int o = 32; o; o >>= 1) v += __shfl_xor(v, o); return v; }
DI float wave_max(float v) { for (int o = 32; o; o >>= 1) v = fmaxf(v, __shfl_xor(v, o)); return v; }
DI float addf(float a, float b) { float r; asm volatile("v_add_f32 %0, %1, %2" : "=v"(r) : "v"(a), "v"(b)); return r; }
DI int crow(int r, int hi) { return (r & 3) + 8 * (r >> 2) + 4 * hi; }

DI float* hres_row(const Params& p, int row) {
  const int b = row / L, l = row - b * L;
  return l < NMETA ? (float*)(p.ws + OFF_META) + (size_t)(b * NMETA + l) * DM
                   : p.out + ((size_t)b * SEQ + (l - NMETA)) * DM;
}

DI void row_bl(int row, int b0, int& b, int& l) { b = b0 + ((row >= (b0 + 1) * L) ? 1 : 0); l = row - b * L; }
#define CBAR() asm volatile("" ::: "memory")
DI int opaque_tid() { int t = threadIdx.x; asm volatile("" : "+v"(t)); return t; }

__device__ const double INVF[8] = {1.0, 0.19392274474868576, 0.03760603093086393, 0.007292664737217109, 0.001414213562373095, 0.0002742481756762073, 5.318295896944988e-05, 1.031338537721246e-05};

DI void phase0(const Params& p, char* smem) {
  const int tid = threadIdx.x, gtid = blockIdx.x * 512 + tid, gsz = gridDim.x * 512;
  const int lane = tid & 63, gw = gtid >> 6, nw = gsz >> 6;
  u16* xb = (u16*)(p.ws + OFF_XB);
  float* rss = (float*)(p.ws + OFF_RSS);
  for (int row = gw; row < RP; row += nw) {
    if (row < R) {
      const int b = row / L, l = row - b * L;
      const float* src = l < NMETA ? p.meta + (size_t)l * DM : p.x + ((size_t)b * SEQ + (l - NMETA)) * DM;
      float ss = 0.f;
#pragma unroll
      for (int i = 0; i < 4; ++i) {
        const f32x4 v = *(const f32x4*)(src + i * 256 + lane * 4);
        ss += v[0] * v[0] + v[1] * v[1] + v[2] * v[2] + v[3] * v[3];
        u32x2 o = {cvtpk(v[0], v[1]), cvtpk(v[2], v[3])};
        *(u32x2*)(xb + (size_t)row * DM + i * 256 + lane * 4) = o;
      }
      ss = wave_sum(ss);
      if (lane == 0) rss[(size_t)row * 16] = ss;
    } else {
#pragma unroll
      for (int i = 0; i < 4; ++i) { u32x2 o = {0u, 0u}; *(u32x2*)(xb + (size_t)row * DM + i * 256 + lane * 4) = o; }
      if (lane == 0) rss[(size_t)row * 16] = 1024.f;
    }
    if (lane >= 1 && lane < 16) rss[(size_t)row * 16 + lane] = 0.f;
  }
  {
    u16* WinT = (u16*)(p.ws + OFF_WIN);
    for (long it = gtid; it < (long)DEPTH * 128 * INW; it += gsz) {
      const int nd = (int)(it % INW); const long t2 = it / INW; const int kc = (int)(t2 % 128), li = (int)(t2 / 128);
      const int c1 = nd & 255;
      const int n = (nd & ~255) + ((c1 >> 5) & 3) * 64 + (c1 >> 7) * 32 + (c1 & 31);
      const float* w = p.w_in + ((size_t)li * DM + kc * 8) * INW + n;
      const float* g = p.norm_gain + li * DM + kc * 8;
      float v[8];
#pragma unroll
      for (int j = 0; j < 8; ++j) v[j] = w[(size_t)j * INW] * g[j];
      u32x4 o = {cvtpk(v[0], v[1]), cvtpk(v[2], v[3]), cvtpk(v[4], v[5]), cvtpk(v[6], v[7])};
      *(u32x4*)(WinT + ((size_t)li * INW + nd) * DM + kc * 8) = o;
    }
  }
  {
    u16* WoutT = (u16*)(p.ws + OFF_WOUT);
    for (long it = gtid; it < (long)DEPTH * 128 * DM; it += gsz) {
      const int n = (int)(it % DM); const long t2 = it / DM; const int kc = (int)(t2 % 128), li = (int)(t2 / 128);
      const float* w = p.w_out + ((size_t)li * DM + kc * 8) * DM + n;
      float v[8];
#pragma unroll
      for (int j = 0; j < 8; ++j) v[j] = w[(size_t)j * DM];
      u32x4 o = {cvtpk(v[0], v[1]), cvtpk(v[2], v[3]), cvtpk(v[4], v[5]), cvtpk(v[6], v[7])};
      *(u32x4*)(WoutT + ((size_t)li * DM + n) * DM + kc * 8) = o;
    }
  }
  {
    u16* Cm = (u16*)(p.ws + OFF_CM); u16* Sm = (u16*)(p.ws + OFF_SM);
    for (int it = gtid; it < KROWS * (KP / 8); it += gsz) {
      const int k = it / (KP / 8), j0 = (it % (KP / 8)) * 8;
      float c[8], s[8];
#pragma unroll
      for (int jj = 0; jj < 8; ++jj) {
        const int j = j0 + jj;
        const bool valid = (k <= LH) && (j <= LH);
        const int m = valid ? (k * j) % L : 0;
        const float rev = (float)m / (float)L;
        c[jj] = valid ? __builtin_amdgcn_cosf(rev) : 0.f;
        s[jj] = valid ? __builtin_amdgcn_sinf(rev) : 0.f;
      }
      u32x4 oc = {cvtpk(c[0], c[1]), cvtpk(c[2], c[3]), cvtpk(c[4], c[5]), cvtpk(c[6], c[7])};
      u32x4 os = {cvtpk(s[0], s[1]), cvtpk(s[2], s[3]), cvtpk(s[4], s[5]), cvtpk(s[6], s[7])};
      *(u32x4*)(Cm + (size_t)k * KP + j0) = oc;
      *(u32x4*)(Sm + (size_t)k * KP + j0) = os;
    }
  }
  {
    u16* Mcs = (u16*)(p.ws + OFF_MCS);
    const float norm = 1.0f / sqrtf((float)L * 128.f);
    float* Wl = (float*)smem;
    float* tcs = (float*)(smem + 65536);
    float* tsn = tcs + 128;
    for (int u = blockIdx.x; u < DEPTH * 4 * 16; u += gridDim.x) {
      const int lg = u >> 4, ccb = u & 15;
      const float* wf = p.w_f + (size_t)lg * 128 * 128;
#pragma unroll
      for (int i = 0; i < 8; ++i) *(f32x4*)(Wl + (tid + 512 * i) * 4) = *(const f32x4*)(wf + (tid + 512 * i) * 4);
      if (tid < 128) { const float rev = (float)tid * (1.0f / 128.f); tcs[tid] = __builtin_amdgcn_cosf(rev); tsn[tid] = __builtin_amdgcn_sinf(rev); }
      __syncthreads();
      const int e = tid & 127, cc0 = ccb * 16 + (tid >> 7) * 4;
      const bool isS = ccb >= 8;
      const float* tab = isS ? tsn : tcs;
      const int c0 = cc0 & 127;
      float a0 = 0.f, a1 = 0.f, a2 = 0.f, a3 = 0.f;
      for (int m = 0; m < 128; ++m) {
        const float w = Wl[m * 128 + e];
        a0 += tab[(m * c0) & 127] * w; a1 += tab[(m * (c0 + 1)) & 127] * w; a2 += tab[(m * (c0 + 2)) & 127] * w; a3 += tab[(m * (c0 + 3)) & 127] * w;
      }
      const float sn = isS ? -norm : norm;
      u32x2 o = {cvtpk(a0 * sn, a1 * sn), cvtpk(a2 * sn, a3 * sn)};
      *(u32x2*)(Mcs + ((size_t)lg * 128 + e) * 256 + cc0) = o;
      __syncthreads();
    }
  }
  {
    u16* uta = (u16*)(p.ws + OFF_UTA); u16* utb = (u16*)(p.ws + OFF_UTB);
    for (int it = gtid; it < NB * 512 * 64; it += gsz) {
      const int row = it >> 6, i = it & 63;
      if (i < 55) { uta[(size_t)row * KP + 2057 + i] = 0; utb[(size_t)row * KP + 2057 + i] = 0; }
      else if (i == 55) utb[(size_t)row * KP] = 0;
      else if (i == 56) utb[(size_t)row * KP + LH] = 0;
    }
  }
  {
    u16* qn = (u16*)(p.ws + OFF_QN); u16* kn = (u16*)(p.ws + OFF_KN); u16* vt = (u16*)(p.ws + OFF_VN);
    for (int it = gtid; it < NB * NH * (LP - L) * 16; it += gsz) {
      const int ch = it & 15, rr = (it >> 4) % (LP - L), bh = (it >> 4) / (LP - L);
      const size_t off = ((size_t)bh * LP + L + rr) * 128 + ch * 8;
      u32x4 z = {0u, 0u, 0u, 0u};
      *(u32x4*)(qn + off) = z; *(u32x4*)(kn + off) = z;
    }
    for (int it = gtid; it < NB * NH * 128 * ((LP - L) / 8); it += gsz) {
      const int ch = it % ((LP - L) / 8), row = it / ((LP - L) / 8);
      u32x4 z = {0u, 0u, 0u, 0u};
      *(u32x4*)(vt + (size_t)row * LP + L + ch * 8) = z;
    }
  }
  {
    float* rope = (float*)(p.ws + OFF_ROPE);
    for (int it = gtid; it < L * 8; it += gsz) {
      const int l = it >> 3, i = it & 7;
      double rv = (double)l * INVF[i] * 0.15915494309189535;
      rv -= floor(rv);
      const float r = (float)rv;
      rope[l * 16 + i] = __builtin_amdgcn_cosf(r);
      rope[l * 16 + 8 + i] = __builtin_amdgcn_sinf(r);
    }
  }
  if (blockIdx.x == 0) {
    const int wid = tid >> 6;
    if (wid < DEPTH) {
      const int li = wid;
      float a = p.lq1[li * 64 + lane] * p.lk1[li * 64 + lane];
      float bq = p.lq2[li * 64 + lane] * p.lk2[li * 64 + lane];
      a = wave_sum(a); bq = wave_sum(bq);
      const float gq = wave_max(fabsf(p.qg[li * 64 + lane]));
      const float gk = wave_max(fabsf(p.kg[li * 64 + lane]));
      if (lane == 0) {
        float* cst = (float*)(p.ws + OFF_CST) + li * 8;
        const float lam_init = 0.8f - 0.6f * expf(-0.3f * (float)li);
        cst[0] = expf(a) - expf(bq) + lam_init;
        cst[1] = 1.0f - lam_init;
        cst[2] = (8.0f * gq * gk * 1.01f + 0.05f) * 1.4426950408889634f;
      }
    }
    if (tid < 64) ((int*)(p.ws + OFF_CNT))[tid] = 0;
    for (int i = tid; i < 4 * 2 * 16 * 16; i += 512) ((int*)(p.ws + OFF_Q))[i] = 0;
    float* sm = (float*)(p.ws + OFF_SMALL);
    if (tid < 256) { sm[tid] = p.qg[tid]; sm[256 + tid] = p.kg[tid]; }
    sm[512 + tid] = p.subln[tid];
  }
}

namespace pg8 {
#define PG8_LAS __attribute__((address_space(3)))
constexpr int BM = 256, BK = 64, HALF = 128, HTB = HALF * BK * 2, NXCD = 8, WGM = 8;
DI int lds_byte(int r, int c) { const int st = (r >> 4) * 2 + (c >> 5), rr = r & 15, cc = c & 31, ob = rr * 64 + cc * 2; return st * 1024 + (ob ^ (((ob >> 9) & 1) << 5)); }
DI void stage_rc(int b, int& R, int& C) { const int st = b / 1024, sb = b % 1024, swz = sb ^ (((sb >> 9) & 1) << 5); R = (st >> 1) * 16 + swz / 64; C = (st & 1) * 32 + (swz % 64) / 2; }
DI int perm32(int rho) { const int n = rho >> 4, i = rho & 15; return 8 * (i >> 2) + 4 * n + (i & 3); }
struct Unit { int pm, pn; };
struct Gemm { const u16* A; const u16* Bt; int M, N, K; };
struct StaticOrder {
  int nM, nN, nwg, G, c;
  DI void init(int M, int N, int G_, int c_) { nM = M / BM; nN = N / BM; nwg = nM * nN; G = G_; c = c_; }
  DI bool next(int i, Unit& u) const {
    const long Lx = (long)i * G + c; if (Lx >= nwg) return false;
    int wgid = (int)Lx; { const int q = nwg / NXCD, r = nwg % NXCD, xcd = wgid % NXCD, off = wgid / NXCD; wgid = (xcd < r ? xcd * (q + 1) : r * (q + 1) + (xcd - r) * q) + off; }
    const int nig = WGM * nN, gid = wgid / nig, fm = gid * WGM, gsz = (nM - fm) < WGM ? (nM - fm) : WGM;
    u.pm = fm + ((wgid % nig) % gsz); u.pn = (wgid % nig) / gsz; return true;
  }
  DI void done(int) const {}
};
struct Order {
  int mode; StaticOrder st; int pm, pn; unsigned* sig;
  const unsigned* bready;
  DI void a_ready(const Unit& u) const {
    if (bready == nullptr) return;
    if (threadIdx.x < 64) {
      const int b1 = (u.pm * 256) / L; int b2 = (u.pm * 256 + 255) / L; if (b2 > NB - 1) b2 = NB - 1;
      while ((unsigned)__builtin_amdgcn_readfirstlane(__hip_atomic_load(bready + b1 * 16, __ATOMIC_RELAXED, __HIP_MEMORY_SCOPE_AGENT)) < 200u ||
             (unsigned)__builtin_amdgcn_readfirstlane(__hip_atomic_load(bready + b2 * 16, __ATOMIC_RELAXED, __HIP_MEMORY_SCOPE_AGENT)) < 200u) __builtin_amdgcn_s_sleep(2);
      __builtin_amdgcn_fence(__ATOMIC_ACQUIRE, "agent");
      asm volatile("s_waitcnt vmcnt(0)" ::: "memory");
    }
    asm volatile("" ::: "memory"); __builtin_amdgcn_s_barrier(); asm volatile("" ::: "memory");
  }
  DI bool next(int i, Unit& u) const { if (mode == 0) return st.next(i, u); if (i != 0) return false; u.pm = pm; u.pn = pn; return true; }
  DI void done(int lane) const {
    if (mode == 1) {
      asm volatile("s_waitcnt vmcnt(0)" ::: "memory");
      __builtin_amdgcn_fence(__ATOMIC_RELEASE, "agent");
      asm volatile("s_waitcnt vmcnt(0)" ::: "memory");
      if (lane == 0) __hip_atomic_fetch_add(sig, 1u, __ATOMIC_RELAXED, __HIP_MEMORY_SCOPE_AGENT);
    }
  }
};
template <class Epi, class Sched>
DI void gemm_phase(PG8_LAS unsigned char* lds, const Gemm g, const Sched& S, const Epi& E) {
  const int tid = opaque_tid(), wid = __builtin_amdgcn_readfirstlane(tid >> 6), lane = tid & 63, wr = wid >> 2, wc = wid & 3, fr = lane & 15, fq = lane >> 4;
  const int K = g.K, nt = K / BK;
  unsigned voffA[2], voffB[2];
#pragma unroll
  for (int i = 0; i < 2; ++i) { int R_, C_; stage_rc(tid * 16 + i * 8192, R_, C_); const int Rb = (R_ & ~31) + perm32(R_ & 31);
    voffA[i] = (unsigned)(R_ * K + C_) * 2u; voffB[i] = (unsigned)(Rb * K + C_) * 2u; }
  const size_t kstep = (size_t)(BK * 2);
  const size_t hstep = (size_t)HALF * K * 2;
  const size_t tstep = 2 * hstep;
  const unsigned ldsw = (unsigned)wid * 1024u;
  const int aoff = lds_byte(wr * 64 + fr, fq * 8), boff = lds_byte(wc * 32 + fr, fq * 8);
#define PG8_SA(b, h) (((b) * 2 + (h)) * HTB)
#define PG8_SB(b, h) ((4 + (b) * 2 + (h)) * HTB)
#define PG8_STAGE(bufoff, gbase, voff) do { _Pragma("unroll") for (int _i = 0; _i < 2; ++_i) \
    __builtin_amdgcn_global_load_lds((const unsigned*)((const char*)(gbase) + (voff)[_i]), (PG8_LAS unsigned*)(lds + (bufoff) + ldsw + _i * 8192), 16, 0, 0); } while (0)
#define PG8_LDA(dst, b, h) do { _Pragma("unroll") for (int m = 0; m < 4; ++m) _Pragma("unroll") for (int k = 0; k < 2; ++k) dst[m][k] = *(const PG8_LAS bf16x8*)(lds + PG8_SA(b, h) + aoff + m * 2048 + k * 1024); } while (0)
#define PG8_LDB(dst, b, h) do { _Pragma("unroll") for (int n = 0; n < 2; ++n) _Pragma("unroll") for (int k = 0; k < 2; ++k) dst[n][k] = *(const PG8_LAS bf16x8*)(lds + PG8_SB(b, h) + boff + n * 2048 + k * 1024); } while (0)
#define PG8_MMA(ai, bj, At, Bt) do { __builtin_amdgcn_s_setprio(1); _Pragma("unroll") for (int m = 0; m < 4; ++m) _Pragma("unroll") for (int n = 0; n < 2; ++n) _Pragma("unroll") for (int k = 0; k < 2; ++k) \
    acc[ai][bj][m][n] = __builtin_amdgcn_mfma_f32_16x16x32_bf16(Bt[n][k], At[m][k], acc[ai][bj][m][n], 0, 0, 0); __builtin_amdgcn_s_setprio(0); } while (0)
#define PG8_WAIT_V(n) asm volatile("s_waitcnt vmcnt(" #n ")" ::: "memory")
#define PG8_WAIT_L(n) asm volatile("s_waitcnt lgkmcnt(" #n ")" ::: "memory")
#define PG8_BAR __builtin_amdgcn_s_barrier()
#define PG8_SCHED __builtin_amdgcn_sched_barrier(0)
  Unit cur, nxt; int ui = 0;
  if (!S.next(0, cur)) return;
  f32x4 acc[2][2][4][2];
#pragma unroll
  for (int a = 0; a < 2; ++a)
#pragma unroll
    for (int b = 0; b < 2; ++b)
#pragma unroll
      for (int m = 0; m < 4; ++m)
#pragma unroll
        for (int n = 0; n < 2; ++n) acc[a][b][m][n] = (f32x4){0.f, 0.f, 0.f, 0.f};
  bf16x8 At[4][2], B0[2][2], B1[2][2];
  const char* cA = (const char*)g.A + (size_t)cur.pm * tstep; const char* cB = (const char*)g.Bt + (size_t)cur.pn * tstep;
  S.a_ready(cur);
  PG8_STAGE(PG8_SB(0, 0), cB, voffB); PG8_STAGE(PG8_SA(0, 0), cA, voffA); PG8_STAGE(PG8_SB(0, 1), cB + hstep, voffB); PG8_STAGE(PG8_SA(0, 1), cA + hstep, voffA);
  if (wr == 1) PG8_BAR;
  PG8_WAIT_V(4); PG8_BAR;
  PG8_STAGE(PG8_SB(1, 0), cB + kstep, voffB); PG8_STAGE(PG8_SA(1, 0), cA + kstep, voffA); PG8_STAGE(PG8_SB(1, 1), cB + hstep + kstep, voffB);
  PG8_WAIT_V(6); PG8_BAR;
  for (;;) {
    const bool has_next = S.next(ui + 1, nxt);
    const char* nA = has_next ? (const char*)g.A + (size_t)nxt.pm * tstep : cA; const char* nB = has_next ? (const char*)g.Bt + (size_t)nxt.pn * tstep : cB;
    for (int t = 0; t < nt; t += 2) {
      const bool last = (t == nt - 2);
      const char* a1 = cA + (size_t)(t + 1) * kstep;
      const char* a2 = last ? nA : cA + (size_t)(t + 2) * kstep; const char* b2 = last ? nB : cB + (size_t)(t + 2) * kstep;
      const char* a3 = a2 + kstep; const char* b3 = b2 + kstep;
      if (last && has_next) S.a_ready(nxt);
      PG8_LDB(B0, 0, 0); PG8_SCHED; PG8_LDA(At, 0, 0); PG8_STAGE(PG8_SA(1, 1), a1 + hstep, voffA);
      PG8_WAIT_L(8); PG8_BAR; PG8_WAIT_L(0); PG8_MMA(0, 0, At, B0); PG8_BAR; PG8_SCHED;
      PG8_LDB(B1, 0, 1); PG8_STAGE(PG8_SB(0, 0), b2, voffB);
      PG8_BAR; PG8_WAIT_L(0); PG8_MMA(0, 1, At, B1); PG8_BAR;
      PG8_LDA(At, 0, 1); PG8_STAGE(PG8_SA(0, 0), a2, voffA);
      PG8_BAR; PG8_WAIT_L(0); PG8_MMA(1, 0, At, B0); PG8_BAR; PG8_SCHED;
      PG8_STAGE(PG8_SB(0, 1), b2 + hstep, voffB);
      PG8_WAIT_V(6); PG8_BAR; PG8_MMA(1, 1, At, B1); PG8_BAR;
      PG8_LDB(B0, 1, 0); PG8_SCHED; PG8_LDA(At, 1, 0); PG8_STAGE(PG8_SA(0, 1), a2 + hstep, voffA);
      PG8_WAIT_L(8); PG8_BAR; PG8_WAIT_L(0); PG8_MMA(0, 0, At, B0); PG8_BAR; PG8_SCHED;
      PG8_LDB(B1, 1, 1); PG8_STAGE(PG8_SB(1, 0), b3, voffB);
      PG8_BAR; PG8_WAIT_L(0); PG8_MMA(0, 1, At, B1); PG8_BAR;
      PG8_LDA(At, 1, 1); PG8_STAGE(PG8_SA(1, 0), a3, voffA);
      PG8_BAR; PG8_WAIT_L(0); PG8_MMA(1, 0, At, B0); PG8_BAR; PG8_SCHED;
      PG8_STAGE(PG8_SB(1, 1), b3 + hstep, voffB);
      PG8_WAIT_V(6); PG8_BAR; PG8_MMA(1, 1, At, B1); PG8_BAR;
    }
    E(acc, cur, wr, wc, fr, fq);
    S.done(lane);
    if (!has_next) break;
#pragma unroll
    for (int a = 0; a < 2; ++a)
#pragma unroll
      for (int b = 0; b < 2; ++b)
#pragma unroll
        for (int m = 0; m < 4; ++m)
#pragma unroll
          for (int n = 0; n < 2; ++n) acc[a][b][m][n] = (f32x4){0.f, 0.f, 0.f, 0.f};
    cur = nxt; cA = nA; cB = nB; ++ui;
  }
  PG8_WAIT_V(0);
  if (wr == 0) PG8_BAR;
  PG8_BAR;
#undef PG8_SA
#undef PG8_SB
#undef PG8_STAGE
#undef PG8_LDA
#undef PG8_LDB
#undef PG8_MMA
#undef PG8_WAIT_V
#undef PG8_WAIT_L
#undef PG8_BAR
#undef PG8_SCHED
}
}

DI float row_scale(const float* rsp, int row) {
  const f32x4* rp = (const f32x4*)(rsp + (size_t)row * 16);
  const f32x4 a0 = rp[0], a1 = rp[1], a2 = rp[2], a3 = rp[3];
  const float s = ((a0[0] + a0[1]) + (a0[2] + a0[3])) + ((a1[0] + a1[1]) + (a1[2] + a1[3])) + ((a2[0] + a2[1]) + (a2[2] + a2[3])) + ((a3[0] + a3[1]) + (a3[2] + a3[3]));
  return rsqrtf(s * (1.0f / DM) + EPS);
}

struct EpiA {
  char* ws; int li;
  DI void operator()(const f32x4 (&acc)[2][2][4][2], const pg8::Unit& u, int wr, int wc, int fr, int fq) const {
    const int mt = u.pm, nt = u.pn;
    const float* rsp = (const float*)(ws + OFF_RSS);
    const int b0 = (mt * 256) / L;
    const int rbase = mt * 256 + wr * 64 + fr;
    float scv[2][4];
    {
      const int lane_ = fq * 16 + fr, r0_ = mt * 256 + wr * 64 + lane_;
      const float so0 = row_scale(rsp, r0_ < R ? r0_ : 0), so1 = row_scale(rsp, r0_ + 128 < R ? r0_ + 128 : 0);
#pragma unroll
      for (int m = 0; m < 4; ++m) { scv[0][m] = __shfl(so0, m * 16 + fr); scv[1][m] = __shfl(so1, m * 16 + fr); }
    }
    if (nt < 2) {
      u16* uta = (u16*)(ws + OFF_UTA); u16* utb = (u16*)(ws + OFF_UTB);
      const int chb = nt * 256 + wc * 64 + 8 * fq;
#pragma unroll
      for (int ai = 0; ai < 2; ++ai)
#pragma unroll
        for (int m = 0; m < 4; ++m) {
          const int row = rbase + ai * 128 + m * 16;
          if (row < R) {
            int b, l; row_bl(row, b0, b, l);
            const float sc = scv[ai][m];
            u16* dst = (l <= LH) ? uta + (size_t)b * 512 * KP + l : utb + (size_t)b * 512 * KP + (L - l);
#pragma unroll
            for (int bj = 0; bj < 2; ++bj)
#pragma unroll
              for (int n = 0; n < 2; ++n)
#pragma unroll
                for (int j = 0; j < 4; ++j) dst[(size_t)(chb + bj * 32 + n * 4 + j) * KP] = f2bf(acc[ai][bj][m][n][j] * sc);
          }
          CBAR();
        }
    } else if (nt < 6) {
      const bool isq = nt < 4;
      const int gi = (isq ? nt - 2 : nt - 4) * 4 + wc;
      const int h = gi >> 1, comp = gi & 1;
      const float* gain = (const float*)(ws + OFF_SMALL) + (isq ? 0 : 256) + li * 64 + 8 * fq;
      const f32x4 g00 = *(const f32x4*)(gain), g01 = *(const f32x4*)(gain + 4), g10 = *(const f32x4*)(gain + 32), g11 = *(const f32x4*)(gain + 36);
      const float qsc = isq ? 0.125f * 1.4426950408889634f : 1.0f;
      const float* rope = (const float*)(ws + OFF_ROPE);
      u16* dbase = (u16*)(ws + (isq ? OFF_QN : OFF_KN));
#pragma unroll
      for (int ai = 0; ai < 2; ++ai)
#pragma unroll
        for (int m = 0; m < 4; ++m) {
          const int row = rbase + ai * 128 + m * 16;
          const bool valid = row < R;
          const int rowc = valid ? row : 0;
          int b, l; row_bl(rowc, valid ? b0 : 0, b, l);
          const float sc = scv[ai][m];
          f32x4 v00 = acc[ai][0][m][0] * sc, v01 = acc[ai][0][m][1] * sc, v10 = acc[ai][1][m][0] * sc, v11 = acc[ai][1][m][1] * sc;
          float ss = 0.f;
#pragma unroll
          for (int j = 0; j < 4; ++j) ss += v00[j] * v00[j] + v01[j] * v01[j] + v10[j] * v10[j] + v11[j] * v11[j];
          ss += __shfl_xor(ss, 16); ss += __shfl_xor(ss, 32);
          const float rq = rsqrtf(ss * (1.0f / 64.f) + EPS) * qsc;
          v00 = v00 * g00 * rq; v01 = v01 * g01 * rq; v10 = v10 * g10 * rq; v11 = v11 * g11 * rq;
          const f32x4 c0 = *(const f32x4*)(rope + l * 16), c1 = *(const f32x4*)(rope + l * 16 + 4), s0 = *(const f32x4*)(rope + l * 16 + 8), s1 = *(const f32x4*)(rope + l * 16 + 12);
          f32x4 p0, p1;
#pragma unroll
          for (int j = 0; j < 4; ++j) { p0[j] = __shfl_xor(v00[j], 16); p1[j] = __shfl_xor(v01[j], 16); }
          if (fq == 0) { v00 = v00 * c0 - p0 * s0; v01 = v01 * c1 - p1 * s1; }
          else if (fq == 1) { v00 = v00 * c0 + p0 * s0; v01 = v01 * c1 + p1 * s1; }
          if (valid) {
            u16* dst = dbase + (((size_t)(b * NH + h)) * LP + l) * 128 + comp * 64 + 8 * fq;
            u32x4 w0 = {cvtpk(v00[0], v00[1]), cvtpk(v00[2], v00[3]), cvtpk(v01[0], v01[1]), cvtpk(v01[2], v01[3])};
            u32x4 w1 = {cvtpk(v10[0], v10[1]), cvtpk(v10[2], v10[3]), cvtpk(v11[0], v11[1]), cvtpk(v11[2], v11[3])};
            *(u32x4*)(dst) = w0; *(u32x4*)(dst + 32) = w1;
          }
          CBAR();
        }
    } else if (nt < 8) {
      const int cv = (nt - 6) * 256 + wc * 64;
      const int h = cv >> 7, dv = (cv & 127) + 8 * fq;
      u16* vt = (u16*)(ws + OFF_VN);
#pragma unroll
      for (int ai = 0; ai < 2; ++ai)
#pragma unroll
        for (int m = 0; m < 4; ++m) {
          const int row = rbase + ai * 128 + m * 16;
          if (row < R) {
            int b, l; row_bl(row, b0, b, l);
            const float sc = scv[ai][m];
            const int o = l & 15;
            const int pos = (l & ~15) + 8 * ((o >> 2) & 1) + 4 * (o >> 3) + (o & 3);
            u16* dst = vt + ((size_t)(b * NH + h) * 128 + dv) * LP + pos;
#pragma unroll
            for (int bj = 0; bj < 2; ++bj)
#pragma unroll
              for (int n = 0; n < 2; ++n)
#pragma unroll
                for (int j = 0; j < 4; ++j) dst[(size_t)(bj * 32 + n * 4 + j) * LP] = f2bf(acc[ai][bj][m][n][j] * sc);
          }
          CBAR();
        }
    } else {
      u16* gg = (u16*)(ws + OFF_GG);
      const int cgc = (nt - 8) * 256 + wc * 64 + 8 * fq;
#pragma unroll
      for (int ai = 0; ai < 2; ++ai)
#pragma unroll
        for (int m = 0; m < 4; ++m) {
          const int row = rbase + ai * 128 + m * 16;
          if (row < R) {
            const float sc = scv[ai][m];
            u16* dst = gg + (size_t)row * DM + cgc;
#pragma unroll
            for (int bj = 0; bj < 2; ++bj) {
              f32x4 a = acc[ai][bj][m][0] * sc, c = acc[ai][bj][m][1] * sc;
#pragma unroll
              for (int j = 0; j < 4; ++j) { a[j] = a[j] * __builtin_amdgcn_rcpf(1.0f + __expf(-a[j])); c[j] = c[j] * __builtin_amdgcn_rcpf(1.0f + __expf(-c[j])); }
              u32x4 w = {cvtpk(a[0], a[1]), cvtpk(a[2], a[3]), cvtpk(c[0], c[1]), cvtpk(c[2], c[3])};
              *(u32x4*)(dst + bj * 32) = w;
            }
          }
          CBAR();
        }
    }
  }
};
DI void phaseA(const P2& p, int li, char* smem, int mode, int pn, unsigned* sig) {
  pg8::Gemm g; g.A = (const u16*)(p.ws + OFF_XB); g.Bt = (const u16*)(p.ws + OFF_WIN) + (size_t)li * INW * DM; g.M = RP; g.N = INW; g.K = DM;
  pg8::Order S; S.mode = mode; S.st.init(RP - 256, INW, gridDim.x, blockIdx.x); S.pm = RP / 256 - 1; S.pn = pn; S.sig = sig; S.bready = nullptr;
  EpiA E; E.ws = p.ws; E.li = li;
  pg8::gemm_phase((PG8_LAS unsigned char*)smem, g, S, E);
}

struct EpiC {
  char* ws; float* out; const float* x; const float* meta; int li;
  DI void operator()(const f32x4 (&acc)[2][2][4][2], const pg8::Unit& u, int wr, int wc, int fr, int fq) const {
    const int mt = u.pm, nt = u.pn;
    const bool last = (li == DEPTH - 1), first = (li == 0);
    u16* xb = (u16*)(ws + OFF_XB);
    float* rsp = (float*)(ws + OFF_RSS);
    const int b0 = (mt * 256) / L;
    const int rbase = mt * 256 + wr * 64 + fr;
    const int cb = nt * 256 + wc * 32 + 8 * fq;
#pragma unroll
    for (int ai = 0; ai < 2; ++ai)
#pragma unroll
      for (int m = 0; m < 4; ++m) {
        const int row = rbase + ai * 128 + m * 16;
        const bool valid = row < R;
        float ss = 0.f;
        if (valid) {
          int b, l; row_bl(row, b0, b, l);
          u16* xr = xb + (size_t)row * DM + cb;
          const float* xin = (l < NMETA ? meta + (size_t)l * DM : x + ((size_t)b * SEQ + (l - NMETA)) * DM) + cb;
          float* orow = out + ((size_t)b * SEQ + (l - NMETA)) * DM + cb;
#pragma unroll
          for (int bj = 0; bj < 2; ++bj) {
            f32x4 a, c;
            if (first) { a = *(const f32x4*)(xin + bj * 128); c = *(const f32x4*)(xin + bj * 128 + 4); }
            else { const u32x4 w = *(const u32x4*)(xr + bj * 128);
              a = f32x4{__uint_as_float(w[0] << 16), __uint_as_float(w[0] & 0xffff0000u), __uint_as_float(w[1] << 16), __uint_as_float(w[1] & 0xffff0000u)};
              c = f32x4{__uint_as_float(w[2] << 16), __uint_as_float(w[2] & 0xffff0000u), __uint_as_float(w[3] << 16), __uint_as_float(w[3] & 0xffff0000u)}; }
            a += acc[ai][bj][m][0]; c += acc[ai][bj][m][1];
            if (last) { if (l >= NMETA) { *(f32x4*)(orow + bj * 128) = a; *(f32x4*)(orow + bj * 128 + 4) = c; } }
            else { u32x4 w = {cvtpk(a[0], a[1]), cvtpk(a[2], a[3]), cvtpk(c[0], c[1]), cvtpk(c[2], c[3])}; *(u32x4*)(xr + bj * 128) = w; }
#pragma unroll
            for (int j = 0; j < 4; ++j) ss += a[j] * a[j] + c[j] * c[j];
          }
        }
        ss += __shfl_xor(ss, 16); ss += __shfl_xor(ss, 32);
        if (valid && !last && fq == 0) rsp[(size_t)row * 16 + nt * 4 + wc] = ss;
        if (m == 1 || m == 3) CBAR();
      }
  }
};
DI void phaseC(const P2& p, int li, char* smem, int mode, int pn, unsigned* sig) {
  pg8::Gemm g; g.A = (const u16*)(p.ws + OFF_GY); g.Bt = (const u16*)(p.ws + OFF_WOUT) + (size_t)li * DM * DM; g.M = RP; g.N = DM; g.K = DM;
  pg8::Order S; S.mode = mode; S.st.init(li == DEPTH - 1 ? RP : RP - 256, DM, gridDim.x, blockIdx.x); S.pm = RP / 256 - 1; S.pn = pn; S.sig = sig;
  S.bready = nullptr;
  EpiC E; E.ws = p.ws; E.out = p.out; E.x = p.x; E.meta = p.meta; E.li = li;
  pg8::gemm_phase((PG8_LAS unsigned char*)smem, g, S, E);
}

#define KSWZ(row, colB) ((row) * 256 + ((colB) ^ (((row) & 15) << 4)))
DI int v_st(int k, int c) { const int kk = (k & ~0xC) | ((k & 4) << 1) | ((k & 8) >> 1); return ((kk >> 3) * 4 + (c >> 5)) * 512 + ((kk & 7) * 32 + (c & 31)) * 2; }
DI int v_rd_base(int lane) { return ((lane & 3) << 3) | (((lane >> 2) & 3) << 6) | (((lane >> 4) & 1) << 5) | (((lane >> 5) & 1) << 8); }
constexpr int v_rd_off(int d0, int ks, int half) { return d0 * 512 + ks * 4096 + half * 2048; }
template <int OFF> DI s16x4 tr_read(int vb) {
  s16x4 r; asm volatile("ds_read_b64_tr_b16 %0, %1 offset:%2" : "=&v"(r) : "v"(vb), "i"(OFF) : "memory"); return r;
}
template <int D0> DI void pv_one(f32x16& od, int vb, bf16x8 pa0, bf16x8 pa1, bf16x8 pa2, bf16x8 pa3) {
  const s16x4 l0 = tr_read<v_rd_off(D0, 0, 0)>(vb), h0 = tr_read<v_rd_off(D0, 0, 1)>(vb), l1 = tr_read<v_rd_off(D0, 1, 0)>(vb), h1 = tr_read<v_rd_off(D0, 1, 1)>(vb);
  const s16x4 l2 = tr_read<v_rd_off(D0, 2, 0)>(vb), h2 = tr_read<v_rd_off(D0, 2, 1)>(vb), l3 = tr_read<v_rd_off(D0, 3, 0)>(vb), h3 = tr_read<v_rd_off(D0, 3, 1)>(vb);
  asm volatile("s_waitcnt lgkmcnt(0)" ::: "memory"); __builtin_amdgcn_sched_barrier(0);
#define PKV(Lo, Hi) (bf16x8){Lo[0], Lo[1], Lo[2], Lo[3], Hi[0], Hi[1], Hi[2], Hi[3]}
  od = MFMA32(pa0, PKV(l0, h0), od);
  od = MFMA32(pa1, PKV(l1, h1), od);
  od = MFMA32(pa2, PKV(l2, h2), od);
  od = MFMA32(pa3, PKV(l3, h3), od);
#undef PKV
}

DI void attn_tile(const P2& p, int li, int item, char* smem) {
  const int tid = opaque_tid(), wid = tid >> 6, lane = tid & 63, r32 = lane & 31, hi = lane >> 5;
  const int cm = wid >> 2, rg = wid & 3;
  const int bh = item / 33, qb = item - bh * 33;
  const int b = bh >> 2, h = bh & 3;
  const u16* Qh = (const u16*)(p.ws + OFF_QN) + (size_t)bh * LP * 128;
  const u16* Kh = (const u16*)(p.ws + OFF_KN) + (size_t)bh * LP * 128;
  const u16* Vh = (const u16*)(p.ws + OFF_VN) + (size_t)bh * 128 * LP;
  const float* cst = (const float*)(p.ws + OFF_CST) + li * 8;
  const float lam = cst[0], oml = cst[1];
  const int lq = qb * 128 + rg * 32 + r32;
  bf16x8 qr[4];
#pragma unroll
  for (int d0 = 0; d0 < 4; ++d0) qr[d0] = *(const bf16x8*)(Qh + (size_t)lq * 128 + cm * 64 + d0 * 16 + hi * 8);
  const int sr = tid >> 4, sc = (tid & 15) * 8;
  const int kst0 = KSWZ(sr, sc * 2), kst1 = KSWZ(32 + sr, sc * 2);
  const int vrow = tid >> 3, vch = tid & 7;
  const int vst0 = 16384 + vrow * 128 + ((vch ^ ((vrow >> 1) & 7)) << 4), vst1 = vst0 + 64 * 128;
  int voff[4];
#pragma unroll
  for (int ks = 0; ks < 4; ++ks) voff[ks] = 16384 + r32 * 128 + (((2 * ks + hi) ^ ((r32 >> 1) & 7)) << 4);
  int koff[4];
#pragma unroll
  for (int d0 = 0; d0 < 4; ++d0) koff[d0] = r32 * 256 + ((cm * 128 + d0 * 32 + hi * 16) ^ ((r32 & 15) << 4));
  f32x16 o[4];
#pragma unroll
  for (int d = 0; d < 4; ++d)
#pragma unroll
    for (int r = 0; r < 16; ++r) o[d][r] = 0.f;
  float lsum = 0.f;
  u32x4 gk0, gk1, gv0, gv1;
  f32x16 pA0, pA1, pB0, pB1;
  bf16x8 pa0, pa1, pa2, pa3;
#define SBAR() __builtin_amdgcn_sched_barrier(0)
  const u16* kp_ = Kh + (size_t)sr * 128 + sc; const u16* vp_ = Vh + (size_t)vrow * LP + vch * 8;
#define LOADT(jt) do { gk0 = *(const u32x4*)(kp_); gk1 = *(const u32x4*)(kp_ + 32 * 128); \
    gv0 = *(const u32x4*)(vp_); gv1 = *(const u32x4*)(vp_ + (size_t)64 * LP); kp_ += 64 * 128; vp_ += 64; } while (0)
#define WRITET(ro) do { *(u32x4*)(smem + (ro) + kst0) = gk0; *(u32x4*)(smem + (ro) + kst1) = gk1; \
    *(u32x4*)(smem + (ro) + vst0) = gv0; *(u32x4*)(smem + (ro) + vst1) = gv1; } while (0)
#define QKMM(P0, P1, kb_) do { _Pragma("unroll") for (int d0 = 0; d0 < 4; ++d0) { \
      const bf16x8 b0_ = *(const bf16x8*)((kb_) + koff[d0]); const bf16x8 b1_ = *(const bf16x8*)((kb_) + koff[d0] + 8192); \
      P0 = MFMA32(b0_, qr[d0], P0); P1 = MFMA32(b1_, qr[d0], P1); } } while (0)
  \
  \
#define QKT(P0, P1, ro, MASKED) do { const char* kb_ = smem + (ro); \
    _Pragma("unroll") for (int r = 0; r < 16; ++r) { P0[r] = 0.f; P1[r] = 0.f; } \
    QKMM(P0, P1, kb_); \
    if (MASKED) { _Pragma("unroll") for (int r = 8; r < 16; ++r) P0[r] = -1e30f; _Pragma("unroll") for (int r = 0; r < 16; ++r) P1[r] = -1e30f; } } while (0)
#define EXPS(P0, P1) do { _Pragma("unroll") for (int r = 0; r < 16; ++r) { P0[r] = __builtin_amdgcn_exp2f(P0[r]); P1[r] = __builtin_amdgcn_exp2f(P1[r]); } } while (0)
#define EXPH(P, B0_) do { _Pragma("unroll") for (int r = 0; r < 8; ++r) P[(B0_) + r] = __builtin_amdgcn_exp2f(P[(B0_) + r]); } while (0)
#define PK4(P, BASE, OUT) do { u32x4 w = {cvtpk(P[BASE + 0], P[BASE + 1]), cvtpk(P[BASE + 2], P[BASE + 3]), cvtpk(P[BASE + 4], P[BASE + 5]), cvtpk(P[BASE + 6], P[BASE + 7])}; \
    OUT = *reinterpret_cast<bf16x8*>(&w); } while (0)
#define PACK(P0, P1) do { float s0_ = P0[0], s1_ = P0[1], s2_ = P0[2], s3_ = P0[3]; \
    _Pragma("unroll") for (int r = 4; r < 16; r += 4) { s0_ = addf(s0_, P0[r]); s1_ = addf(s1_, P0[r + 1]); s2_ = addf(s2_, P0[r + 2]); s3_ = addf(s3_, P0[r + 3]); } \
    _Pragma("unroll") for (int r = 0; r < 16; r += 4) { s0_ = addf(s0_, P1[r]); s1_ = addf(s1_, P1[r + 1]); s2_ = addf(s2_, P1[r + 2]); s3_ = addf(s3_, P1[r + 3]); } \
    lsum += (s0_ + s1_) + (s2_ + s3_); \
    PK4(P0, 0, pa0); PK4(P0, 8, pa1); PK4(P1, 0, pa2); PK4(P1, 8, pa3); } while (0)
#define PVD(D0, vb) do { const bf16x8 v0_ = *(const bf16x8*)((vb) + voff[0] + (D0) * 4096), v1_ = *(const bf16x8*)((vb) + voff[1] + (D0) * 4096); \
    const bf16x8 v2_ = *(const bf16x8*)((vb) + voff[2] + (D0) * 4096), v3_ = *(const bf16x8*)((vb) + voff[3] + (D0) * 4096); \
    o[D0] = MFMA32(pa0, v0_, o[D0]); o[D0] = MFMA32(pa1, v1_, o[D0]); o[D0] = MFMA32(pa2, v2_, o[D0]); o[D0] = MFMA32(pa3, v3_, o[D0]); } while (0)
#define STEP(C0, C1, N0, N1, jj, NX, MASKED) do { const int j_ = (jj); \
    if (j_ + 2 < NKT) WRITET(r2); \
    if (j_ + 3 < NKT) LOADT(j_ + 3); \
    SBAR(); \
    if (act) { if (NX) QKT(N0, N1, r1, MASKED); \
    PACK(C0, C1); } \
    SBAR(); \
    if (act) { const char* vb_ = smem + r0; \
      PVD(0, vb_); if (NX) EXPH(N0, 0); \
      PVD(1, vb_); if (NX) EXPH(N0, 8); \
      PVD(2, vb_); if (NX) EXPH(N1, 0); \
      PVD(3, vb_); if (NX) EXPH(N1, 8); } \
    SBAR(); \
    __syncthreads(); \
    { const int t_ = r0; r0 = r1; r1 = r2; r2 = t_; } } while (0)
  int r0 = 0, r1 = 32768, r2 = 65536;
  LOADT(0); WRITET(0); LOADT(1); WRITET(32768); LOADT(2);
  __syncthreads();
  const bool act = (qb < 32) || (rg == 0);
  QKT(pA0, pA1, 0, 0); EXPS(pA0, pA1);
  for (int j = 0; j < NKT - 3; j += 2) {
    STEP(pA0, pA1, pB0, pB1, j, 1, 0);
    STEP(pB0, pB1, pA0, pA1, j + 1, 1, 0);
  }
  STEP(pA0, pA1, pB0, pB1, NKT - 3, 1, 0);
  STEP(pB0, pB1, pA0, pA1, NKT - 2, 1, 1);
  STEP(pA0, pA1, pB0, pB1, NKT - 1, 0, 0);
#undef STEP
#undef PVD
#undef PACK
#undef PK4
#undef EXPS
#undef EXPH
#undef QKT
#undef QKMM
#undef LOADT
#undef WRITET
  lsum += __shfl_xor(lsum, 32);
  float inv = 1.0f / lsum; if (cm == 1) inv *= lam;
  float* li_l = (float*)(smem + 98304) + wid * 32;
  if (hi == 0) li_l[r32] = inv;
  __syncthreads();
  float rl[16];
#pragma unroll
  for (int r = 0; r < 16; ++r) rl[r] = li_l[crow(r, hi)];
#pragma unroll
  for (int d = 0; d < 4; ++d)
#pragma unroll
    for (int r = 0; r < 16; ++r) o[d][r] *= rl[r];
  float* xbuf = (float*)smem + rg * 4096;
  if (cm == 1) {
#pragma unroll
    for (int d = 0; d < 4; ++d)
#pragma unroll
      for (int r = 0; r < 16; ++r) xbuf[crow(r, hi) * 128 + d * 32 + r32] = o[d][r];
  }
  __syncthreads();
  if (cm == 0) {
    u16* gy = (u16*)(p.ws + OFF_GY); const u16* gg = (const u16*)(p.ws + OFF_GG);
    const float* sg = (const float*)(p.ws + OFF_SMALL) + 512 + li * 128;
    const float s0 = sg[r32], s1 = sg[32 + r32], s2 = sg[64 + r32], s3 = sg[96 + r32];
#pragma unroll
    for (int r = 0; r < 16; ++r) {
      const int rr = crow(r, hi);
      const float v0 = o[0][r] - xbuf[rr * 128 + r32], v1 = o[1][r] - xbuf[rr * 128 + 32 + r32];
      const float v2 = o[2][r] - xbuf[rr * 128 + 64 + r32], v3 = o[3][r] - xbuf[rr * 128 + 96 + r32];
      float ss = v0 * v0 + v1 * v1 + v2 * v2 + v3 * v3;
      ss += __shfl_xor(ss, 1); ss += __shfl_xor(ss, 2); ss += __shfl_xor(ss, 4); ss += __shfl_xor(ss, 8); ss += __shfl_xor(ss, 16);
      const float rinv = rsqrtf(ss * (1.0f / 128.f) + EPS) * oml;
      xbuf[rr * 128 + r32] = v0 * rinv * s0; xbuf[rr * 128 + 32 + r32] = v1 * rinv * s1;
      xbuf[rr * 128 + 64 + r32] = v2 * rinv * s2; xbuf[rr * 128 + 96 + r32] = v3 * rinv * s3;
    }
    asm volatile("s_waitcnt lgkmcnt(0)" ::: "memory");
#pragma unroll
    for (int it = 0; it < 8; ++it) {
      const int rw = it * 4 + (lane >> 4), c8 = (lane & 15) * 8;
      const int l = qb * 128 + rg * 32 + rw;
      const f32x4 a = *(const f32x4*)(xbuf + rw * 128 + c8), c = *(const f32x4*)(xbuf + rw * 128 + c8 + 4);
      if (l < L) {
        const size_t go = ((size_t)(b * L + l)) * DM + 512 + h * 128 + c8;
        const u32x4 gt = *(const u32x4*)(gg + go);
        u32x4 w;
        w[0] = cvtpk(a[0] * __uint_as_float(gt[0] << 16), a[1] * __uint_as_float(gt[0] & 0xffff0000u));
        w[1] = cvtpk(a[2] * __uint_as_float(gt[1] << 16), a[3] * __uint_as_float(gt[1] & 0xffff0000u));
        w[2] = cvtpk(c[0] * __uint_as_float(gt[2] << 16), c[1] * __uint_as_float(gt[2] & 0xffff0000u));
        w[3] = cvtpk(c[2] * __uint_as_float(gt[3] << 16), c[3] * __uint_as_float(gt[3] & 0xffff0000u));
        *(u32x4*)(gy + go) = w;
      }
    }
  }
  __syncthreads();
}

DI void fourier_tile(const P2& p, int li, int item, char* smem) {
  const int tid = opaque_tid(), wid = tid >> 6, lane = tid & 63, fr = lane & 15, fq = lane >> 4;
  const int qd = wid >> 2, wq = wid & 3;
  const int b = item / 36, rem = item - b * 36, g = rem / 9, kt = rem - g * 9;
  const u16* Cm = (const u16*)(p.ws + OFF_CM); const u16* Sm = (const u16*)(p.ws + OFF_SM);
  const u16* uta = (const u16*)(p.ws + OFF_UTA); const u16* utb = (const u16*)(p.ws + OFF_UTB);
  char* As = smem; char* Bs = smem + 65536;
  const int srow = tid >> 3, scc = tid & 7;
  const int soff = srow * 128 + ((scc ^ ((srow >> 1) & 7)) << 4);
  const u16* cgp = Cm + (size_t)(kt * 128 + srow) * KP + scc * 8;
  const u16* sgp = Sm + (size_t)(kt * 128 + srow) * KP + scc * 8;
  const u16* uap = uta + ((size_t)(b * 512 + g * 128 + srow)) * KP + scc * 8;
  const u16* ubp = utb + ((size_t)(b * 512 + g * 128 + srow)) * KP + scc * 8;
  u32x4 raA[4], ruaA[2], rubA[2];
#define FLOAD(ra, rua, rub, k2) do { ra[0] = *(const u32x4*)(cgp + (k2) * 64); ra[1] = *(const u32x4*)(cgp + (size_t)64 * KP + (k2) * 64); \
    ra[2] = *(const u32x4*)(sgp + (k2) * 64); ra[3] = *(const u32x4*)(sgp + (size_t)64 * KP + (k2) * 64); \
    rua[0] = *(const u32x4*)(uap + (k2) * 64); rua[1] = *(const u32x4*)(uap + (size_t)64 * KP + (k2) * 64); \
    rub[0] = *(const u32x4*)(ubp + (k2) * 64); rub[1] = *(const u32x4*)(ubp + (size_t)64 * KP + (k2) * 64); } while (0)
#define FWRITE(ra, rua, rub, bf) do { _Pragma("unroll") for (int i = 0; i < 4; ++i) *(u32x4*)(As + (bf) * 32768 + soff + i * 8192) = ra[i]; \
    _Pragma("unroll") for (int i = 0; i < 2; ++i) { u32x4 ev, ov; \
      _Pragma("unroll") for (int d = 0; d < 4; ++d) { const unsigned ua_ = rua[i][d], ub_ = rub[i][d]; \
        const float al = __uint_as_float(ua_ << 16), ah = __uint_as_float(ua_ & 0xffff0000u); \
        const float bl = __uint_as_float(ub_ << 16), bh_ = __uint_as_float(ub_ & 0xffff0000u); \
        ev[d] = cvtpk(al + bl, ah + bh_); ov[d] = cvtpk(al - bl, ah - bh_); } \
      *(u32x4*)(Bs + (bf) * 32768 + soff + i * 8192) = ev; *(u32x4*)(Bs + (bf) * 32768 + 16384 + soff + i * 8192) = ov; } } while (0)
  f32x4 acc[8][2], acc2[8][2];
#pragma unroll
  for (int m = 0; m < 8; ++m) { acc[m][0] = f32x4{0.f, 0.f, 0.f, 0.f}; acc[m][1] = f32x4{0.f, 0.f, 0.f, 0.f}; acc2[m][0] = f32x4{0.f, 0.f, 0.f, 0.f}; acc2[m][1] = f32x4{0.f, 0.f, 0.f, 0.f}; }
  const bf16x8 sgn = {0, (short)0x8000, 0, (short)0x8000, 0, (short)0x8000, 0, (short)0x8000};
  const int aoff0 = (qd * 128 + fr) * 128, boff0 = (qd * 128 + wq * 32 + fr) * 128, swz = fr >> 1;
  constexpr int NK2 = KP / 64;
#define FCOMP(buf) do { const char* Ab = As + (buf) * 32768; const char* Bb = Bs + (buf) * 32768; \
    _Pragma("unroll") for (int ks = 0; ks < 2; ++ks) { const int co = ((ks * 4 + fq) ^ swz) << 4; \
      const bf16x8 bf0 = *(const bf16x8*)(Bb + boff0 + co), bf1 = *(const bf16x8*)(Bb + boff0 + 2048 + co); \
      const bf16x8 bal0 = bf0 ^ sgn, bal1 = bf1 ^ sgn; \
      _Pragma("unroll") for (int mh = 0; mh < 2; ++mh) { bf16x8 af[4]; \
        _Pragma("unroll") for (int m = 0; m < 4; ++m) af[m] = *(const bf16x8*)(Ab + aoff0 + (mh * 4 + m) * 2048 + co); \
        _Pragma("unroll") for (int m = 0; m < 4; ++m) { acc[mh * 4 + m][0] = MFMA16(af[m], bf0, acc[mh * 4 + m][0]); acc[mh * 4 + m][1] = MFMA16(af[m], bf1, acc[mh * 4 + m][1]); \
          acc2[mh * 4 + m][0] = MFMA16(af[m], bal0, acc2[mh * 4 + m][0]); acc2[mh * 4 + m][1] = MFMA16(af[m], bal1, acc2[mh * 4 + m][1]); } } } } while (0)
  FLOAD(raA, ruaA, rubA, 0); FWRITE(raA, ruaA, rubA, 0);
  __syncthreads();
  for (int k2 = 0; k2 < NK2; ++k2) {
    const int buf = k2 & 1;
    if (k2 + 1 < NK2) FLOAD(raA, ruaA, rubA, k2 + 1);
    FCOMP(buf);
    if (k2 + 1 < NK2) FWRITE(raA, ruaA, rubA, buf ^ 1);
    __syncthreads();
  }
#undef FLOAD
#undef FWRITE
#undef FCOMP
  u16* gy = (u16*)(p.ws + OFF_GY); const u16* gg = (const u16*)(p.ws + OFF_GG);
  const u16* Mb = (const u16*)(p.ws + OFF_MCS) + ((size_t)(li * 4 + g) * 128) * 256;
  const int arow = wid * 16 + fr;
#pragma clang loop unroll(disable)
  for (int pass = 0; pass < 2; ++pass) {
#pragma unroll
    for (int m = 0; m < 8; ++m)
#pragma unroll
      for (int n = 0; n < 2; ++n)
#pragma unroll
        for (int j = 0; j < 4; ++j) {
          const int row = m * 16 + fq * 4 + j, col = qd * 128 + wq * 32 + n * 16 + fr;
          *(u16*)(smem + row * 512 + ((((col >> 3) ^ (row & 15))) << 4) + (col & 7) * 2) = f2bf(acc[m][n][j]);
        }
    __syncthreads();
    f32x4 accP[8], accQ[8];
#pragma unroll
    for (int n = 0; n < 8; ++n) { accP[n] = f32x4{0.f, 0.f, 0.f, 0.f}; accQ[n] = f32x4{0.f, 0.f, 0.f, 0.f}; }
#pragma clang loop unroll(disable)
    for (int ks = 0; ks < 4; ++ks) {
      const bf16x8 a = *(const bf16x8*)(smem + arow * 512 + (((ks * 4 + fq) ^ fr) << 4));
#pragma unroll
      for (int n = 0; n < 8; ++n) {
        const bf16x8 bb = *(const bf16x8*)(Mb + (size_t)(n * 16 + fr) * 256 + ks * 32 + fq * 8);
        accP[n] = MFMA16(a, bb, accP[n]);
      }
    }
#pragma clang loop unroll(disable)
    for (int ks = 4; ks < 8; ++ks) {
      const bf16x8 a = *(const bf16x8*)(smem + arow * 512 + (((ks * 4 + fq) ^ fr) << 4));
#pragma unroll
      for (int n = 0; n < 8; ++n) {
        const bf16x8 bb = *(const bf16x8*)(Mb + (size_t)(n * 16 + fr) * 256 + ks * 32 + fq * 8);
        accQ[n] = MFMA16(a, bb, accQ[n]);
      }
    }
    const float sq = pass ? -1.f : 1.f;
    float* stg = (float*)(smem + 65536 + wid * 8192);
#pragma unroll
    for (int half = 0; half < 2; ++half) {
      const float sh = half ? -sq : sq;
#pragma unroll
      for (int n = 0; n < 8; ++n)
#pragma unroll
        for (int j = 0; j < 4; ++j) stg[(fq * 4 + j) * 128 + n * 16 + fr] = accP[n][j] + sh * accQ[n][j];
      asm volatile("s_waitcnt lgkmcnt(0)" ::: "memory");
#pragma unroll
      for (int it = 0; it < 4; ++it) {
        const int rw = it * 4 + (lane >> 4), c8 = (lane & 15) * 8;
        const int k0 = kt * 128 + wid * 16 + rw;
        const int kk = pass ? LH - k0 : k0;
        bool ok = (k0 <= LH / 2) && !(pass && k0 == LH / 2);
        if (half) ok = ok && (kk >= 1) && (kk < LH);
        const int orow = half ? L - kk : kk;
        const f32x4 a = *(const f32x4*)(stg + rw * 128 + c8), c = *(const f32x4*)(stg + rw * 128 + c8 + 4);
        if (ok) {
          const size_t o1 = ((size_t)(b * L + orow)) * DM + g * 128 + c8;
          const u32x4 gt = *(const u32x4*)(gg + o1);
          u32x4 w;
          w[0] = cvtpk(a[0] * __uint_as_float(gt[0] << 16), a[1] * __uint_as_float(gt[0] & 0xffff0000u));
          w[1] = cvtpk(a[2] * __uint_as_float(gt[1] << 16), a[3] * __uint_as_float(gt[1] & 0xffff0000u));
          w[2] = cvtpk(c[0] * __uint_as_float(gt[2] << 16), c[1] * __uint_as_float(gt[2] & 0xffff0000u));
          w[3] = cvtpk(c[2] * __uint_as_float(gt[3] << 16), c[3] * __uint_as_float(gt[3] & 0xffff0000u));
          *(u32x4*)(gy + o1) = w;
        }
      }
      asm volatile("s_waitcnt lgkmcnt(0)" ::: "memory");
    }
    __syncthreads();
#pragma unroll
    for (int m = 0; m < 8; ++m) { acc[m][0] = acc2[m][0]; acc[m][1] = acc2[m][1]; }
  }
}

constexpr int N_ATT = NB * NH * 33;
constexpr int N_FOU = NB * 4 * 9;
#ifndef REPA
#define REPA 1
#endif
#ifndef REPB
#define REPB 1
#endif
#ifndef REPB_MODE
#define REPB_MODE 0
#endif
DI void phaseB(const P2& p, int li, char* smem, int rep) {
  int* qb_ = (int*)(p.ws + OFF_Q) + (li * 2 + rep) * 256;
  unsigned* bdone = (unsigned*)(p.ws + OFF_Q) + (li * 2) * 256 + 128;
  int* s_item = (int*)(smem + 131072);
  unsigned* sig1 = (unsigned*)(p.ws + OFF_CNT) + 40 + 2 * li + 1;
  const int myx = (int)(__builtin_amdgcn_s_getreg((3 << 11) | 20) & 7u);
  int d = 0;
  for (;;) {
    if (threadIdx.x == 0) {
      int dd = d, idx = -1, xq = 0;
      while (dd < 8) {
        xq = (myx + dd) & 7;
        idx = atomicAdd(qb_ + xq * 16, 1);
        if (idx < 168) break;
        idx = -1; ++dd;
      }
      s_item[0] = idx; s_item[1] = xq; s_item[3] = dd;
    }
    __syncthreads();
    const int idx = __builtin_amdgcn_readfirstlane(s_item[0]), xq = __builtin_amdgcn_readfirstlane(s_item[1]);
    d = __builtin_amdgcn_readfirstlane(s_item[3]);
    __syncthreads();
    if (idx < 0) break;
    const int grp = idx / 42, r = idx - grp * 42;
    int isf, sub;
    if (grp < 3) { const int f0 = (r * 9) / 42, f1 = ((r + 1) * 9) / 42; isf = f1 > f0; sub = isf ? f0 : r - f0; }
    else { isf = r >= 33; sub = isf ? r - 33 : r; }
    const int pair = xq + 8 * grp, bat = pair >> 2;
    if (bat == NB - 1) wait_sig(sig1, 96u);
    if (!isf) attn_tile(p, li, pair * 33 + sub, smem);
    else fourier_tile(p, li, bat * 36 + (pair & 3) * 9 + sub, smem);
  }
}

__global__ void __launch_bounds__(512) mega(Params p, int ph_begin, int ph_end) {
  __shared__ __attribute__((aligned(16))) char smem[131072 + 64 + 1024];
  if (ph_begin == 0) {
    phase0(p, smem);
    if (ph_end > 1) cg::this_grid().sync();
  }
  P2 q; q.out = p.out; q.ws = p.ws; q.x = p.x; q.meta = p.meta;
  unsigned nbar = 0;
#pragma clang loop unroll(disable)
  for (int ph = (ph_begin < 1 ? 1 : ph_begin); ph < ph_end; ++ph) {
    const int li = (ph - 1) / 3, s = (ph - 1) % 3;
    unsigned* sig0 = (unsigned*)(q.ws + OFF_CNT) + 40 + 2 * li;
    unsigned* sig1 = sig0 + 1;
    const int bx = blockIdx.x;
    { int mode = -1, lc = li;
      if (s == 2) mode = 0; else if (s == 1 && li > 0 && bx < 4) { mode = 1; lc = li - 1; }
      if (mode >= 0) phaseC(q, lc, smem, mode, bx, sig0); }
    { int mode = -1;
      if (s == 0) mode = 0; else if (s == 1 && bx >= 4 && bx < 16) { mode = 1; wait_sig(sig0, li > 0 ? 32u : 0u); }
      if (mode >= 0) phaseA(q, li, smem, mode, bx - 4, sig1); }
    if (s == 1) { for (int rep = 0; rep < REPB; ++rep) phaseB(q, li, smem, rep); }
    if (ph + 1 < ph_end) { ++nbar; grid_barrier((unsigned*)(q.ws + OFF_CNT) + 32, nbar * gridDim.x); }
  }
}

extern "C" void kernel_launch(void* const* d_in, const int* in_sizes, int n_in, void* d_out, int out_size, void* d_ws, size_t ws_size, hipStream_t stream) {
  if (ws_size < WS_END) { fprintf(stderr, "workspace too small: %zu < %zu\n", ws_size, (size_t)WS_END); return; }
  Params p{};
  p.x = (const float*)d_in[0]; p.meta = (const float*)d_in[1]; p.norm_gain = (const float*)d_in[2]; p.w_in = (const float*)d_in[3];
  p.w_f = (const float*)d_in[4]; p.qg = (const float*)d_in[5]; p.kg = (const float*)d_in[6]; p.lq1 = (const float*)d_in[7];
  p.lk1 = (const float*)d_in[8]; p.lq2 = (const float*)d_in[9]; p.lk2 = (const float*)d_in[10]; p.subln = (const float*)d_in[11];
  p.w_out = (const float*)d_in[12]; p.out = (float*)d_out; p.ws = (char*)d_ws;
  constexpr int NPH = 1 + 3 * DEPTH;
#if MULTI_LAUNCH
  for (int ph = 0; ph < NPH; ++ph) hipLaunchKernelGGL(mega, dim3(256), dim3(512), 0, stream, p, ph, ph + 1);
#else
  static int grid_blocks = 0;
  if (!grid_blocks) {
    int dev = 0, cus = 0, per_cu = 0;
    hipGetDevice(&dev);
    hipDeviceGetAttribute(&cus, hipDeviceAttributeMultiprocessorCount, dev);
    hipOccupancyMaxActiveBlocksPerMultiprocessor(&per_cu, mega, 512, 0);
    if (per_cu < 1) per_cu = 1;
    grid_blocks = cus * 1;
  }
  int b0 = 0, b1 = NPH;
  void* args[] = {&p, &b0, &b1};
  hipError_t e = hipLaunchCooperativeKernel((void*)mega, dim3(grid_blocks), dim3(512), args, 0, stream);
  if (e != hipSuccess) fprintf(stderr, "cooperative launch failed: %s (grid %d)\n", hipGetErrorString(e), grid_blocks);
#endif
}
```

```cpp
#include <hip/hip_runtime.h>
#include <hip/hip_bf16.h>
#include <hip/hip_cooperative_groups.h>
#include <cstdio>
#include <cstdint>
namespace cg = cooperative_groups;

#ifndef MULTI_LAUNCH
#define MULTI_LAUNCH 0
#endif

typedef unsigned short u16;
using bf16x8 = __attribute__((ext_vector_type(8))) short;
using s16x4  = __attribute__((ext_vector_type(4))) short;
using f32x4  = __attribute__((ext_vector_type(4))) float;
using f32x16 = __attribute__((ext_vector_type(16))) float;
using u32x4  = __attribute__((ext_vector_type(4))) unsigned;
using u32x2  = __attribute__((ext_vector_type(2))) unsigned;

constexpr int NB = 8, SEQ = 4096, NMETA = 16, L = 4112, DM = 1024, DEPTH = 4;
constexpr int R = NB * L;
constexpr int RP = 33024;
constexpr int INW = 3072;
constexpr int NH = 4;
constexpr int LP = 4224;
constexpr int LH = 2056;
constexpr int KROWS = 2176;
constexpr int KP = 2112;
constexpr int NKT = 65;
constexpr float EPS = 1e-6f;

constexpr size_t al256(size_t x) { return (x + 255) / 256 * 256; }
constexpr size_t OFF_META = 0;
constexpr size_t OFF_XB   = al256(OFF_META + (size_t)NB * NMETA * DM * 4);
constexpr size_t OFF_GY   = al256(OFF_XB + (size_t)RP * DM * 2);
constexpr size_t OFF_QN   = al256(OFF_GY + (size_t)RP * DM * 2);
constexpr size_t QKV_BYTES = (size_t)NB * NH * LP * 128 * 2;
constexpr size_t OFF_KN   = al256(OFF_QN + QKV_BYTES);
constexpr size_t OFF_VN   = al256(OFF_KN + QKV_BYTES);
constexpr size_t OFF_WIN  = al256(OFF_VN + QKV_BYTES);
constexpr size_t OFF_WOUT = al256(OFF_WIN + (size_t)DEPTH * INW * DM * 2);
constexpr size_t OFF_CM   = al256(OFF_WOUT + (size_t)DEPTH * DM * DM * 2);
constexpr size_t OFF_SM   = al256(OFF_CM + (size_t)KROWS * KP * 2);
constexpr size_t OFF_MCS  = al256(OFF_SM + (size_t)KROWS * KP * 2);
constexpr size_t OFF_UTA  = al256(OFF_MCS + (size_t)DEPTH * 4 * 128 * 256 * 2);
constexpr size_t OFF_UTB  = al256(OFF_UTA + (size_t)NB * 512 * KP * 2);
constexpr size_t OFF_RSS  = al256(OFF_UTB + (size_t)NB * 512 * KP * 2);
constexpr size_t OFF_ROPE = al256(OFF_RSS + (size_t)RP * 16 * 4);
constexpr size_t OFF_CST  = al256(OFF_ROPE + (size_t)L * 16 * 4);
constexpr size_t OFF_SMALL = al256(OFF_CST + 256);
constexpr size_t OFF_CNT  = al256(OFF_SMALL + 4096);
constexpr size_t OFF_GG   = al256(OFF_CNT + 256);
constexpr size_t OFF_Q    = al256(OFF_GG + (size_t)RP * DM * 2);
constexpr size_t WS_END   = OFF_Q + 4 * 2 * 16 * 16 * 4;

struct Params {
  const float *x, *meta, *norm_gain, *w_in, *w_f, *qg, *kg, *lq1, *lk1, *lq2, *lk2, *subln, *w_out;
  float* out;
  char* ws;
};

struct P2 { float* out; char* ws; const float* x; const float* meta; };
__device__ __forceinline__ void grid_barrier(unsigned* bar, unsigned target) {
  asm volatile("s_waitcnt vmcnt(0) lgkmcnt(0)" ::: "memory");
  __syncthreads();
  if (threadIdx.x == 0) {
    __builtin_amdgcn_fence(__ATOMIC_RELEASE, "agent");
    asm volatile("s_waitcnt vmcnt(0)" ::: "memory");
    __hip_atomic_fetch_add(bar, 1u, __ATOMIC_RELAXED, __HIP_MEMORY_SCOPE_AGENT);
    while (__hip_atomic_load(bar, __ATOMIC_RELAXED, __HIP_MEMORY_SCOPE_AGENT) < target) __builtin_amdgcn_s_sleep(2);
    __builtin_amdgcn_fence(__ATOMIC_ACQUIRE, "agent");
    asm volatile("s_waitcnt vmcnt(0)" ::: "memory");
  }
  __syncthreads();
}
#define DI __device__ __forceinline__
#define MFMA16(a, b, c) __builtin_amdgcn_mfma_f32_16x16x32_bf16((a), (b), (c), 0, 0, 0)
#define MFMA32(a, b, c) __builtin_amdgcn_mfma_f32_32x32x16_bf16((a), (b), (c), 0, 0, 0)

using bf16v2 = __attribute__((ext_vector_type(2))) __bf16;
DI void wait_sig(unsigned* sig, unsigned target) {
  if (threadIdx.x == 0) {
    while (__hip_atomic_load(sig, __ATOMIC_RELAXED, __HIP_MEMORY_SCOPE_AGENT) < target) __builtin_amdgcn_s_sleep(2);
    __builtin_amdgcn_fence(__ATOMIC_ACQUIRE, "agent");
    asm volatile("s_waitcnt vmcnt(0)" ::: "memory");
  }
  __syncthreads();
}
DI unsigned cvtpk(float lo, float hi) { bf16v2 v; v[0] = (__bf16)lo; v[1] = (__bf16)hi; return __builtin_bit_cast(unsigned, v); }
DI u16 f2bf(float x) { return (u16)(cvtpk(x, x) & 0xffffu); }
DI float bf2f(u16 v) { return __uint_as_float(((unsigned)v) << 16); }
DI float wave_sum(float v) { for (int o = 32; o; o >>= 1) v += __shfl_xor(v, o); return v; }
DI float wave_max(float v) { for (int o = 32; o; o >>= 1) v = fmaxf(v, __shfl_xor(v, o)); return v; }
DI float addf(float a, float b) { float r; asm volatile("v_add_f32 %0, %1, %2" : "=v"(r) : "v"(a), "v"(b)); return r; }
DI int crow(int r, int hi) { return (r & 3) + 8 * (r >> 2) + 4 * hi; }

DI float* hres_row(const Params& p, int row) {
  const int b = row / L, l = row - b * L;
  return l < NMETA ? (float*)(p.ws + OFF_META) + (size_t)(b * NMETA + l) * DM
                   : p.out + ((size_t)b * SEQ + (l - NMETA)) * DM;
}

DI void row_bl(int row, int b0, int& b, int& l) { b = b0 + ((row >= (b0 + 1) * L) ? 1 : 0); l = row - b * L; }
#define CBAR() asm volatile("" ::: "memory")
DI int opaque_tid() { int t = threadIdx.x; asm volatile("" : "+v"(t)); return t; }

__device__ const double INVF[8] = {1.0, 0.19392274474868576, 0.03760603093086393, 0.007292664737217109, 0.001414213562373095, 0.0002742481756762073, 5.318295896944988e-05, 1.031338537721246e-05};

DI void phase0(const Params& p, char* smem) {
  const int tid = threadIdx.x, gtid = blockIdx.x * 512 + tid, gsz = gridDim.x * 512;
  const int lane = tid & 63, gw = gtid >> 6, nw = gsz >> 6;
  u16* xb = (u16*)(p.ws + OFF_XB);
  float* rss = (float*)(p.ws + OFF_RSS);
  for (int row = gw; row < RP; row += nw) {
    if (row < R) {
      const int b = row / L, l = row - b * L;
      const float* src = l < NMETA ? p.meta + (size_t)l * DM : p.x + ((size_t)b * SEQ + (l - NMETA)) * DM;
      float ss = 0.f;
#pragma unroll
      for (int i = 0; i < 4; ++i) {
        const f32x4 v = *(const f32x4*)(src + i * 256 + lane * 4);
        ss += v[0] * v[0] + v[1] * v[1] + v[2] * v[2] + v[3] * v[3];
        u32x2 o = {cvtpk(v[0], v[1]), cvtpk(v[2], v[3])};
        *(u32x2*)(xb + (size_t)row * DM + i * 256 + lane * 4) = o;
      }
      ss = wave_sum(ss);
      if (lane == 0) rss[(size_t)row * 16] = ss;
    } else {
#pragma unroll
      for (int i = 0; i < 4; ++i) { u32x2 o = {0u, 0u}; *(u32x2*)(xb + (size_t)row * DM + i * 256 + lane * 4) = o; }
      if (lane == 0) rss[(size_t)row * 16] = 1024.f;
    }
    if (lane >= 1 && lane < 16) rss[(size_t)row * 16 + lane] = 0.f;
  }
  {
    u16* WinT = (u16*)(p.ws + OFF_WIN);
    for (long it = gtid; it < (long)DEPTH * 128 * INW; it += gsz) {
      const int nd = (int)(it % INW); const long t2 = it / INW; const int kc = (int)(t2 % 128), li = (int)(t2 / 128);
      const int c1 = nd & 255;
      const int n = (nd & ~255) + ((c1 >> 5) & 3) * 64 + (c1 >> 7) * 32 + (c1 & 31);
      const float* w = p.w_in + ((size_t)li * DM + kc * 8) * INW + n;
      const float* g = p.norm_gain + li * DM + kc * 8;
      float v[8];
#pragma unroll
      for (int j = 0; j < 8; ++j) v[j] = w[(size_t)j * INW] * g[j];
      u32x4 o = {cvtpk(v[0], v[1]), cvtpk(v[2], v[3]), cvtpk(v[4], v[5]), cvtpk(v[6], v[7])};
      *(u32x4*)(WinT + ((size_t)li * INW + nd) * DM + kc * 8) = o;
    }
  }
  {
    u16* WoutT = (u16*)(p.ws + OFF_WOUT);
    for (long it = gtid; it < (long)DEPTH * 128 * DM; it += gsz) {
      const int n = (int)(it % DM); const long t2 = it / DM; const int kc = (int)(t2 % 128), li = (int)(t2 / 128);
      const float* w = p.w_out + ((size_t)li * DM + kc * 8) * DM + n;
      float v[8];
#pragma unroll
      for (int j = 0; j < 8; ++j) v[j] = w[(size_t)j * DM];
      u32x4 o = {cvtpk(v[0], v[1]), cvtpk(v[2], v[3]), cvtpk(v[4], v[5]), cvtpk(v[6], v[7])};
      *(u32x4*)(WoutT + ((size_t)li * DM + n) * DM + kc * 8) = o;
    }
  }
  {
    u16* Cm = (u16*)(p.ws + OFF_CM); u16* Sm = (u16*)(p.ws + OFF_SM);
    for (int it = gtid; it < KROWS * (KP / 8); it += gsz) {
      const int k = it / (KP / 8), j0 = (it % (KP / 8)) * 8;
      float c[8], s[8];
#pragma unroll
      for (int jj = 0; jj < 8; ++jj) {
        const int j = j0 + jj;
        const bool valid = (k <= LH) && (j <= LH);
        const int m = valid ? (k * j) % L : 0;
        const float rev = (float)m / (float)L;
        c[jj] = valid ? __builtin_amdgcn_cosf(rev) : 0.f;
        s[jj] = valid ? __builtin_amdgcn_sinf(rev) : 0.f;
      }
      u32x4 oc = {cvtpk(c[0], c[1]), cvtpk(c[2], c[3]), cvtpk(c[4], c[5]), cvtpk(c[6], c[7])};
      u32x4 os = {cvtpk(s[0], s[1]), cvtpk(s[2], s[3]), cvtpk(s[4], s[5]), cvtpk(s[6], s[7])};
      *(u32x4*)(Cm + (size_t)k * KP + j0) = oc;
      *(u32x4*)(Sm + (size_t)k * KP + j0) = os;
    }
  }
  {
    u16* Mcs = (u16*)(p.ws + OFF_MCS);
    const float norm = 1.0f / sqrtf((float)L * 128.f);
    float* Wl = (float*)smem;
    float* tcs = (float*)(smem + 65536);
    float* tsn = tcs + 128;
    for (int u = blockIdx.x; u < DEPTH * 4 * 16; u += gridDim.x) {
      const int lg = u >> 4, ccb = u & 15;
      const float* wf = p.w_f + (size_t)lg * 128 * 128;
#pragma unroll
      for (int i = 0; i < 8; ++i) *(f32x4*)(Wl + (tid + 512 * i) * 4) = *(const f32x4*)(wf + (tid + 512 * i) * 4);
      if (tid < 128) { const float rev = (float)tid * (1.0f / 128.f); tcs[tid] = __builtin_amdgcn_cosf(rev); tsn[tid] = __builtin_amdgcn_sinf(rev); }
      __syncthreads();
      const int e = tid & 127, cc0 = ccb * 16 + (tid >> 7) * 4;
      const bool isS = ccb >= 8;
      const float* tab = isS ? tsn : tcs;
      const int c0 = cc0 & 127;
      float a0 = 0.f, a1 = 0.f, a2 = 0.f, a3 = 0.f;
      for (int m = 0; m < 128; ++m) {
        const float w = Wl[m * 128 + e];
        a0 += tab[(m * c0) & 127] * w; a1 += tab[(m * (c0 + 1)) & 127] * w; a2 += tab[(m * (c0 + 2)) & 127] * w; a3 += tab[(m * (c0 + 3)) & 127] * w;
      }
      const float sn = isS ? -norm : norm;
      u32x2 o = {cvtpk(a0 * sn, a1 * sn), cvtpk(a2 * sn, a3 * sn)};
      *(u32x2*)(Mcs + ((size_t)lg * 128 + e) * 256 + cc0) = o;
      __syncthreads();
    }
  }
  {
    u16* uta = (u16*)(p.ws + OFF_UTA); u16* utb = (u16*)(p.ws + OFF_UTB);
    for (int it = gtid; it < NB * 512 * 64; it += gsz) {
      const int row = it >> 6, i = it & 63;
      if (i < 55) { uta[(size_t)row * KP + 2057 + i] = 0; utb[(size_t)row * KP + 2057 + i] = 0; }
      else if (i == 55) utb[(size_t)row * KP] = 0;
      else if (i == 56) utb[(size_t)row * KP + LH] = 0;
    }
  }
  {
    u16* qn = (u16*)(p.ws + OFF_QN); u16* kn = (u16*)(p.ws + OFF_KN); u16* vt = (u16*)(p.ws + OFF_VN);
    for (int it = gtid; it < NB * NH * (LP - L) * 16; it += gsz) {
      const int ch = it & 15, rr = (it >> 4) % (LP - L), bh = (it >> 4) / (LP - L);
      const size_t off = ((size_t)bh * LP + L + rr) * 128 + ch * 8;
      u32x4 z = {0u, 0u, 0u, 0u};
      *(u32x4*)(qn + off) = z; *(u32x4*)(kn + off) = z;
    }
    for (int it = gtid; it < NB * NH * 128 * ((LP - L) / 8); it += gsz) {
      const int ch = it % ((LP - L) / 8), row = it / ((LP - L) / 8);
      u32x4 z = {0u, 0u, 0u, 0u};
      *(u32x4*)(vt + (size_t)row * LP + L + ch * 8) = z;
    }
  }
  {
    float* rope = (float*)(p.ws + OFF_ROPE);
    for (int it = gtid; it < L * 8; it += gsz) {
      const int l = it >> 3, i = it & 7;
      double rv = (double)l * INVF[i] * 0.15915494309189535;
      rv -= floor(rv);
      const float r = (float)rv;
      rope[l * 16 + i] = __builtin_amdgcn_cosf(r);
      rope[l * 16 + 8 + i] = __builtin_amdgcn_sinf(r);
    }
  }
  if (blockIdx.x == 0) {
    const int wid = tid >> 6;
    if (wid < DEPTH) {
      const int li = wid;
      float a = p.lq1[li * 64 + lane] * p.lk1[li * 64 + lane];
      float bq = p.lq2[li * 64 + lane] * p.lk2[li * 64 + lane];
      a = wave_sum(a); bq = wave_sum(bq);
      const float gq = wave_max(fabsf(p.qg[li * 64 + lane]));
      const float gk = wave_max(fabsf(p.kg[li * 64 + lane]));
      if (lane == 0) {
        float* cst = (float*)(p.ws + OFF_CST) + li * 8;
        const float lam_init = 0.8f - 0.6f * expf(-0.3f * (float)li);
        cst[0] = expf(a) - expf(bq) + lam_init;
        cst[1] = 1.0f - lam_init;
        cst[2] = (8.0f * gq * gk * 1.01f + 0.05f) * 1.4426950408889634f;
      }
    }
    if (tid < 64) ((int*)(p.ws + OFF_CNT))[tid] = 0;
    for (int i = tid; i < 4 * 2 * 16 * 16; i += 512) ((int*)(p.ws + OFF_Q))[i] = 0;
    float* sm = (float*)(p.ws + OFF_SMALL);
    if (tid < 256) { sm[tid] = p.qg[tid]; sm[256 + tid] = p.kg[tid]; }
    sm[512 + tid] = p.subln[tid];
  }
}

namespace pg8 {
#define PG8_LAS __attribute__((address_space(3)))
constexpr int BM = 256, BK = 64, HALF = 128, HTB = HALF * BK * 2, NXCD = 8, WGM = 8;
DI int lds_byte(int r, int c) { const int st = (r >> 4) * 2 + (c >> 5), rr = r & 15, cc = c & 31, ob = rr * 64 + cc * 2; return st * 1024 + (ob ^ (((ob >> 9) & 1) << 5)); }
DI void stage_rc(int b, int& R, int& C) { const int st = b / 1024, sb = b % 1024, swz = sb ^ (((sb >> 9) & 1) << 5); R = (st >> 1) * 16 + swz / 64; C = (st & 1) * 32 + (swz % 64) / 2; }
DI int perm32(int rho) { const int n = rho >> 4, i = rho & 15; return 8 * (i >> 2) + 4 * n + (i & 3); }
struct Unit { int pm, pn; };
struct Gemm { const u16* A; const u16* Bt; int M, N, K; };
struct StaticOrder {
  int nM, nN, nwg, G, c;
  DI void init(int M, int N, int G_, int c_) { nM = M / BM; nN = N / BM; nwg = nM * nN; G = G_; c = c_; }
  DI bool next(int i, Unit& u) const {
    const long Lx = (long)i * G + c; if (Lx >= nwg) return false;
    int wgid = (int)Lx; { const int q = nwg / NXCD, r = nwg % NXCD, xcd = wgid % NXCD, off = wgid / NXCD; wgid = (xcd < r ? xcd * (q + 1) : r * (q + 1) + (xcd - r) * q) + off; }
    const int nig = WGM * nN, gid = wgid / nig, fm = gid * WGM, gsz = (nM - fm) < WGM ? (nM - fm) : WGM;
    u.pm = fm + ((wgid % nig) % gsz); u.pn = (wgid % nig) / gsz; return true;
  }
  DI void done(int) const {}
};
struct Order {
  int mode; StaticOrder st; int pm, pn; unsigned* sig;
  const unsigned* bready;
  DI void a_ready(const Unit& u) const {
    if (bready == nullptr) return;
    if (threadIdx.x < 64) {
      const int b1 = (u.pm * 256) / L; int b2 = (u.pm * 256 + 255) / L; if (b2 > NB - 1) b2 = NB - 1;
      while ((unsigned)__builtin_amdgcn_readfirstlane(__hip_atomic_load(bready + b1 * 16, __ATOMIC_RELAXED, __HIP_MEMORY_SCOPE_AGENT)) < 200u ||
             (unsigned)__builtin_amdgcn_readfirstlane(__hip_atomic_load(bready + b2 * 16, __ATOMIC_RELAXED, __HIP_MEMORY_SCOPE_AGENT)) < 200u) __builtin_amdgcn_s_sleep(2);
      __builtin_amdgcn_fence(__ATOMIC_ACQUIRE, "agent");
      asm volatile("s_waitcnt vmcnt(0)" ::: "memory");
    }
    asm volatile("" ::: "memory"); __builtin_amdgcn_s_barrier(); asm volatile("" ::: "memory");
  }
  DI bool next(int i, Unit& u) const { if (mode == 0) return st.next(i, u); if (i != 0) return false; u.pm = pm; u.pn = pn; return true; }
  DI void done(int lane) const {
    if (mode == 1) {
      asm volatile("s_waitcnt vmcnt(0)" ::: "memory");
      __builtin_amdgcn_fence(__ATOMIC_RELEASE, "agent");
      asm volatile("s_waitcnt vmcnt(0)" ::: "memory");
      if (lane == 0) __hip_atomic_fetch_add(sig, 1u, __ATOMIC_RELAXED, __HIP_MEMORY_SCOPE_AGENT);
    }
  }
};
template <class Epi, class Sched>
DI void gemm_phase(PG8_LAS unsigned char* lds, const Gemm g, const Sched& S, const Epi& E) {
  const int tid = opaque_tid(), wid = __builtin_amdgcn_readfirstlane(tid >> 6), lane = tid & 63, wr = wid >> 2, wc = wid & 3, fr = lane & 15, fq = lane >> 4;
  const int K = g.K, nt = K / BK;
  unsigned voffA[2], voffB[2];
#pragma unroll
  for (int i = 0; i < 2; ++i) { int R_, C_; stage_rc(tid * 16 + i * 8192, R_, C_); const int Rb = (R_ & ~31) + perm32(R_ & 31);
    voffA[i] = (unsigned)(R_ * K + C_) * 2u; voffB[i] = (unsigned)(Rb * K + C_) * 2u; }
  const size_t kstep = (size_t)(BK * 2);
  const size_t hstep = (size_t)HALF * K * 2;
  const size_t tstep = 2 * hstep;
  const unsigned ldsw = (unsigned)wid * 1024u;
  const int aoff = lds_byte(wr * 64 + fr, fq * 8), boff = lds_byte(wc * 32 + fr, fq * 8);
#define PG8_SA(b, h) (((b) * 2 + (h)) * HTB)
#define PG8_SB(b, h) ((4 + (b) * 2 + (h)) * HTB)
#define PG8_STAGE(bufoff, gbase, voff) do { _Pragma("unroll") for (int _i = 0; _i < 2; ++_i) \
    __builtin_amdgcn_global_load_lds((const unsigned*)((const char*)(gbase) + (voff)[_i]), (PG8_LAS unsigned*)(lds + (bufoff) + ldsw + _i * 8192), 16, 0, 0); } while (0)
#define PG8_LDA(dst, b, h) do { _Pragma("unroll") for (int m = 0; m < 4; ++m) _Pragma("unroll") for (int k = 0; k < 2; ++k) dst[m][k] = *(const PG8_LAS bf16x8*)(lds + PG8_SA(b, h) + aoff + m * 2048 + k * 1024); } while (0)
#define PG8_LDB(dst, b, h) do { _Pragma("unroll") for (int n = 0; n < 2; ++n) _Pragma("unroll") for (int k = 0; k < 2; ++k) dst[n][k] = *(const PG8_LAS bf16x8*)(lds + PG8_SB(b, h) + boff + n * 2048 + k * 1024); } while (0)
#define PG8_MMA(ai, bj, At, Bt) do { __builtin_amdgcn_s_setprio(1); _Pragma("unroll") for (int m = 0; m < 4; ++m) _Pragma("unroll") for (int n = 0; n < 2; ++n) _Pragma("unroll") for (int k = 0; k < 2; ++k) \
    acc[ai][bj][m][n] = __builtin_amdgcn_mfma_f32_16x16x32_bf16(Bt[n][k], At[m][k], acc[ai][bj][m][n], 0, 0, 0); __builtin_amdgcn_s_setprio(0); } while (0)
#define PG8_WAIT_V(n) asm volatile("s_waitcnt vmcnt(" #n ")" ::: "memory")
#define PG8_WAIT_L(n) asm volatile("s_waitcnt lgkmcnt(" #n ")" ::: "memory")
#define PG8_BAR __builtin_amdgcn_s_barrier()
#define PG8_SCHED __builtin_amdgcn_sched_barrier(0)
  Unit cur, nxt; int ui = 0;
  if (!S.next(0, cur)) return;
  f32x4 acc[2][2][4][2];
#pragma unroll
  for (int a = 0; a < 2; ++a)
#pragma unroll
    for (int b = 0; b < 2; ++b)
#pragma unroll
      for (int m = 0; m < 4; ++m)
#pragma unroll
        for (int n = 0; n < 2; ++n) acc[a][b][m][n] = (f32x4){0.f, 0.f, 0.f, 0.f};
  bf16x8 At[4][2], B0[2][2], B1[2][2];
  const char* cA = (const char*)g.A + (size_t)cur.pm * tstep; const char* cB = (const char*)g.Bt + (size_t)cur.pn * tstep;
  S.a_ready(cur);
  PG8_STAGE(PG8_SB(0, 0), cB, voffB); PG8_STAGE(PG8_SA(0, 0), cA, voffA); PG8_STAGE(PG8_SB(0, 1), cB + hstep, voffB); PG8_STAGE(PG8_SA(0, 1), cA + hstep, voffA);
  if (wr == 1) PG8_BAR;
  PG8_WAIT_V(4); PG8_BAR;
  PG8_STAGE(PG8_SB(1, 0), cB + kstep, voffB); PG8_STAGE(PG8_SA(1, 0), cA + kstep, voffA); PG8_STAGE(PG8_SB(1, 1), cB + hstep + kstep, voffB);
  PG8_WAIT_V(6); PG8_BAR;
  for (;;) {
    const bool has_next = S.next(ui + 1, nxt);
    const char* nA = has_next ? (const char*)g.A + (size_t)nxt.pm * tstep : cA; const char* nB = has_next ? (const char*)g.Bt + (size_t)nxt.pn * tstep : cB;
    for (int t = 0; t < nt; t += 2) {
      const bool last = (t == nt - 2);
      const char* a1 = cA + (size_t)(t + 1) * kstep;
      const char* a2 = last ? nA : cA + (size_t)(t + 2) * kstep; const char* b2 = last ? nB : cB + (size_t)(t + 2) * kstep;
      const char* a3 = a2 + kstep; const char* b3 = b2 + kstep;
      if (last && has_next) S.a_ready(nxt);
      PG8_LDB(B0, 0, 0); PG8_SCHED; PG8_LDA(At, 0, 0); PG8_STAGE(PG8_SA(1, 1), a1 + hstep, voffA);
      PG8_WAIT_L(8); PG8_BAR; PG8_WAIT_L(0); PG8_MMA(0, 0, At, B0); PG8_BAR; PG8_SCHED;
      PG8_LDB(B1, 0, 1); PG8_STAGE(PG8_SB(0, 0), b2, voffB);
      PG8_BAR; PG8_WAIT_L(0); PG8_MMA(0, 1, At, B1); PG8_BAR;
      PG8_LDA(At, 0, 1); PG8_STAGE(PG8_SA(0, 0), a2, voffA);
      PG8_BAR; PG8_WAIT_L(0); PG8_MMA(1, 0, At, B0); PG8_BAR; PG8_SCHED;
      PG8_STAGE(PG8_SB(0, 1), b2 + hstep, voffB);
      PG8_WAIT_V(6); PG8_BAR; PG8_MMA(1, 1, At, B1); PG8_BAR;
      PG8_LDB(B0, 1, 0); PG8_SCHED; PG8_LDA(At, 1, 0); PG8_STAGE(PG8_SA(0, 1), a2 + hstep, voffA);
      PG8_WAIT_L(8); PG8_BAR; PG8_WAIT_L(0); PG8_MMA(0, 0, At, B0); PG8_BAR; PG8_SCHED;
      PG8_LDB(B1, 1, 1); PG8_STAGE(PG8_SB(1, 0), b3, voffB);
      PG8_BAR; PG8_WAIT_L(0); PG8_MMA(0, 1, At, B1); PG8_BAR;
      PG8_LDA(At, 1, 1); PG8_STAGE(PG8_SA(1, 0), a3, voffA);
      PG8_BAR; PG8_WAIT_L(0); PG8_MMA(1, 0, At, B0); PG8_BAR; PG8_SCHED;
      PG8_STAGE(PG8_SB(1, 1), b3 + hstep, voffB);
      PG8_WAIT_V(6); PG8_BAR; PG8_MMA(1, 1, At, B1); PG8_BAR;
    }
    E(acc, cur, wr, wc, fr, fq);
    S.done(lane);
    if (!has_next) break;
#pragma unroll
    for (int a = 0; a < 2; ++a)
#pragma unroll
      for (int b = 0; b < 2; ++b)
#pragma unroll
        for (int m = 0; m < 4; ++m)
#pragma unroll
          for (int n = 0; n < 2; ++n) acc[a][b][m][n] = (f32x4){0.f, 0.f, 0.f, 0.f};
    cur = nxt; cA = nA; cB = nB; ++ui;
  }
  PG8_WAIT_V(0);
  if (wr == 0) PG8_BAR;
  PG8_BAR;
#undef PG8_SA
#undef PG8_SB
#undef PG8_STAGE
#undef PG8_LDA
#undef PG8_LDB
#undef PG8_MMA
#undef PG8_WAIT_V
#undef PG8_WAIT_L
#undef PG8_BAR
#undef PG8_SCHED
}
}

DI float row_scale(const float* rsp, int row) {
  const f32x4* rp = (const f32x4*)(rsp + (size_t)row * 16);
  const f32x4 a0 = rp[0], a1 = rp[1], a2 = rp[2], a3 = rp[3];
  const float s = ((a0[0] + a0[1]) + (a0[2] + a0[3])) + ((a1[0] + a1[1]) + (a1[2] + a1[3])) + ((a2[0] + a2[1]) + (a2[2] + a2[3])) + ((a3[0] + a3[1]) + (a3[2] + a3[3]));
  return rsqrtf(s * (1.0f / DM) + EPS);
}

struct EpiA {
  char* ws; int li;
  DI void operator()(const f32x4 (&acc)[2][2][4][2], const pg8::Unit& u, int wr, int wc, int fr, int fq) const {
    const int mt = u.pm, nt = u.pn;
    const float* rsp = (const float*)(ws + OFF_RSS);
    const int b0 = (mt * 256) / L;
    const int rbase = mt * 256 + wr * 64 + fr;
    float scv[2][4];
    {
      const int lane_ = fq * 16 + fr, r0_ = mt * 256 + wr * 64 + lane_;
      const float so0 = row_scale(rsp, r0_ < R ? r0_ : 0), so1 = row_scale(rsp, r0_ + 128 < R ? r0_ + 128 : 0);
#pragma unroll
      for (int m = 0; m < 4; ++m) { scv[0][m] = __shfl(so0, m * 16 + fr); scv[1][m] = __shfl(so1, m * 16 + fr); }
    }
    if (nt < 2) {
      u16* uta = (u16*)(ws + OFF_UTA); u16* utb = (u16*)(ws + OFF_UTB);
      const int chb = nt * 256 + wc * 64 + 8 * fq;
#pragma unroll
      for (int ai = 0; ai < 2; ++ai)
#pragma unroll
        for (int m = 0; m < 4; ++m) {
          const int row = rbase + ai * 128 + m * 16;
          if (row < R) {
            int b, l; row_bl(row, b0, b, l);
            const float sc = scv[ai][m];
            u16* dst = (l <= LH) ? uta + (size_t)b * 512 * KP + l : utb + (size_t)b * 512 * KP + (L - l);
#pragma unroll
            for (int bj = 0; bj < 2; ++bj)
#pragma unroll
              for (int n = 0; n < 2; ++n)
#pragma unroll
                for (int j = 0; j < 4; ++j) dst[(size_t)(chb + bj * 32 + n * 4 + j) * KP] = f2bf(acc[ai][bj][m][n][j] * sc);
          }
          CBAR();
        }
    } else if (nt < 6) {
      const bool isq = nt < 4;
      const int gi = (isq ? nt - 2 : nt - 4) * 4 + wc;
      const int h = gi >> 1, comp = gi & 1;
      const float* gain = (const float*)(ws + OFF_SMALL) + (isq ? 0 : 256) + li * 64 + 8 * fq;
      const f32x4 g00 = *(const f32x4*)(gain), g01 = *(const f32x4*)(gain + 4), g10 = *(const f32x4*)(gain + 32), g11 = *(const f32x4*)(gain + 36);
      const float qsc = isq ? 0.125f * 1.4426950408889634f : 1.0f;
      const float* rope = (const float*)(ws + OFF_ROPE);
      u16* dbase = (u16*)(ws + (isq ? OFF_QN : OFF_KN));
#pragma unroll
      for (int ai = 0; ai < 2; ++ai)
#pragma unroll
        for (int m = 0; m < 4; ++m) {
          const int row = rbase + ai * 128 + m * 16;
          const bool valid = row < R;
          const int rowc = valid ? row : 0;
          int b, l; row_bl(rowc, valid ? b0 : 0, b, l);
          const float sc = scv[ai][m];
          f32x4 v00 = acc[ai][0][m][0] * sc, v01 = acc[ai][0][m][1] * sc, v10 = acc[ai][1][m][0] * sc, v11 = acc[ai][1][m][1] * sc;
          float ss = 0.f;
#pragma unroll
          for (int j = 0; j < 4; ++j) ss += v00[j] * v00[j] + v01[j] * v01[j] + v10[j] * v10[j] + v11[j] * v11[j];
          ss += __shfl_xor(ss, 16); ss += __shfl_xor(ss, 32);
          const float rq = rsqrtf(ss * (1.0f / 64.f) + EPS) * qsc;
          v00 = v00 * g00 * rq; v01 = v01 * g01 * rq; v10 = v10 * g10 * rq; v11 = v11 * g11 * rq;
          const f32x4 c0 = *(const f32x4*)(rope + l * 16), c1 = *(const f32x4*)(rope + l * 16 + 4), s0 = *(const f32x4*)(rope + l * 16 + 8), s1 = *(const f32x4*)(rope + l * 16 + 12);
          f32x4 p0, p1;
#pragma unroll
          for (int j = 0; j < 4; ++j) { p0[j] = __shfl_xor(v00[j], 16); p1[j] = __shfl_xor(v01[j], 16); }
          if (fq == 0) { v00 = v00 * c0 - p0 * s0; v01 = v01 * c1 - p1 * s1; }
          else if (fq == 1) { v00 = v00 * c0 + p0 * s0; v01 = v01 * c1 + p1 * s1; }
          if (valid) {
            u16* dst = dbase + (((size_t)(b * NH + h)) * LP + l) * 128 + comp * 64 + 8 * fq;
            u32x4 w0 = {cvtpk(v00[0], v00[1]), cvtpk(v00[2], v00[3]), cvtpk(v01[0], v01[1]), cvtpk(v01[2], v01[3])};
            u32x4 w1 = {cvtpk(v10[0], v10[1]), cvtpk(v10[2], v10[3]), cvtpk(v11[0], v11[1]), cvtpk(v11[2], v11[3])};
            *(u32x4*)(dst) = w0; *(u32x4*)(dst + 32) = w1;
          }
          CBAR();
        }
    } else if (nt < 8) {
      const int cv = (nt - 6) * 256 + wc * 64;
      const int h = cv >> 7, dv = (cv & 127) + 8 * fq;
      u16* vt = (u16*)(ws + OFF_VN);
#pragma unroll
      for (int ai = 0; ai < 2; ++ai)
#pragma unroll
        for (int m = 0; m < 4; ++m) {
          const int row = rbase + ai * 128 + m * 16;
          if (row < R) {
            int b, l; row_bl(row, b0, b, l);
            const float sc = scv[ai][m];
            const int o = l & 15;
            const int pos = (l & ~15) + 8 * ((o >> 2) & 1) + 4 * (o >> 3) + (o & 3);
            u16* dst = vt + ((size_t)(b * NH + h) * 128 + dv) * LP + pos;
#pragma unroll
            for (int bj = 0; bj < 2; ++bj)
#pragma unroll
              for (int n = 0; n < 2; ++n)
#pragma unroll
                for (int j = 0; j < 4; ++j) dst[(size_t)(bj * 32 + n * 4 + j) * LP] = f2bf(acc[ai][bj][m][n][j] * sc);
          }
          CBAR();
        }
    } else {
      u16* gg = (u16*)(ws + OFF_GG);
      const int cgc = (nt - 8) * 256 + wc * 64 + 8 * fq;
#pragma unroll
      for (int ai = 0; ai < 2; ++ai)
#pragma unroll
        for (int m = 0; m < 4; ++m) {
          const int row = rbase + ai * 128 + m * 16;
          if (row < R) {
            const float sc = scv[ai][m];
            u16* dst = gg + (size_t)row * DM + cgc;
#pragma unroll
            for (int bj = 0; bj < 2; ++bj) {
              f32x4 a = acc[ai][bj][m][0] * sc, c = acc[ai][bj][m][1] * sc;
#pragma unroll
              for (int j = 0; j < 4; ++j) { a[j] = a[j] * __builtin_amdgcn_rcpf(1.0f + __expf(-a[j])); c[j] = c[j] * __builtin_amdgcn_rcpf(1.0f + __expf(-c[j])); }
              u32x4 w = {cvtpk(a[0], a[1]), cvtpk(a[2], a[3]), cvtpk(c[0], c[1]), cvtpk(c[2], c[3])};
              *(u32x4*)(dst + bj * 32) = w;
            }
          }
          CBAR();
        }
    }
  }
};
DI void phaseA(const P2& p, int li, char* smem, int mode, int pn, unsigned* sig) {
  pg8::Gemm g; g.A = (const u16*)(p.ws + OFF_XB); g.Bt = (const u16*)(p.ws + OFF_WIN) + (size_t)li * INW * DM; g.M = RP; g.N = INW; g.K = DM;
  pg8::Order S; S.mode = mode; S.st.init(RP - 256, INW, gridDim.x, blockIdx.x); S.pm = RP / 256 - 1; S.pn = pn; S.sig = sig; S.bready = nullptr;
  EpiA E; E.ws = p.ws; E.li = li;
  pg8::gemm_phase((PG8_LAS unsigned char*)smem, g, S, E);
}

struct EpiC {
  char* ws; float* out; const float* x; const float* meta; int li;
  DI void operator()(const f32x4 (&acc)[2][2][4][2], const pg8::Unit& u, int wr, int wc, int fr, int fq) const {
    const int mt = u.pm, nt = u.pn;
    const bool last = (li == DEPTH - 1), first = (li == 0);
    u16* xb = (u16*)(ws + OFF_XB);
    float* rsp = (float*)(ws + OFF_RSS);
    const int b0 = (mt * 256) / L;
    const int rbase = mt * 256 + wr * 64 + fr;
    const int cb = nt * 256 + wc * 32 + 8 * fq;
#pragma unroll
    for (int ai = 0; ai < 2; ++ai)
#pragma unroll
      for (int m = 0; m < 4; ++m) {
        const int row = rbase + ai * 128 + m * 16;
        const bool valid = row < R;
        float ss = 0.f;
        if (valid) {
          int b, l; row_bl(row, b0, b, l);
          u16* xr = xb + (size_t)row * DM + cb;
          const float* xin = (l < NMETA ? meta + (size_t)l * DM : x + ((size_t)b * SEQ + (l - NMETA)) * DM) + cb;
          float* orow = out + ((size_t)b * SEQ + (l - NMETA)) * DM + cb;
#pragma unroll
          for (int bj = 0; bj < 2; ++bj) {
            f32x4 a, c;
            if (first) { a = *(const f32x4*)(xin + bj * 128); c = *(const f32x4*)(xin + bj * 128 + 4); }
            else { const u32x4 w = *(const u32x4*)(xr + bj * 128);
              a = f32x4{__uint_as_float(w[0] << 16), __uint_as_float(w[0] & 0xffff0000u), __uint_as_float(w[1] << 16), __uint_as_float(w[1] & 0xffff0000u)};
              c = f32x4{__uint_as_float(w[2] << 16), __uint_as_float(w[2] & 0xffff0000u), __uint_as_float(w[3] << 16), __uint_as_float(w[3] & 0xffff0000u)}; }
            a += acc[ai][bj][m][0]; c += acc[ai][bj][m][1];
            if (last) { if (l >= NMETA) { *(f32x4*)(orow + bj * 128) = a; *(f32x4*)(orow + bj * 128 + 4) = c; } }
            else { u32x4 w = {cvtpk(a[0], a[1]), cvtpk(a[2], a[3]), cvtpk(c[0], c[1]), cvtpk(c[2], c[3])}; *(u32x4*)(xr + bj * 128) = w; }
#pragma unroll
            for (int j = 0; j < 4; ++j) ss += a[j] * a[j] + c[j] * c[j];
          }
        }
        ss += __shfl_xor(ss, 16); ss += __shfl_xor(ss, 32);
        if (valid && !last && fq == 0) rsp[(size_t)row * 16 + nt * 4 + wc] = ss;
        if (m == 1 || m == 3) CBAR();
      }
  }
};
DI void phaseC(const P2& p, int li, char* smem, int mode, int pn, unsigned* sig) {
  pg8::Gemm g; g.A = (const u16*)(p.ws + OFF_GY); g.Bt = (const u16*)(p.ws + OFF_WOUT) + (size_t)li * DM * DM; g.M = RP; g.N = DM; g.K = DM;
  pg8::Order S; S.mode = mode; S.st.init(li == DEPTH - 1 ? RP : RP - 256, DM, gridDim.x, blockIdx.x); S.pm = RP / 256 - 1; S.pn = pn; S.sig = sig;
  S.bready = nullptr;
  EpiC E; E.ws = p.ws; E.out = p.out; E.x = p.x; E.meta = p.meta; E.li = li;
  pg8::gemm_phase((PG8_LAS unsigned char*)smem, g, S, E);
}

#define KSWZ(row, colB) ((row) * 256 + ((colB) ^ (((row) & 15) << 4)))
DI int v_st(int k, int c) { const int kk = (k & ~0xC) | ((k & 4) << 1) | ((k & 8) >> 1); return ((kk >> 3) * 4 + (c >> 5)) * 512 + ((kk & 7) * 32 + (c & 31)) * 2; }
DI int v_rd_base(int lane) { return ((lane & 3) << 3) | (((lane >> 2) & 3) << 6) | (((lane >> 4) & 1) << 5) | (((lane >> 5) & 1) << 8); }
constexpr int v_rd_off(int d0, int ks, int half) { return d0 * 512 + ks * 4096 + half * 2048; }
template <int OFF> DI s16x4 tr_read(int vb) {
  s16x4 r; asm volatile("ds_read_b64_tr_b16 %0, %1 offset:%2" : "=&v"(r) : "v"(vb), "i"(OFF) : "memory"); return r;
}
template <int D0> DI void pv_one(f32x16& od, int vb, bf16x8 pa0, bf16x8 pa1, bf16x8 pa2, bf16x8 pa3) {
  const s16x4 l0 = tr_read<v_rd_off(D0, 0, 0)>(vb), h0 = tr_read<v_rd_off(D0, 0, 1)>(vb), l1 = tr_read<v_rd_off(D0, 1, 0)>(vb), h1 = tr_read<v_rd_off(D0, 1, 1)>(vb);
  const s16x4 l2 = tr_read<v_rd_off(D0, 2, 0)>(vb), h2 = tr_read<v_rd_off(D0, 2, 1)>(vb), l3 = tr_read<v_rd_off(D0, 3, 0)>(vb), h3 = tr_read<v_rd_off(D0, 3, 1)>(vb);
  asm volatile("s_waitcnt lgkmcnt(0)" ::: "memory"); __builtin_amdgcn_sched_barrier(0);
#define PKV(Lo, Hi) (bf16x8){Lo[0], Lo[1], Lo[2], Lo[3], Hi[0], Hi[1], Hi[2], Hi[3]}
  od = MFMA32(pa0, PKV(l0, h0), od);
  od = MFMA32(pa1, PKV(l1, h1), od);
  od = MFMA32(pa2, PKV(l2, h2), od);
  od = MFMA32(pa3, PKV(l3, h3), od);
#undef PKV
}

DI void attn_tile(const P2& p, int li, int item, char* smem) {
  const int tid = opaque_tid(), wid = tid >> 6, lane = tid & 63, r32 = lane & 31, hi = lane >> 5;
  const int cm = wid >> 2, rg = wid & 3;
  const int bh = item / 33, qb = item - bh * 33;
  const int b = bh >> 2, h = bh & 3;
  const u16* Qh = (const u16*)(p.ws + OFF_QN) + (size_t)bh * LP * 128;
  const u16* Kh = (const u16*)(p.ws + OFF_KN) + (size_t)bh * LP * 128;
  const u16* Vh = (const u16*)(p.ws + OFF_VN) + (size_t)bh * 128 * LP;
  const float* cst = (const float*)(p.ws + OFF_CST) + li * 8;
  const float lam = cst[0], oml = cst[1];
  const int lq = qb * 128 + rg * 32 + r32;
  bf16x8 qr[4];
#pragma unroll
  for (int d0 = 0; d0 < 4; ++d0) qr[d0] = *(const bf16x8*)(Qh + (size_t)lq * 128 + cm * 64 + d0 * 16 + hi * 8);
  PG8_LAS unsigned char* ldsp = (PG8_LAS unsigned char*)smem;
  const int widu = __builtin_amdgcn_readfirstlane(wid);
  int kgo[2], vgo[2];
#pragma unroll
  for (int q = 0; q < 2; ++q) {
    const int rowk = 8 * wid + 4 * q + (lane >> 4), rowv = 16 * wid + 8 * q + (lane >> 3);
    kgo[q] = rowk * 128 + (((lane & 15) ^ (rowk & 15)) << 3);
    vgo[q] = rowv * LP + (((lane & 7) ^ ((rowv >> 1) & 7)) << 3);
  }
  int voff[4];
#pragma unroll
  for (int ks = 0; ks < 4; ++ks) voff[ks] = 16384 + r32 * 128 + (((2 * ks + hi) ^ ((r32 >> 1) & 7)) << 4);
  int koff[4];
#pragma unroll
  for (int d0 = 0; d0 < 4; ++d0) koff[d0] = r32 * 256 + ((cm * 128 + d0 * 32 + hi * 16) ^ ((r32 & 15) << 4));
  f32x16 o[4];
#pragma unroll
  for (int d = 0; d < 4; ++d)
#pragma unroll
    for (int r = 0; r < 16; ++r) o[d][r] = 0.f;
  float lsum = 0.f;
  f32x16 pA0, pA1, pB0, pB1;
  bf16x8 pa0, pa1, pa2, pa3;
#define SBAR() __builtin_amdgcn_sched_barrier(0)
#define GLDS(t, slot) do { const u16* kt_ = Kh + (size_t)(t) * 64 * 128; const u16* vt_ = Vh + (size_t)(t) * 64; \
    _Pragma("unroll") for (int q = 0; q < 2; ++q) __builtin_amdgcn_global_load_lds((const unsigned*)(kt_ + kgo[q]), (PG8_LAS unsigned*)(ldsp + (slot) + (2 * widu + q) * 1024), 16, 0, 0); \
    _Pragma("unroll") for (int q = 0; q < 2; ++q) __builtin_amdgcn_global_load_lds((const unsigned*)(vt_ + vgo[q]), (PG8_LAS unsigned*)(ldsp + (slot) + 16384 + (2 * widu + q) * 1024), 16, 0, 0); } while (0)
#define QKMM(P0, P1, kb_) do { _Pragma("unroll") for (int d0 = 0; d0 < 4; ++d0) { \
      const bf16x8 b0_ = *(const bf16x8*)((kb_) + koff[d0]); const bf16x8 b1_ = *(const bf16x8*)((kb_) + koff[d0] + 8192); \
      P0 = MFMA32(b0_, qr[d0], P0); P1 = MFMA32(b1_, qr[d0], P1); } } while (0)
  \
  \
#define QKT(P0, P1, ro, MASKED) do { const char* kb_ = smem + (ro); \
    _Pragma("unroll") for (int r = 0; r < 16; ++r) { P0[r] = 0.f; P1[r] = 0.f; } \
    QKMM(P0, P1, kb_); \
    if (MASKED) { _Pragma("unroll") for (int r = 8; r < 16; ++r) P0[r] = -1e30f; _Pragma("unroll") for (int r = 0; r < 16; ++r) P1[r] = -1e30f; } } while (0)
#define EXPS(P0, P1) do { _Pragma("unroll") for (int r = 0; r < 16; ++r) { P0[r] = __builtin_amdgcn_exp2f(P0[r]); P1[r] = __builtin_amdgcn_exp2f(P1[r]); } } while (0)
#define EXPH(P, B0_) do { _Pragma("unroll") for (int r = 0; r < 8; ++r) P[(B0_) + r] = __builtin_amdgcn_exp2f(P[(B0_) + r]); } while (0)
#define PK4(P, BASE, OUT) do { u32x4 w = {cvtpk(P[BASE + 0], P[BASE + 1]), cvtpk(P[BASE + 2], P[BASE + 3]), cvtpk(P[BASE + 4], P[BASE + 5]), cvtpk(P[BASE + 6], P[BASE + 7])}; \
    OUT = *reinterpret_cast<bf16x8*>(&w); } while (0)
#define PACK(P0, P1) do { float s0_ = P0[0], s1_ = P0[1], s2_ = P0[2], s3_ = P0[3]; \
    _Pragma("unroll") for (int r = 4; r < 16; r += 4) { s0_ = addf(s0_, P0[r]); s1_ = addf(s1_, P0[r + 1]); s2_ = addf(s2_, P0[r + 2]); s3_ = addf(s3_, P0[r + 3]); } \
    _Pragma("unroll") for (int r = 0; r < 16; r += 4) { s0_ = addf(s0_, P1[r]); s1_ = addf(s1_, P1[r + 1]); s2_ = addf(s2_, P1[r + 2]); s3_ = addf(s3_, P1[r + 3]); } \
    lsum += (s0_ + s1_) + (s2_ + s3_); \
    PK4(P0, 0, pa0); PK4(P0, 8, pa1); PK4(P1, 0, pa2); PK4(P1, 8, pa3); } while (0)
#define PVD(D0, vb) do { const bf16x8 v0_ = *(const bf16x8*)((vb) + voff[0] + (D0) * 4096), v1_ = *(const bf16x8*)((vb) + voff[1] + (D0) * 4096); \
    const bf16x8 v2_ = *(const bf16x8*)((vb) + voff[2] + (D0) * 4096), v3_ = *(const bf16x8*)((vb) + voff[3] + (D0) * 4096); \
    o[D0] = MFMA32(pa0, v0_, o[D0]); o[D0] = MFMA32(pa1, v1_, o[D0]); o[D0] = MFMA32(pa2, v2_, o[D0]); o[D0] = MFMA32(pa3, v3_, o[D0]); } while (0)
#define STEP(C0, C1, N0, N1, jj, NX, MASKED) do { const int j_ = (jj); \
    if (j_ + 3 < NKT) GLDS(j_ + 3, ((j_ + 3) & 3) * 32768);          \
    SBAR(); \
    if (act) { if (NX) QKT(N0, N1, ((j_ + 1) & 3) * 32768, MASKED); \
    PACK(C0, C1); } \
    SBAR(); \
    if (act) { const char* vb_ = smem + (j_ & 3) * 32768; \
      PVD(0, vb_); if (NX) EXPH(N0, 0); \
      PVD(1, vb_); if (NX) EXPH(N0, 8); \
      PVD(2, vb_); if (NX) EXPH(N1, 0); \
      PVD(3, vb_); if (NX) EXPH(N1, 8); } \
    SBAR(); \
    if (j_ + 3 < NKT) asm volatile("s_waitcnt vmcnt(4)" ::: "memory"); else asm volatile("s_waitcnt vmcnt(0)" ::: "memory");     \
    asm volatile("s_waitcnt lgkmcnt(0)" ::: "memory"); \
    __builtin_amdgcn_s_barrier(); \
    asm volatile("" ::: "memory"); SBAR(); } while (0)
  GLDS(0, 0); GLDS(1, 32768); GLDS(2, 65536);
  asm volatile("s_waitcnt vmcnt(4)" ::: "memory");
  __builtin_amdgcn_s_barrier();
  asm volatile("" ::: "memory"); SBAR();
  const bool act = (qb < 32) || (rg == 0);
  QKT(pA0, pA1, 0, 0); EXPS(pA0, pA1);
  for (int j = 0; j < NKT - 3; j += 2) {
    STEP(pA0, pA1, pB0, pB1, j, 1, 0);
    STEP(pB0, pB1, pA0, pA1, j + 1, 1, 0);
  }
  STEP(pA0, pA1, pB0, pB1, NKT - 3, 1, 0);
  STEP(pB0, pB1, pA0, pA1, NKT - 2, 1, 1);
  STEP(pA0, pA1, pB0, pB1, NKT - 1, 0, 0);
  __syncthreads();
#undef STEP
#undef PVD
#undef PACK
#undef PK4
#undef EXPS
#undef EXPH
#undef QKT
#undef QKMM
#undef GLDS
  lsum += __shfl_xor(lsum, 32);
  float inv = 1.0f / lsum; if (cm == 1) inv *= lam;
  float* li_l = (float*)(smem + 98304) + wid * 32;
  if (hi == 0) li_l[r32] = inv;
  __syncthreads();
  float rl[16];
#pragma unroll
  for (int r = 0; r < 16; ++r) rl[r] = li_l[crow(r, hi)];
#pragma unroll
  for (int d = 0; d < 4; ++d)
#pragma unroll
    for (int r = 0; r < 16; ++r) o[d][r] *= rl[r];
  float* xbuf = (float*)smem + rg * 4096;
  if (cm == 1) {
#pragma unroll
    for (int d = 0; d < 4; ++d)
#pragma unroll
      for (int r = 0; r < 16; ++r) xbuf[crow(r, hi) * 128 + d * 32 + r32] = o[d][r];
  }
  __syncthreads();
  if (cm == 0) {
    u16* gy = (u16*)(p.ws + OFF_GY); const u16* gg = (const u16*)(p.ws + OFF_GG);
    const float* sg = (const float*)(p.ws + OFF_SMALL) + 512 + li * 128;
    const float s0 = sg[r32], s1 = sg[32 + r32], s2 = sg[64 + r32], s3 = sg[96 + r32];
#pragma unroll
    for (int r = 0; r < 16; ++r) {
      const int rr = crow(r, hi);
      const float v0 = o[0][r] - xbuf[rr * 128 + r32], v1 = o[1][r] - xbuf[rr * 128 + 32 + r32];
      const float v2 = o[2][r] - xbuf[rr * 128 + 64 + r32], v3 = o[3][r] - xbuf[rr * 128 + 96 + r32];
      float ss = v0 * v0 + v1 * v1 + v2 * v2 + v3 * v3;
      ss += __shfl_xor(ss, 1); ss += __shfl_xor(ss, 2); ss += __shfl_xor(ss, 4); ss += __shfl_xor(ss, 8); ss += __shfl_xor(ss, 16);
      const float rinv = rsqrtf(ss * (1.0f / 128.f) + EPS) * oml;
      xbuf[rr * 128 + r32] = v0 * rinv * s0; xbuf[rr * 128 + 32 + r32] = v1 * rinv * s1;
      xbuf[rr * 128 + 64 + r32] = v2 * rinv * s2; xbuf[rr * 128 + 96 + r32] = v3 * rinv * s3;
    }
    asm volatile("s_waitcnt lgkmcnt(0)" ::: "memory");
#pragma unroll
    for (int it = 0; it < 8; ++it) {
      const int rw = it * 4 + (lane >> 4), c8 = (lane & 15) * 8;
      const int l = qb * 128 + rg * 32 + rw;
      const f32x4 a = *(const f32x4*)(xbuf + rw * 128 + c8), c = *(const f32x4*)(xbuf + rw * 128 + c8 + 4);
      if (l < L) {
        const size_t go = ((size_t)(b * L + l)) * DM + 512 + h * 128 + c8;
        const u32x4 gt = *(const u32x4*)(gg + go);
        u32x4 w;
        w[0] = cvtpk(a[0] * __uint_as_float(gt[0] << 16), a[1] * __uint_as_float(gt[0] & 0xffff0000u));
        w[1] = cvtpk(a[2] * __uint_as_float(gt[1] << 16), a[3] * __uint_as_float(gt[1] & 0xffff0000u));
        w[2] = cvtpk(c[0] * __uint_as_float(gt[2] << 16), c[1] * __uint_as_float(gt[2] & 0xffff0000u));
        w[3] = cvtpk(c[2] * __uint_as_float(gt[3] << 16), c[3] * __uint_as_float(gt[3] & 0xffff0000u));
        *(u32x4*)(gy + go) = w;
      }
    }
  }
  __syncthreads();
}

DI void fourier_tile(const P2& p, int li, int item, char* smem) {
  const int tid = opaque_tid(), wid = tid >> 6, lane = tid & 63, fr = lane & 15, fq = lane >> 4;
  const int qd = wid >> 2, wq = wid & 3;
  const int b = item / 36, rem = item - b * 36, g = rem / 9, kt = rem - g * 9;
  const u16* Cm = (const u16*)(p.ws + OFF_CM); const u16* Sm = (const u16*)(p.ws + OFF_SM);
  const u16* uta = (const u16*)(p.ws + OFF_UTA); const u16* utb = (const u16*)(p.ws + OFF_UTB);
  char* As = smem; char* Bs = smem + 65536;
  const int srow = tid >> 3, scc = tid & 7;
  const int soff = srow * 128 + ((scc ^ ((srow >> 1) & 7)) << 4);
  const u16* cgp = Cm + (size_t)(kt * 128 + srow) * KP + scc * 8;
  const u16* sgp = Sm + (size_t)(kt * 128 + srow) * KP + scc * 8;
  const u16* uap = uta + ((size_t)(b * 512 + g * 128 + srow)) * KP + scc * 8;
  const u16* ubp = utb + ((size_t)(b * 512 + g * 128 + srow)) * KP + scc * 8;
  u32x4 raA[4], ruaA[2], rubA[2];
#define FLOAD(ra, rua, rub, k2) do { ra[0] = *(const u32x4*)(cgp + (k2) * 64); ra[1] = *(const u32x4*)(cgp + (size_t)64 * KP + (k2) * 64); \
    ra[2] = *(const u32x4*)(sgp + (k2) * 64); ra[3] = *(const u32x4*)(sgp + (size_t)64 * KP + (k2) * 64); \
    rua[0] = *(const u32x4*)(uap + (k2) * 64); rua[1] = *(const u32x4*)(uap + (size_t)64 * KP + (k2) * 64); \
    rub[0] = *(const u32x4*)(ubp + (k2) * 64); rub[1] = *(const u32x4*)(ubp + (size_t)64 * KP + (k2) * 64); } while (0)
#define FWRITE(ra, rua, rub, bf) do { _Pragma("unroll") for (int i = 0; i < 4; ++i) *(u32x4*)(As + (bf) * 32768 + soff + i * 8192) = ra[i]; \
    _Pragma("unroll") for (int i = 0; i < 2; ++i) { u32x4 ev, ov; \
      _Pragma("unroll") for (int d = 0; d < 4; ++d) { const unsigned ua_ = rua[i][d], ub_ = rub[i][d]; \
        const float al = __uint_as_float(ua_ << 16), ah = __uint_as_float(ua_ & 0xffff0000u); \
        const float bl = __uint_as_float(ub_ << 16), bh_ = __uint_as_float(ub_ & 0xffff0000u); \
        ev[d] = cvtpk(al + bl, ah + bh_); ov[d] = cvtpk(al - bl, ah - bh_); } \
      *(u32x4*)(Bs + (bf) * 32768 + soff + i * 8192) = ev; *(u32x4*)(Bs + (bf) * 32768 + 16384 + soff + i * 8192) = ov; } } while (0)
  f32x4 acc[8][2], acc2[8][2];
#pragma unroll
  for (int m = 0; m < 8; ++m) { acc[m][0] = f32x4{0.f, 0.f, 0.f, 0.f}; acc[m][1] = f32x4{0.f, 0.f, 0.f, 0.f}; acc2[m][0] = f32x4{0.f, 0.f, 0.f, 0.f}; acc2[m][1] = f32x4{0.f, 0.f, 0.f, 0.f}; }
  const bf16x8 sgn = {0, (short)0x8000, 0, (short)0x8000, 0, (short)0x8000, 0, (short)0x8000};
  const int aoff0 = (qd * 128 + fr) * 128, boff0 = (qd * 128 + wq * 32 + fr) * 128, swz = fr >> 1;
  constexpr int NK2 = KP / 64;
#define FCOMP(buf) do { const char* Ab = As + (buf) * 32768; const char* Bb = Bs + (buf) * 32768; \
    _Pragma("unroll") for (int ks = 0; ks < 2; ++ks) { const int co = ((ks * 4 + fq) ^ swz) << 4; \
      const bf16x8 bf0 = *(const bf16x8*)(Bb + boff0 + co), bf1 = *(const bf16x8*)(Bb + boff0 + 2048 + co); \
      const bf16x8 bal0 = bf0 ^ sgn, bal1 = bf1 ^ sgn; \
      _Pragma("unroll") for (int mh = 0; mh < 2; ++mh) { bf16x8 af[4]; \
        _Pragma("unroll") for (int m = 0; m < 4; ++m) af[m] = *(const bf16x8*)(Ab + aoff0 + (mh * 4 + m) * 2048 + co); \
        _Pragma("unroll") for (int m = 0; m < 4; ++m) { acc[mh * 4 + m][0] = MFMA16(af[m], bf0, acc[mh * 4 + m][0]); acc[mh * 4 + m][1] = MFMA16(af[m], bf1, acc[mh * 4 + m][1]); \
          acc2[mh * 4 + m][0] = MFMA16(af[m], bal0, acc2[mh * 4 + m][0]); acc2[mh * 4 + m][1] = MFMA16(af[m], bal1, acc2[mh * 4 + m][1]); } } } } while (0)
  FLOAD(raA, ruaA, rubA, 0); FWRITE(raA, ruaA, rubA, 0);
  __syncthreads();
  for (int k2 = 0; k2 < NK2; ++k2) {
    const int buf = k2 & 1;
    if (k2 + 1 < NK2) FLOAD(raA, ruaA, rubA, k2 + 1);
    FCOMP(buf);
    if (k2 + 1 < NK2) FWRITE(raA, ruaA, rubA, buf ^ 1);
    __syncthreads();
  }
#undef FLOAD
#undef FWRITE
#undef FCOMP
  u16* gy = (u16*)(p.ws + OFF_GY); const u16* gg = (const u16*)(p.ws + OFF_GG);
  const u16* Mb = (const u16*)(p.ws + OFF_MCS) + ((size_t)(li * 4 + g) * 128) * 256;
  const int arow = wid * 16 + fr;
#pragma clang loop unroll(disable)
  for (int pass = 0; pass < 2; ++pass) {
#pragma unroll
    for (int m = 0; m < 8; ++m)
#pragma unroll
      for (int n = 0; n < 2; ++n)
#pragma unroll
        for (int j = 0; j < 4; ++j) {
          const int row = m * 16 + fq * 4 + j, col = qd * 128 + wq * 32 + n * 16 + fr;
          *(u16*)(smem + row * 512 + ((((col >> 3) ^ (row & 15))) << 4) + (col & 7) * 2) = f2bf(acc[m][n][j]);
        }
    __syncthreads();
    f32x4 accP[8], accQ[8];
#pragma unroll
    for (int n = 0; n < 8; ++n) { accP[n] = f32x4{0.f, 0.f, 0.f, 0.f}; accQ[n] = f32x4{0.f, 0.f, 0.f, 0.f}; }
#pragma clang loop unroll(disable)
    for (int ks = 0; ks < 4; ++ks) {
      const bf16x8 a = *(const bf16x8*)(smem + arow * 512 + (((ks * 4 + fq) ^ fr) << 4));
#pragma unroll
      for (int n = 0; n < 8; ++n) {
        const bf16x8 bb = *(const bf16x8*)(Mb + (size_t)(n * 16 + fr) * 256 + ks * 32 + fq * 8);
        accP[n] = MFMA16(a, bb, accP[n]);
      }
    }
#pragma clang loop unroll(disable)
    for (int ks = 4; ks < 8; ++ks) {
      const bf16x8 a = *(const bf16x8*)(smem + arow * 512 + (((ks * 4 + fq) ^ fr) << 4));
#pragma unroll
      for (int n = 0; n < 8; ++n) {
        const bf16x8 bb = *(const bf16x8*)(Mb + (size_t)(n * 16 + fr) * 256 + ks * 32 + fq * 8);
        accQ[n] = MFMA16(a, bb, accQ[n]);
      }
    }
    const float sq = pass ? -1.f : 1.f;
    float* stg = (float*)(smem + 65536 + wid * 8192);
#pragma unroll
    for (int half = 0; half < 2; ++half) {
      const float sh = half ? -sq : sq;
#pragma unroll
      for (int n = 0; n < 8; ++n)
#pragma unroll
        for (int j = 0; j < 4; ++j) stg[(fq * 4 + j) * 128 + n * 16 + fr] = accP[n][j] + sh * accQ[n][j];
      asm volatile("s_waitcnt lgkmcnt(0)" ::: "memory");
#pragma unroll
      for (int it = 0; it < 4; ++it) {
        const int rw = it * 4 + (lane >> 4), c8 = (lane & 15) * 8;
        const int k0 = kt * 128 + wid * 16 + rw;
        const int kk = pass ? LH - k0 : k0;
        bool ok = (k0 <= LH / 2) && !(pass && k0 == LH / 2);
        if (half) ok = ok && (kk >= 1) && (kk < LH);
        const int orow = half ? L - kk : kk;
        const f32x4 a = *(const f32x4*)(stg + rw * 128 + c8), c = *(const f32x4*)(stg + rw * 128 + c8 + 4);
        if (ok) {
          const size_t o1 = ((size_t)(b * L + orow)) * DM + g * 128 + c8;
          const u32x4 gt = *(const u32x4*)(gg + o1);
          u32x4 w;
          w[0] = cvtpk(a[0] * __uint_as_float(gt[0] << 16), a[1] * __uint_as_float(gt[0] & 0xffff0000u));
          w[1] = cvtpk(a[2] * __uint_as_float(gt[1] << 16), a[3] * __uint_as_float(gt[1] & 0xffff0000u));
          w[2] = cvtpk(c[0] * __uint_as_float(gt[2] << 16), c[1] * __uint_as_float(gt[2] & 0xffff0000u));
          w[3] = cvtpk(c[2] * __uint_as_float(gt[3] << 16), c[3] * __uint_as_float(gt[3] & 0xffff0000u));
          *(u32x4*)(gy + o1) = w;
        }
      }
      asm volatile("s_waitcnt lgkmcnt(0)" ::: "memory");
    }
    __syncthreads();
#pragma unroll
    for (int m = 0; m < 8; ++m) { acc[m][0] = acc2[m][0]; acc[m][1] = acc2[m][1]; }
  }
}

constexpr int N_ATT = NB * NH * 33;
constexpr int N_FOU = NB * 4 * 9;
#ifndef REPA
#define REPA 1
#endif
#ifndef REPB
#define REPB 1
#endif
#ifndef REPB_MODE
#define REPB_MODE 0
#endif
DI void phaseB(const P2& p, int li, char* smem, int rep) {
  int* qb_ = (int*)(p.ws + OFF_Q) + (li * 2 + rep) * 256;
  unsigned* bdone = (unsigned*)(p.ws + OFF_Q) + (li * 2) * 256 + 128;
  int* s_item = (int*)(smem + 131072);
  unsigned* sig1 = (unsigned*)(p.ws + OFF_CNT) + 40 + 2 * li + 1;
  const int myx = (int)(__builtin_amdgcn_s_getreg((3 << 11) | 20) & 7u);
  int d = 0;
  for (;;) {
    if (threadIdx.x == 0) {
      int dd = d, idx = -1, xq = 0;
      while (dd < 8) {
        xq = (myx + dd) & 7;
        idx = atomicAdd(qb_ + xq * 16, 1);
        if (idx < 168) break;
        idx = -1; ++dd;
      }
      s_item[0] = idx; s_item[1] = xq; s_item[3] = dd;
    }
    __syncthreads();
    const int idx = __builtin_amdgcn_readfirstlane(s_item[0]), xq = __builtin_amdgcn_readfirstlane(s_item[1]);
    d = __builtin_amdgcn_readfirstlane(s_item[3]);
    __syncthreads();
    if (idx < 0) break;
    const int grp = idx / 42, r = idx - grp * 42;
    int isf, sub;
    if (grp < 3) { const int f0 = (r * 9) / 42, f1 = ((r + 1) * 9) / 42; isf = f1 > f0; sub = isf ? f0 : r - f0; }
    else { isf = r >= 33; sub = isf ? r - 33 : r; }
    const int pair = xq + 8 * grp, bat = pair >> 2;
    if (bat == NB - 1) wait_sig(sig1, 96u);
    if (!isf) attn_tile(p, li, pair * 33 + sub, smem);
    else fourier_tile(p, li, bat * 36 + (pair & 3) * 9 + sub, smem);
  }
}

__global__ void __launch_bounds__(512) mega(Params p, int ph_begin, int ph_end) {
  __shared__ __attribute__((aligned(16))) char smem[131072 + 64 + 1024];
  if (ph_begin == 0) {
    phase0(p, smem);
    if (ph_end > 1) cg::this_grid().sync();
  }
  P2 q; q.out = p.out; q.ws = p.ws; q.x = p.x; q.meta = p.meta;
  unsigned nbar = 0;
#pragma clang loop unroll(disable)
  for (int ph = (ph_begin < 1 ? 1 : ph_begin); ph < ph_end; ++ph) {
    const int li = (ph - 1) / 3, s = (ph - 1) % 3;
    unsigned* sig0 = (unsigned*)(q.ws + OFF_CNT) + 40 + 2 * li;
    unsigned* sig1 = sig0 + 1;
    const int bx = blockIdx.x;
    { int mode = -1, lc = li;
      if (s == 2) mode = 0; else if (s == 1 && li > 0 && bx < 4) { mode = 1; lc = li - 1; }
      if (mode >= 0) phaseC(q, lc, smem, mode, bx, sig0); }
    { int mode = -1;
      if (s == 0) mode = 0; else if (s == 1 && bx >= 4 && bx < 16) { mode = 1; wait_sig(sig0, li > 0 ? 32u : 0u); }
      if (mode >= 0) phaseA(q, li, smem, mode, bx - 4, sig1); }
    if (s == 1) { for (int rep = 0; rep < REPB; ++rep) phaseB(q, li, smem, rep); }
    if (ph + 1 < ph_end) { ++nbar; grid_barrier((unsigned*)(q.ws + OFF_CNT) + 32, nbar * gridDim.x); }
  }
}

extern "C" void kernel_launch(void* const* d_in, const int* in_sizes, int n_in, void* d_out, int out_size, void* d_ws, size_t ws_size, hipStream_t stream) {
  if (ws_size < WS_END) { fprintf(stderr, "workspace too small: %zu < %zu\n", ws_size, (size_t)WS_END); return; }
  Params p{};
  p.x = (const float*)d_in[0]; p.meta = (const float*)d_in[1]; p.norm_gain = (const float*)d_in[2]; p.w_in = (const float*)d_in[3];
  p.w_f = (const float*)d_in[4]; p.qg = (const float*)d_in[5]; p.kg = (const float*)d_in[6]; p.lq1 = (const float*)d_in[7];
  p.lk1 = (const float*)d_in[8]; p.lq2 = (const float*)d_in[9]; p.lk2 = (const float*)d_in[10]; p.subln = (const float*)d_in[11];
  p.w_out = (const float*)d_in[12]; p.out = (float*)d_out; p.ws = (char*)d_ws;
  constexpr int NPH = 1 + 3 * DEPTH;
#if MULTI_LAUNCH
  for (int ph = 0; ph < NPH; ++ph) hipLaunchKernelGGL(mega, dim3(256), dim3(512), 0, stream, p, ph, ph + 1);
#else
  static int grid_blocks = 0;
  if (!grid_blocks) {
    int dev = 0, cus = 0, per_cu = 0;
    hipGetDevice(&dev);
    hipDeviceGetAttribute(&cus, hipDeviceAttributeMultiprocessorCount, dev);
    hipOccupancyMaxActiveBlocksPerMultiprocessor(&per_cu, mega, 512, 0);
    if (per_cu < 1) per_cu = 1;
    grid_blocks = cus * 1;
  }
  int b0 = 0, b1 = NPH;
  void* args[] = {&p, &b0, &b1};
  hipError_t e = hipLaunchCooperativeKernel((void*)mega, dim3(grid_blocks), dim3(512), args, 0, stream);
  if (e != hipSuccess) fprintf(stderr, "cooperative launch failed: %s (grid %d)\n", hipGetErrorString(e), grid_blocks);
#endif
}
```

```cpp
#include <hip/hip_runtime.h>
#include <hip/hip_bf16.h>
#include <hip/hip_cooperative_groups.h>
#include <cstdio>
#include <cstdint>
namespace cg = cooperative_groups;

#ifndef MULTI_LAUNCH
#define MULTI_LAUNCH 0
#endif

typedef unsigned short u16;
using bf16x8 = __attribute__((ext_vector_type(8))) short;
using s16x4  = __attribute__((ext_vector_type(4))) short;
using f32x4  = __attribute__((ext_vector_type(4))) float;
using f32x16 = __attribute__((ext_vector_type(16))) float;
using u32x4  = __attribute__((ext_vector_type(4))) unsigned;
using u32x2  = __attribute__((ext_vector_type(2))) unsigned;

constexpr int NB = 8, SEQ = 4096, NMETA = 16, L = 4112, DM = 1024, DEPTH = 4;
constexpr int R = NB * L;
constexpr int RP = 33024;
constexpr int INW = 3072;
constexpr int NH = 4;
constexpr int LP = 4224;
constexpr int LH = 2056;
constexpr int KROWS = 2176;
constexpr int KP = 2112;
constexpr int NKT = 65;
constexpr float EPS = 1e-6f;

constexpr size_t al256(size_t x) { return (x + 255) / 256 * 256; }
constexpr size_t OFF_META = 0;
constexpr size_t OFF_XB   = al256(OFF_META + (size_t)NB * NMETA * DM * 4);
constexpr size_t OFF_GY   = al256(OFF_XB + (size_t)RP * DM * 2);
constexpr size_t OFF_QN   = al256(OFF_GY + (size_t)RP * DM * 2);
constexpr size_t QKV_BYTES = (size_t)NB * NH * LP * 128 * 2;
constexpr size_t OFF_KN   = al256(OFF_QN + QKV_BYTES);
constexpr size_t OFF_VN   = al256(OFF_KN + QKV_BYTES);
constexpr size_t OFF_WIN  = al256(OFF_VN + QKV_BYTES);
constexpr size_t OFF_WOUT = al256(OFF_WIN + (size_t)DEPTH * INW * DM * 2);
constexpr size_t OFF_CM   = al256(OFF_WOUT + (size_t)DEPTH * DM * DM * 2);
constexpr size_t OFF_SM   = al256(OFF_CM + (size_t)KROWS * KP * 2);
constexpr size_t OFF_MCS  = al256(OFF_SM + (size_t)KROWS * KP * 2);
constexpr size_t OFF_UTA  = al256(OFF_MCS + (size_t)DEPTH * 4 * 128 * 256 * 2);
constexpr size_t OFF_UTB  = al256(OFF_UTA + (size_t)NB * 512 * KP * 2);
constexpr size_t OFF_RSS  = al256(OFF_UTB + (size_t)NB * 512 * KP * 2);
constexpr size_t OFF_ROPE = al256(OFF_RSS + (size_t)RP * 16 * 4);
constexpr size_t OFF_CST  = al256(OFF_ROPE + (size_t)L * 16 * 4);
constexpr size_t OFF_SMALL = al256(OFF_CST + 256);
constexpr size_t OFF_CNT  = al256(OFF_SMALL + 4096);
constexpr size_t OFF_GG   = al256(OFF_CNT + 256);
constexpr size_t OFF_Q    = al256(OFF_GG + (size_t)RP * DM * 2);
constexpr size_t WS_END   = OFF_Q + 4 * 2 * 16 * 16 * 4;

struct Params {
  const float *x, *meta, *norm_gain, *w_in, *w_f, *qg, *kg, *lq1, *lk1, *lq2, *lk2, *subln, *w_out;
  float* out;
  char* ws;
};

struct P2 { float* out; char* ws; const float* x; const float* meta; };
__device__ __forceinline__ void grid_barrier(unsigned* bar, unsigned target) {
  asm volatile("s_waitcnt vmcnt(0) lgkmcnt(0)" ::: "memory");
  __syncthreads();
  if (threadIdx.x == 0) {
    __builtin_amdgcn_fence(__ATOMIC_RELEASE, "agent");
    asm volatile("s_waitcnt vmcnt(0)" ::: "memory");
    __hip_atomic_fetch_add(bar, 1u, __ATOMIC_RELAXED, __HIP_MEMORY_SCOPE_AGENT);
    while (__hip_atomic_load(bar, __ATOMIC_RELAXED, __HIP_MEMORY_SCOPE_AGENT) < target) __builtin_amdgcn_s_sleep(2);
    __builtin_amdgcn_fence(__ATOMIC_ACQUIRE, "agent");
    asm volatile("s_waitcnt vmcnt(0)" ::: "memory");
  }
  __syncthreads();
}
#define DI __device__ __forceinline__
#define MFMA16(a, b, c) __builtin_amdgcn_mfma_f32_16x16x32_bf16((a), (b), (c), 0, 0, 0)
#define MFMA32(a, b, c) __builtin_amdgcn_mfma_f32_32x32x16_bf16((a), (b), (c), 0, 0, 0)

using bf16v2 = __attribute__((ext_vector_type(2))) __bf16;
DI void wait_sig(unsigned* sig, unsigned target) {
  if (threadIdx.x == 0) {
    while (__hip_atomic_load(sig, __ATOMIC_RELAXED, __HIP_MEMORY_SCOPE_AGENT) < target) __builtin_amdgcn_s_sleep(2);
    __builtin_amdgcn_fence(__ATOMIC_ACQUIRE, "agent");
    asm volatile("s_waitcnt vmcnt(0)" ::: "memory");
  }
  __syncthreads();
}
DI unsigned cvtpk(float lo, float hi) { bf16v2 v; v[0] = (__bf16)lo; v[1] = (__bf16)hi; return __builtin_bit_cast(unsigned, v); }
DI u16 f2bf(float x) { return (u16)(cvtpk(x, x) & 0xffffu); }
DI float bf2f(u16 v) { return __uint_as_float(((unsigned)v) << 16); }
DI float wave_sum(float v) { for (int o = 32; o; o >>= 1) v += __shfl_xor(v, o); return v; }
DI float wave_max(float v) { for (int o = 32; o; o >>= 1) v = fmaxf(v, __shfl_xor(v, o)); return v; }
DI float addf(float a, float b) { float r; asm volatile("v_add_f32 %0, %1, %2" : "=v"(r) : "v"(a), "v"(b)); return r; }
DI int crow(int r, int hi) { return (r & 3) + 8 * (r >> 2) + 4 * hi; }

DI float* hres_row(const Params& p, int row) {
  const int b = row / L, l = row - b * L;
  return l < NMETA ? (float*)(p.ws + OFF_META) + (size_t)(b * NMETA + l) * DM
                   : p.out + ((size_t)b * SEQ + (l - NMETA)) * DM;
}

DI void row_bl(int row, int b0, int& b, int& l) { b = b0 + ((row >= (b0 + 1) * L) ? 1 : 0); l = row - b * L; }
#define CBAR() asm volatile("" ::: "memory")
DI int opaque_tid() { int t = threadIdx.x; asm volatile("" : "+v"(t)); return t; }

__device__ const double INVF[8] = {1.0, 0.19392274474868576, 0.03760603093086393, 0.007292664737217109, 0.001414213562373095, 0.0002742481756762073, 5.318295896944988e-05, 1.031338537721246e-05};

DI void phase0(const Params& p, char* smem) {
  const int tid = threadIdx.x, gtid = blockIdx.x * 512 + tid, gsz = gridDim.x * 512;
  const int lane = tid & 63, gw = gtid >> 6, nw = gsz >> 6;
  u16* xb = (u16*)(p.ws + OFF_XB);
  float* rss = (float*)(p.ws + OFF_RSS);
  for (int row = gw; row < RP; row += nw) {
    if (row < R) {
      const int b = row / L, l = row - b * L;
      const float* src = l < NMETA ? p.meta + (size_t)l * DM : p.x + ((size_t)b * SEQ + (l - NMETA)) * DM;
      float ss = 0.f;
#pragma unroll
      for (int i = 0; i < 4; ++i) {
        const f32x4 v = *(const f32x4*)(src + i * 256 + lane * 4);
        ss += v[0] * v[0] + v[1] * v[1] + v[2] * v[2] + v[3] * v[3];
        u32x2 o = {cvtpk(v[0], v[1]), cvtpk(v[2], v[3])};
        *(u32x2*)(xb + (size_t)row * DM + i * 256 + lane * 4) = o;
      }
      ss = wave_sum(ss);
      if (lane == 0) rss[(size_t)row * 16] = ss;
    } else {
#pragma unroll
      for (int i = 0; i < 4; ++i) { u32x2 o = {0u, 0u}; *(u32x2*)(xb + (size_t)row * DM + i * 256 + lane * 4) = o; }
      if (lane == 0) rss[(size_t)row * 16] = 1024.f;
    }
    if (lane >= 1 && lane < 16) rss[(size_t)row * 16 + lane] = 0.f;
  }
  {
    u16* WinT = (u16*)(p.ws + OFF_WIN);
    for (long it = gtid; it < (long)DEPTH * 128 * INW; it += gsz) {
      const int nd = (int)(it % INW); const long t2 = it / INW; const int kc = (int)(t2 % 128), li = (int)(t2 / 128);
      const int c1 = nd & 255;
      const int n = (nd & ~255) + ((c1 >> 5) & 3) * 64 + (c1 >> 7) * 32 + (c1 & 31);
      const float* w = p.w_in + ((size_t)li * DM + kc * 8) * INW + n;
      const float* g = p.norm_gain + li * DM + kc * 8;
      float v[8];
#pragma unroll
      for (int j = 0; j < 8; ++j) v[j] = w[(size_t)j * INW] * g[j];
      u32x4 o = {cvtpk(v[0], v[1]), cvtpk(v[2], v[3]), cvtpk(v[4], v[5]), cvtpk(v[6], v[7])};
      *(u32x4*)(WinT + ((size_t)li * INW + nd) * DM + kc * 8) = o;
    }
  }
  {
    u16* WoutT = (u16*)(p.ws + OFF_WOUT);
    for (long it = gtid; it < (long)DEPTH * 128 * DM; it += gsz) {
      const int n = (int)(it % DM); const long t2 = it / DM; const int kc = (int)(t2 % 128), li = (int)(t2 / 128);
      const float* w = p.w_out + ((size_t)li * DM + kc * 8) * DM + n;
      float v[8];
#pragma unroll
      for (int j = 0; j < 8; ++j) v[j] = w[(size_t)j * DM];
      u32x4 o = {cvtpk(v[0], v[1]), cvtpk(v[2], v[3]), cvtpk(v[4], v[5]), cvtpk(v[6], v[7])};
      *(u32x4*)(WoutT + ((size_t)li * DM + n) * DM + kc * 8) = o;
    }
  }
  {
    u16* Cm = (u16*)(p.ws + OFF_CM); u16* Sm = (u16*)(p.ws + OFF_SM);
    for (int it = gtid; it < KROWS * (KP / 8); it += gsz) {
      const int k = it / (KP / 8), j0 = (it % (KP / 8)) * 8;
      float c[8], s[8];
#pragma unroll
      for (int jj = 0; jj < 8; ++jj) {
        const int j = j0 + jj;
        const bool valid = (k <= LH) && (j <= LH);
        const int m = valid ? (k * j) % L : 0;
        const float rev = (float)m / (float)L;
        c[jj] = valid ? __builtin_amdgcn_cosf(rev) : 0.f;
        s[jj] = valid ? __builtin_amdgcn_sinf(rev) : 0.f;
      }
      u32x4 oc = {cvtpk(c[0], c[1]), cvtpk(c[2], c[3]), cvtpk(c[4], c[5]), cvtpk(c[6], c[7])};
      u32x4 os = {cvtpk(s[0], s[1]), cvtpk(s[2], s[3]), cvtpk(s[4], s[5]), cvtpk(s[6], s[7])};
      *(u32x4*)(Cm + (size_t)k * KP + j0) = oc;
      *(u32x4*)(Sm + (size_t)k * KP + j0) = os;
    }
  }
  {
    u16* Mcs = (u16*)(p.ws + OFF_MCS);
    const float norm = 1.0f / sqrtf((float)L * 128.f);
    float* Wl = (float*)smem;
    float* tcs = (float*)(smem + 65536);
    float* tsn = tcs + 128;
    for (int u = blockIdx.x; u < DEPTH * 4 * 16; u += gridDim.x) {
      const int lg = u >> 4, ccb = u & 15;
      const float* wf = p.w_f + (size_t)lg * 128 * 128;
#pragma unroll
      for (int i = 0; i < 8; ++i) *(f32x4*)(Wl + (tid + 512 * i) * 4) = *(const f32x4*)(wf + (tid + 512 * i) * 4);
      if (tid < 128) { const float rev = (float)tid * (1.0f / 128.f); tcs[tid] = __builtin_amdgcn_cosf(rev); tsn[tid] = __builtin_amdgcn_sinf(rev); }
      __syncthreads();
      const int e = tid & 127, cc0 = ccb * 16 + (tid >> 7) * 4;
      const bool isS = ccb >= 8;
      const float* tab = isS ? tsn : tcs;
      const int c0 = cc0 & 127;
      float a0 = 0.f, a1 = 0.f, a2 = 0.f, a3 = 0.f;
      for (int m = 0; m < 128; ++m) {
        const float w = Wl[m * 128 + e];
        a0 += tab[(m * c0) & 127] * w; a1 += tab[(m * (c0 + 1)) & 127] * w; a2 += tab[(m * (c0 + 2)) & 127] * w; a3 += tab[(m * (c0 + 3)) & 127] * w;
      }
      const float sn = isS ? -norm : norm;
      u32x2 o = {cvtpk(a0 * sn, a1 * sn), cvtpk(a2 * sn, a3 * sn)};
      *(u32x2*)(Mcs + ((size_t)lg * 128 + e) * 256 + cc0) = o;
      __syncthreads();
    }
  }
  {
    u16* uta = (u16*)(p.ws + OFF_UTA); u16* utb = (u16*)(p.ws + OFF_UTB);
    for (int it = gtid; it < NB * 512 * 64; it += gsz) {
      const int row = it >> 6, i = it & 63;
      if (i < 55) { uta[(size_t)row * KP + 2057 + i] = 0; utb[(size_t)row * KP + 2057 + i] = 0; }
      else if (i == 55) utb[(size_t)row * KP] = 0;
      else if (i == 56) utb[(size_t)row * KP + LH] = 0;
    }
  }
  {
    u16* qn = (u16*)(p.ws + OFF_QN); u16* kn = (u16*)(p.ws + OFF_KN); u16* vt = (u16*)(p.ws + OFF_VN);
    for (int it = gtid; it < NB * NH * (LP - L) * 16; it += gsz) {
      const int ch = it & 15, rr = (it >> 4) % (LP - L), bh = (it >> 4) / (LP - L);
      const size_t off = ((size_t)bh * LP + L + rr) * 128 + ch * 8;
      u32x4 z = {0u, 0u, 0u, 0u};
      *(u32x4*)(qn + off) = z; *(u32x4*)(kn + off) = z;
    }
    for (int it = gtid; it < NB * NH * 128 * ((LP - L) / 8); it += gsz) {
      const int ch = it % ((LP - L) / 8), row = it / ((LP - L) / 8);
      u32x4 z = {0u, 0u, 0u, 0u};
      *(u32x4*)(vt + (size_t)row * LP + L + ch * 8) = z;
    }
  }
  {
    float* rope = (float*)(p.ws + OFF_ROPE);
    for (int it = gtid; it < L * 8; it += gsz) {
      const int l = it >> 3, i = it & 7;
      double rv = (double)l * INVF[i] * 0.15915494309189535;
      rv -= floor(rv);
      const float r = (float)rv;
      rope[l * 16 + i] = __builtin_amdgcn_cosf(r);
      rope[l * 16 + 8 + i] = __builtin_amdgcn_sinf(r);
    }
  }
  if (blockIdx.x == 0) {
    const int wid = tid >> 6;
    if (wid < DEPTH) {
      const int li = wid;
      float a = p.lq1[li * 64 + lane] * p.lk1[li * 64 + lane];
      float bq = p.lq2[li * 64 + lane] * p.lk2[li * 64 + lane];
      a = wave_sum(a); bq = wave_sum(bq);
      const float gq = wave_max(fabsf(p.qg[li * 64 + lane]));
      const float gk = wave_max(fabsf(p.kg[li * 64 + lane]));
      if (lane == 0) {
        float* cst = (float*)(p.ws + OFF_CST) + li * 8;
        const float lam_init = 0.8f - 0.6f * expf(-0.3f * (float)li);
        cst[0] = expf(a) - expf(bq) + lam_init;
        cst[1] = 1.0f - lam_init;
        cst[2] = (8.0f * gq * gk * 1.01f + 0.05f) * 1.4426950408889634f;
      }
    }
    if (tid < 64) ((int*)(p.ws + OFF_CNT))[tid] = 0;
    for (int i = tid; i < 4 * 2 * 16 * 16; i += 512) ((int*)(p.ws + OFF_Q))[i] = 0;
    float* sm = (float*)(p.ws + OFF_SMALL);
    if (tid < 256) { sm[tid] = p.qg[tid]; sm[256 + tid] = p.kg[tid]; }
    sm[512 + tid] = p.subln[tid];
  }
}

namespace pg8 {
#define PG8_LAS __attribute__((address_space(3)))
constexpr int BM = 256, BK = 64, HALF = 128, HTB = HALF * BK * 2, NXCD = 8, WGM = 8;
DI int lds_byte(int r, int c) { const int st = (r >> 4) * 2 + (c >> 5), rr = r & 15, cc = c & 31, ob = rr * 64 + cc * 2; return st * 1024 + (ob ^ (((ob >> 9) & 1) << 5)); }
DI void stage_rc(int b, int& R, int& C) { const int st = b / 1024, sb = b % 1024, swz = sb ^ (((sb >> 9) & 1) << 5); R = (st >> 1) * 16 + swz / 64; C = (st & 1) * 32 + (swz % 64) / 2; }
DI int perm32(int rho) { const int n = rho >> 4, i = rho & 15; return 8 * (i >> 2) + 4 * n + (i & 3); }
struct Unit { int pm, pn; };
struct Gemm { const u16* A; const u16* Bt; int M, N, K; };
struct StaticOrder {
  int nM, nN, nwg, G, c;
  DI void init(int M, int N, int G_, int c_) { nM = M / BM; nN = N / BM; nwg = nM * nN; G = G_; c = c_; }
  DI bool next(int i, Unit& u) const {
    const long Lx = (long)i * G + c; if (Lx >= nwg) return false;
    int wgid = (int)Lx; { const int q = nwg / NXCD, r = nwg % NXCD, xcd = wgid % NXCD, off = wgid / NXCD; wgid = (xcd < r ? xcd * (q + 1) : r * (q + 1) + (xcd - r) * q) + off; }
    const int nig = WGM * nN, gid = wgid / nig, fm = gid * WGM, gsz = (nM - fm) < WGM ? (nM - fm) : WGM;
    u.pm = fm + ((wgid % nig) % gsz); u.pn = (wgid % nig) / gsz; return true;
  }
  DI void done(int) const {}
};
struct Order {
  int mode; StaticOrder st; int pm, pn; unsigned* sig;
  const unsigned* bready;
  DI void a_ready(const Unit& u) const {
    if (bready == nullptr) return;
    if (threadIdx.x < 64) {
      const int b1 = (u.pm * 256) / L; int b2 = (u.pm * 256 + 255) / L; if (b2 > NB - 1) b2 = NB - 1;
      while ((unsigned)__builtin_amdgcn_readfirstlane(__hip_atomic_load(bready + b1 * 16, __ATOMIC_RELAXED, __HIP_MEMORY_SCOPE_AGENT)) < 200u ||
             (unsigned)__builtin_amdgcn_readfirstlane(__hip_atomic_load(bready + b2 * 16, __ATOMIC_RELAXED, __HIP_MEMORY_SCOPE_AGENT)) < 200u) __builtin_amdgcn_s_sleep(2);
      __builtin_amdgcn_fence(__ATOMIC_ACQUIRE, "agent");
      asm volatile("s_waitcnt vmcnt(0)" ::: "memory");
    }
    asm volatile("" ::: "memory"); __builtin_amdgcn_s_barrier(); asm volatile("" ::: "memory");
  }
  DI bool next(int i, Unit& u) const { if (mode == 0) return st.next(i, u); if (i != 0) return false; u.pm = pm; u.pn = pn; return true; }
  DI void done(int lane) const {
    if (mode == 1) {
      asm volatile("s_waitcnt vmcnt(0)" ::: "memory");
      __builtin_amdgcn_fence(__ATOMIC_RELEASE, "agent");
      asm volatile("s_waitcnt vmcnt(0)" ::: "memory");
      if (lane == 0) __hip_atomic_fetch_add(sig, 1u, __ATOMIC_RELAXED, __HIP_MEMORY_SCOPE_AGENT);
    }
  }
};
template <class Epi, class Sched>
DI void gemm_phase(PG8_LAS unsigned char* lds, const Gemm g, const Sched& S, const Epi& E) {
  const int tid = opaque_tid(), wid = __builtin_amdgcn_readfirstlane(tid >> 6), lane = tid & 63, wr = wid >> 2, wc = wid & 3, fr = lane & 15, fq = lane >> 4;
  const int K = g.K, nt = K / BK;
  unsigned voffA[2], voffB[2];
#pragma unroll
  for (int i = 0; i < 2; ++i) { int R_, C_; stage_rc(tid * 16 + i * 8192, R_, C_); const int Rb = (R_ & ~31) + perm32(R_ & 31);
    voffA[i] = (unsigned)(R_ * K + C_) * 2u; voffB[i] = (unsigned)(Rb * K + C_) * 2u; }
  const size_t kstep = (size_t)(BK * 2);
  const size_t hstep = (size_t)HALF * K * 2;
  const size_t tstep = 2 * hstep;
  const unsigned ldsw = (unsigned)wid * 1024u;
  const int aoff = lds_byte(wr * 64 + fr, fq * 8), boff = lds_byte(wc * 32 + fr, fq * 8);
#define PG8_SA(b, h) (((b) * 2 + (h)) * HTB)
#define PG8_SB(b, h) ((4 + (b) * 2 + (h)) * HTB)
#define PG8_STAGE(bufoff, gbase, voff) do { _Pragma("unroll") for (int _i = 0; _i < 2; ++_i) \
    __builtin_amdgcn_global_load_lds((const unsigned*)((const char*)(gbase) + (voff)[_i]), (PG8_LAS unsigned*)(lds + (bufoff) + ldsw + _i * 8192), 16, 0, 0); } while (0)
#define PG8_LDA(dst, b, h) do { _Pragma("unroll") for (int m = 0; m < 4; ++m) _Pragma("unroll") for (int k = 0; k < 2; ++k) dst[m][k] = *(const PG8_LAS bf16x8*)(lds + PG8_SA(b, h) + aoff + m * 2048 + k * 1024); } while (0)
#define PG8_LDB(dst, b, h) do { _Pragma("unroll") for (int n = 0; n < 2; ++n) _Pragma("unroll") for (int k = 0; k < 2; ++k) dst[n][k] = *(const PG8_LAS bf16x8*)(lds + PG8_SB(b, h) + boff + n * 2048 + k * 1024); } while (0)
#define PG8_MMA(ai, bj, At, Bt) do { __builtin_amdgcn_s_setprio(1); _Pragma("unroll") for (int m = 0; m < 4; ++m) _Pragma("unroll") for (int n = 0; n < 2; ++n) _Pragma("unroll") for (int k = 0; k < 2; ++k) \
    acc[ai][bj][m][n] = __builtin_amdgcn_mfma_f32_16x16x32_bf16(Bt[n][k], At[m][k], acc[ai][bj][m][n], 0, 0, 0); __builtin_amdgcn_s_setprio(0); } while (0)
#define PG8_WAIT_V(n) asm volatile("s_waitcnt vmcnt(" #n ")" ::: "memory")
#define PG8_WAIT_L(n) asm volatile("s_waitcnt lgkmcnt(" #n ")" ::: "memory")
#define PG8_BAR __builtin_amdgcn_s_barrier()
#define PG8_SCHED __builtin_amdgcn_sched_barrier(0)
  Unit cur, nxt; int ui = 0;
  if (!S.next(0, cur)) return;
  f32x4 acc[2][2][4][2];
#pragma unroll
  for (int a = 0; a < 2; ++a)
#pragma unroll
    for (int b = 0; b < 2; ++b)
#pragma unroll
      for (int m = 0; m < 4; ++m)
#pragma unroll
        for (int n = 0; n < 2; ++n) acc[a][b][m][n] = (f32x4){0.f, 0.f, 0.f, 0.f};
  bf16x8 At[4][2], B0[2][2], B1[2][2];
  const char* cA = (const char*)g.A + (size_t)cur.pm * tstep; const char* cB = (const char*)g.Bt + (size_t)cur.pn * tstep;
  S.a_ready(cur);
  PG8_STAGE(PG8_SB(0, 0), cB, voffB); PG8_STAGE(PG8_SA(0, 0), cA, voffA); PG8_STAGE(PG8_SB(0, 1), cB + hstep, voffB); PG8_STAGE(PG8_SA(0, 1), cA + hstep, voffA);
  if (wr == 1) PG8_BAR;
  PG8_WAIT_V(4); PG8_BAR;
  PG8_STAGE(PG8_SB(1, 0), cB + kstep, voffB); PG8_STAGE(PG8_SA(1, 0), cA + kstep, voffA); PG8_STAGE(PG8_SB(1, 1), cB + hstep + kstep, voffB);
  PG8_WAIT_V(6); PG8_BAR;
  for (;;) {
    const bool has_next = S.next(ui + 1, nxt);
    const char* nA = has_next ? (const char*)g.A + (size_t)nxt.pm * tstep : cA; const char* nB = has_next ? (const char*)g.Bt + (size_t)nxt.pn * tstep : cB;
    for (int t = 0; t < nt; t += 2) {
      const bool last = (t == nt - 2);
      const char* a1 = cA + (size_t)(t + 1) * kstep;
      const char* a2 = last ? nA : cA + (size_t)(t + 2) * kstep; const char* b2 = last ? nB : cB + (size_t)(t + 2) * kstep;
      const char* a3 = a2 + kstep; const char* b3 = b2 + kstep;
      if (last && has_next) S.a_ready(nxt);
      PG8_LDB(B0, 0, 0); PG8_SCHED; PG8_LDA(At, 0, 0); PG8_STAGE(PG8_SA(1, 1), a1 + hstep, voffA);
      PG8_WAIT_L(8); PG8_BAR; PG8_WAIT_L(0); PG8_MMA(0, 0, At, B0); PG8_BAR; PG8_SCHED;
      PG8_LDB(B1, 0, 1); PG8_STAGE(PG8_SB(0, 0), b2, voffB);
      PG8_BAR; PG8_WAIT_L(0); PG8_MMA(0, 1, At, B1); PG8_BAR;
      PG8_LDA(At, 0, 1); PG8_STAGE(PG8_SA(0, 0), a2, voffA);
      PG8_BAR; PG8_WAIT_L(0); PG8_MMA(1, 0, At, B0); PG8_BAR; PG8_SCHED;
      PG8_STAGE(PG8_SB(0, 1), b2 + hstep, voffB);
      PG8_WAIT_V(6); PG8_BAR; PG8_MMA(1, 1, At, B1); PG8_BAR;
      PG8_LDB(B0, 1, 0); PG8_SCHED; PG8_LDA(At, 1, 0); PG8_STAGE(PG8_SA(0, 1), a2 + hstep, voffA);
      PG8_WAIT_L(8); PG8_BAR; PG8_WAIT_L(0); PG8_MMA(0, 0, At, B0); PG8_BAR; PG8_SCHED;
      PG8_LDB(B1, 1, 1); PG8_STAGE(PG8_SB(1, 0), b3, voffB);
      PG8_BAR; PG8_WAIT_L(0); PG8_MMA(0, 1, At, B1); PG8_BAR;
      PG8_LDA(At, 1, 1); PG8_STAGE(PG8_SA(1, 0), a3, voffA);
      PG8_BAR; PG8_WAIT_L(0); PG8_MMA(1, 0, At, B0); PG8_BAR; PG8_SCHED;
      PG8_STAGE(PG8_SB(1, 1), b3 + hstep, voffB);
      PG8_WAIT_V(6); PG8_BAR; PG8_MMA(1, 1, At, B1); PG8_BAR;
    }
    E(acc, cur, wr, wc, fr, fq);
    S.done(lane);
    if (!has_next) break;
#pragma unroll
    for (int a = 0; a < 2; ++a)
#pragma unroll
      for (int b = 0; b < 2; ++b)
#pragma unroll
        for (int m = 0; m < 4; ++m)
#pragma unroll
          for (int n = 0; n < 2; ++n) acc[a][b][m][n] = (f32x4){0.f, 0.f, 0.f, 0.f};
    cur = nxt; cA = nA; cB = nB; ++ui;
  }
  PG8_WAIT_V(0);
  if (wr == 0) PG8_BAR;
  PG8_BAR;
#undef PG8_SA
#undef PG8_SB
#undef PG8_STAGE
#undef PG8_LDA
#undef PG8_LDB
#undef PG8_MMA
#undef PG8_WAIT_V
#undef PG8_WAIT_L
#undef PG8_BAR
#undef PG8_SCHED
}
}

DI float row_scale(const float* rsp, int row) {
  const f32x4* rp = (const f32x4*)(rsp + (size_t)row * 16);
  const f32x4 a0 = rp[0], a1 = rp[1], a2 = rp[2], a3 = rp[3];
  const float s = ((a0[0] + a0[1]) + (a0[2] + a0[3])) + ((a1[0] + a1[1]) + (a1[2] + a1[3])) + ((a2[0] + a2[1]) + (a2[2] + a2[3])) + ((a3[0] + a3[1]) + (a3[2] + a3[3]));
  return rsqrtf(s * (1.0f / DM) + EPS);
}

struct EpiA {
  char* ws; int li;
  DI void operator()(const f32x4 (&acc)[2][2][4][2], const pg8::Unit& u, int wr, int wc, int fr, int fq) const {
    const int mt = u.pm, nt = u.pn;
    const float* rsp = (const float*)(ws + OFF_RSS);
    const int b0 = (mt * 256) / L;
    const int rbase = mt * 256 + wr * 64 + fr;
    float scv[2][4];
    {
      const int lane_ = fq * 16 + fr, r0_ = mt * 256 + wr * 64 + lane_;
      const float so0 = row_scale(rsp, r0_ < R ? r0_ : 0), so1 = row_scale(rsp, r0_ + 128 < R ? r0_ + 128 : 0);
#pragma unroll
      for (int m = 0; m < 4; ++m) { scv[0][m] = __shfl(so0, m * 16 + fr); scv[1][m] = __shfl(so1, m * 16 + fr); }
    }
    if (nt < 2) {
      u16* uta = (u16*)(ws + OFF_UTA); u16* utb = (u16*)(ws + OFF_UTB);
      const int chb = nt * 256 + wc * 64 + 8 * fq;
#pragma unroll
      for (int ai = 0; ai < 2; ++ai)
#pragma unroll
        for (int m = 0; m < 4; ++m) {
          const int row = rbase + ai * 128 + m * 16;
          if (row < R) {
            int b, l; row_bl(row, b0, b, l);
            const float sc = scv[ai][m];
            u16* dst = (l <= LH) ? uta + (size_t)b * 512 * KP + l : utb + (size_t)b * 512 * KP + (L - l);
#pragma unroll
            for (int bj = 0; bj < 2; ++bj)
#pragma unroll
              for (int n = 0; n < 2; ++n)
#pragma unroll
                for (int j = 0; j < 4; ++j) dst[(size_t)(chb + bj * 32 + n * 4 + j) * KP] = f2bf(acc[ai][bj][m][n][j] * sc);
          }
          CBAR();
        }
    } else if (nt < 6) {
      const bool isq = nt < 4;
      const int gi = (isq ? nt - 2 : nt - 4) * 4 + wc;
      const int h = gi >> 1, comp = gi & 1;
      const float* gain = (const float*)(ws + OFF_SMALL) + (isq ? 0 : 256) + li * 64 + 8 * fq;
      const f32x4 g00 = *(const f32x4*)(gain), g01 = *(const f32x4*)(gain + 4), g10 = *(const f32x4*)(gain + 32), g11 = *(const f32x4*)(gain + 36);
      const float qsc = isq ? 0.125f * 1.4426950408889634f : 1.0f;
      const float* rope = (const float*)(ws + OFF_ROPE);
      u16* dbase = (u16*)(ws + (isq ? OFF_QN : OFF_KN));
#pragma unroll
      for (int ai = 0; ai < 2; ++ai)
#pragma unroll
        for (int m = 0; m < 4; ++m) {
          const int row = rbase + ai * 128 + m * 16;
          const bool valid = row < R;
          const int rowc = valid ? row : 0;
          int b, l; row_bl(rowc, valid ? b0 : 0, b, l);
          const float sc = scv[ai][m];
          f32x4 v00 = acc[ai][0][m][0] * sc, v01 = acc[ai][0][m][1] * sc, v10 = acc[ai][1][m][0] * sc, v11 = acc[ai][1][m][1] * sc;
          float ss = 0.f;
#pragma unroll
          for (int j = 0; j < 4; ++j) ss += v00[j] * v00[j] + v01[j] * v01[j] + v10[j] * v10[j] + v11[j] * v11[j];
          ss += __shfl_xor(ss, 16); ss += __shfl_xor(ss, 32);
          const float rq = rsqrtf(ss * (1.0f / 64.f) + EPS) * qsc;
          v00 = v00 * g00 * rq; v01 = v01 * g01 * rq; v10 = v10 * g10 * rq; v11 = v11 * g11 * rq;
          const f32x4 c0 = *(const f32x4*)(rope + l * 16), c1 = *(const f32x4*)(rope + l * 16 + 4), s0 = *(const f32x4*)(rope + l * 16 + 8), s1 = *(const f32x4*)(rope + l * 16 + 12);
          f32x4 p0, p1;
#pragma unroll
          for (int j = 0; j < 4; ++j) { p0[j] = __shfl_xor(v00[j], 16); p1[j] = __shfl_xor(v01[j], 16); }
          if (fq == 0) { v00 = v00 * c0 - p0 * s0; v01 = v01 * c1 - p1 * s1; }
          else if (fq == 1) { v00 = v00 * c0 + p0 * s0; v01 = v01 * c1 + p1 * s1; }
          if (valid) {
            u16* dst = dbase + (((size_t)(b * NH + h)) * LP + l) * 128 + comp * 64 + 8 * fq;
            u32x4 w0 = {cvtpk(v00[0], v00[1]), cvtpk(v00[2], v00[3]), cvtpk(v01[0], v01[1]), cvtpk(v01[2], v01[3])};
            u32x4 w1 = {cvtpk(v10[0], v10[1]), cvtpk(v10[2], v10[3]), cvtpk(v11[0], v11[1]), cvtpk(v11[2], v11[3])};
            *(u32x4*)(dst) = w0; *(u32x4*)(dst + 32) = w1;
          }
          CBAR();
        }
    } else if (nt < 8) {
      const int cv = (nt - 6) * 256 + wc * 64;
      const int h = cv >> 7, dv = (cv & 127) + 8 * fq;
      u16* vt = (u16*)(ws + OFF_VN);
#pragma unroll
      for (int ai = 0; ai < 2; ++ai)
#pragma unroll
        for (int m = 0; m < 4; ++m) {
          const int row = rbase + ai * 128 + m * 16;
          if (row < R) {
            int b, l; row_bl(row, b0, b, l);
            const float sc = scv[ai][m];
            const int o = l & 15;
            const int pos = (l & ~15) + 8 * ((o >> 2) & 1) + 4 * (o >> 3) + (o & 3);
            u16* dst = vt + ((size_t)(b * NH + h) * 128 + dv) * LP + pos;
#pragma unroll
            for (int bj = 0; bj < 2; ++bj)
#pragma unroll
              for (int n = 0; n < 2; ++n)
#pragma unroll
                for (int j = 0; j < 4; ++j) dst[(size_t)(bj * 32 + n * 4 + j) * LP] = f2bf(acc[ai][bj][m][n][j] * sc);
          }
          CBAR();
        }
    } else {
      u16* gg = (u16*)(ws + OFF_GG);
      const int cgc = (nt - 8) * 256 + wc * 64 + 8 * fq;
#pragma unroll
      for (int ai = 0; ai < 2; ++ai)
#pragma unroll
        for (int m = 0; m < 4; ++m) {
          const int row = rbase + ai * 128 + m * 16;
          if (row < R) {
            const float sc = scv[ai][m];
            u16* dst = gg + (size_t)row * DM + cgc;
#pragma unroll
            for (int bj = 0; bj < 2; ++bj) {
              f32x4 a = acc[ai][bj][m][0] * sc, c = acc[ai][bj][m][1] * sc;
#pragma unroll
              for (int j = 0; j < 4; ++j) { a[j] = a[j] * __builtin_amdgcn_rcpf(1.0f + __expf(-a[j])); c[j] = c[j] * __builtin_amdgcn_rcpf(1.0f + __expf(-c[j])); }
              u32x4 w = {cvtpk(a[0], a[1]), cvtpk(a[2], a[3]), cvtpk(c[0], c[1]), cvtpk(c[2], c[3])};
              *(u32x4*)(dst + bj * 32) = w;
            }
          }
          CBAR();
        }
    }
  }
};
DI void phaseA(const P2& p, int li, char* smem, int mode, int pn, unsigned* sig) {
  pg8::Gemm g; g.A = (const u16*)(p.ws + OFF_XB); g.Bt = (const u16*)(p.ws + OFF_WIN) + (size_t)li * INW * DM; g.M = RP; g.N = INW; g.K = DM;
  pg8::Order S; S.mode = mode; S.st.init(RP - 256, INW, gridDim.x, blockIdx.x); S.pm = RP / 256 - 1; S.pn = pn; S.sig = sig; S.bready = nullptr;
  EpiA E; E.ws = p.ws; E.li = li;
  pg8::gemm_phase((PG8_LAS unsigned char*)smem, g, S, E);
}

struct EpiC {
  char* ws; float* out; const float* x; const float* meta; int li;
  DI void operator()(const f32x4 (&acc)[2][2][4][2], const pg8::Unit& u, int wr, int wc, int fr, int fq) const {
    const int mt = u.pm, nt = u.pn;
    const bool last = (li == DEPTH - 1), first = (li == 0);
    u16* xb = (u16*)(ws + OFF_XB);
    float* rsp = (float*)(ws + OFF_RSS);
    const int b0 = (mt * 256) / L;
    const int rbase = mt * 256 + wr * 64 + fr;
    const int cb = nt * 256 + wc * 32 + 8 * fq;
#pragma unroll
    for (int ai = 0; ai < 2; ++ai)
#pragma unroll
      for (int m = 0; m < 4; ++m) {
        const int row = rbase + ai * 128 + m * 16;
        const bool valid = row < R;
        float ss = 0.f;
        if (valid) {
          int b, l; row_bl(row, b0, b, l);
          u16* xr = xb + (size_t)row * DM + cb;
          const float* xin = (l < NMETA ? meta + (size_t)l * DM : x + ((size_t)b * SEQ + (l - NMETA)) * DM) + cb;
          float* orow = out + ((size_t)b * SEQ + (l - NMETA)) * DM + cb;
#pragma unroll
          for (int bj = 0; bj < 2; ++bj) {
            f32x4 a, c;
            if (first) { a = *(const f32x4*)(xin + bj * 128); c = *(const f32x4*)(xin + bj * 128 + 4); }
            else { const u32x4 w = *(const u32x4*)(xr + bj * 128);
              a = f32x4{__uint_as_float(w[0] << 16), __uint_as_float(w[0] & 0xffff0000u), __uint_as_float(w[1] << 16), __uint_as_float(w[1] & 0xffff0000u)};
              c = f32x4{__uint_as_float(w[2] << 16), __uint_as_float(w[2] & 0xffff0000u), __uint_as_float(w[3] << 16), __uint_as_float(w[3] & 0xffff0000u)}; }
            a += acc[ai][bj][m][0]; c += acc[ai][bj][m][1];
            if (last) { if (l >= NMETA) { *(f32x4*)(orow + bj * 128) = a; *(f32x4*)(orow + bj * 128 + 4) = c; } }
            else { u32x4 w = {cvtpk(a[0], a[1]), cvtpk(a[2], a[3]), cvtpk(c[0], c[1]), cvtpk(c[2], c[3])}; *(u32x4*)(xr + bj * 128) = w; }
#pragma unroll
            for (int j = 0; j < 4; ++j) ss += a[j] * a[j] + c[j] * c[j];
          }
        }
        ss += __shfl_xor(ss, 16); ss += __shfl_xor(ss, 32);
        if (valid && !last && fq == 0) rsp[(size_t)row * 16 + nt * 4 + wc] = ss;
        if (m == 1 || m == 3) CBAR();
      }
  }
};
DI void phaseC(const P2& p, int li, char* smem, int mode, int pn, unsigned* sig) {
  pg8::Gemm g; g.A = (const u16*)(p.ws + OFF_GY); g.Bt = (const u16*)(p.ws + OFF_WOUT) + (size_t)li * DM * DM; g.M = RP; g.N = DM; g.K = DM;
  pg8::Order S; S.mode = mode; S.st.init(li == DEPTH - 1 ? RP : RP - 256, DM, gridDim.x, blockIdx.x); S.pm = RP / 256 - 1; S.pn = pn; S.sig = sig;
  S.bready = nullptr;
  EpiC E; E.ws = p.ws; E.out = p.out; E.x = p.x; E.meta = p.meta; E.li = li;
  pg8::gemm_phase((PG8_LAS unsigned char*)smem, g, S, E);
}

#define KSWZ(row, colB) ((row) * 256 + ((colB) ^ (((row) & 15) << 4)))
DI int v_st(int k, int c) { const int kk = (k & ~0xC) | ((k & 4) << 1) | ((k & 8) >> 1); return ((kk >> 3) * 4 + (c >> 5)) * 512 + ((kk & 7) * 32 + (c & 31)) * 2; }
DI int v_rd_base(int lane) { return ((lane & 3) << 3) | (((lane >> 2) & 3) << 6) | (((lane >> 4) & 1) << 5) | (((lane >> 5) & 1) << 8); }
constexpr int v_rd_off(int d0, int ks, int half) { return d0 * 512 + ks * 4096 + half * 2048; }
template <int OFF> DI s16x4 tr_read(int vb) {
  s16x4 r; asm volatile("ds_read_b64_tr_b16 %0, %1 offset:%2" : "=&v"(r) : "v"(vb), "i"(OFF) : "memory"); return r;
}
template <int D0> DI void pv_one(f32x16& od, int vb, bf16x8 pa0, bf16x8 pa1, bf16x8 pa2, bf16x8 pa3) {
  const s16x4 l0 = tr_read<v_rd_off(D0, 0, 0)>(vb), h0 = tr_read<v_rd_off(D0, 0, 1)>(vb), l1 = tr_read<v_rd_off(D0, 1, 0)>(vb), h1 = tr_read<v_rd_off(D0, 1, 1)>(vb);
  const s16x4 l2 = tr_read<v_rd_off(D0, 2, 0)>(vb), h2 = tr_read<v_rd_off(D0, 2, 1)>(vb), l3 = tr_read<v_rd_off(D0, 3, 0)>(vb), h3 = tr_read<v_rd_off(D0, 3, 1)>(vb);
  asm volatile("s_waitcnt lgkmcnt(0)" ::: "memory"); __builtin_amdgcn_sched_barrier(0);
#define PKV(Lo, Hi) (bf16x8){Lo[0], Lo[1], Lo[2], Lo[3], Hi[0], Hi[1], Hi[2], Hi[3]}
  od = MFMA32(pa0, PKV(l0, h0), od);
  od = MFMA32(pa1, PKV(l1, h1), od);
  od = MFMA32(pa2, PKV(l2, h2), od);
  od = MFMA32(pa3, PKV(l3, h3), od);
#undef PKV
}

DI void attn_tile(const P2& p, int li, int item, char* smem) {
  const int tid = opaque_tid(), wid = tid >> 6, lane = tid & 63, r32 = lane & 31, hi = lane >> 5;
  const int cm = wid >> 2, rg = wid & 3;
  const int bh = item / 33, qb = item - bh * 33;
  const int b = bh >> 2, h = bh & 3;
  const u16* Qh = (const u16*)(p.ws + OFF_QN) + (size_t)bh * LP * 128;
  const u16* Kh = (const u16*)(p.ws + OFF_KN) + (size_t)bh * LP * 128;
  const u16* Vh = (const u16*)(p.ws + OFF_VN) + (size_t)bh * 128 * LP;
  const float* cst = (const float*)(p.ws + OFF_CST) + li * 8;
  const float lam = cst[0], oml = cst[1];
  const int lq = qb * 128 + rg * 32 + r32;
  bf16x8 qr[4];
#pragma unroll
  for (int d0 = 0; d0 < 4; ++d0) qr[d0] = *(const bf16x8*)(Qh + (size_t)lq * 128 + cm * 64 + d0 * 16 + hi * 8);
  PG8_LAS unsigned char* ldsp = (PG8_LAS unsigned char*)smem;
  const int widu = __builtin_amdgcn_readfirstlane(wid);
  int kgo[2], vgo[2];
#pragma unroll
  for (int q = 0; q < 2; ++q) {
    const int rowk = 8 * wid + 4 * q + (lane >> 4), rowv = 16 * wid + 8 * q + (lane >> 3);
    kgo[q] = rowk * 128 + (((lane & 15) ^ (rowk & 15)) << 3);
    vgo[q] = rowv * LP + (((lane & 7) ^ ((rowv >> 1) & 7)) << 3);
  }
  int voff[4];
#pragma unroll
  for (int ks = 0; ks < 4; ++ks) voff[ks] = 16384 + r32 * 128 + (((2 * ks + hi) ^ ((r32 >> 1) & 7)) << 4);
  int koff[4];
#pragma unroll
  for (int d0 = 0; d0 < 4; ++d0) koff[d0] = r32 * 256 + ((cm * 128 + d0 * 32 + hi * 16) ^ ((r32 & 15) << 4));
  f32x16 o[4];
#pragma unroll
  for (int d = 0; d < 4; ++d)
#pragma unroll
    for (int r = 0; r < 16; ++r) o[d][r] = 0.f;
  float lsum = 0.f;
  f32x16 pA0, pA1, pB0, pB1;
  bf16x8 pa0, pa1, pa2, pa3;
#define SBAR() __builtin_amdgcn_sched_barrier(0)
#define GLDS(t, slot) do { const u16* kt_ = Kh + (size_t)(t) * 64 * 128; const u16* vt_ = Vh + (size_t)(t) * 64; \
    _Pragma("unroll") for (int q = 0; q < 2; ++q) __builtin_amdgcn_global_load_lds((const unsigned*)(kt_ + kgo[q]), (PG8_LAS unsigned*)(ldsp + (slot) + (2 * widu + q) * 1024), 16, 0, 0); \
    _Pragma("unroll") for (int q = 0; q < 2; ++q) __builtin_amdgcn_global_load_lds((const unsigned*)(vt_ + vgo[q]), (PG8_LAS unsigned*)(ldsp + (slot) + 16384 + (2 * widu + q) * 1024), 16, 0, 0); } while (0)
#define QKMM(P0, P1, kb_) do { _Pragma("unroll") for (int d0 = 0; d0 < 4; ++d0) { \
      const bf16x8 b0_ = *(const bf16x8*)((kb_) + koff[d0]); const bf16x8 b1_ = *(const bf16x8*)((kb_) + koff[d0] + 8192); \
      P0 = MFMA32(b0_, qr[d0], P0); P1 = MFMA32(b1_, qr[d0], P1); } } while (0)
  \
  \
#define QKT(P0, P1, ro, MASKED) do { const char* kb_ = smem + (ro); \
    _Pragma("unroll") for (int r = 0; r < 16; ++r) { P0[r] = 0.f; P1[r] = 0.f; } \
    QKMM(P0, P1, kb_); \
    if (MASKED) { _Pragma("unroll") for (int r = 8; r < 16; ++r) P0[r] = -1e30f; _Pragma("unroll") for (int r = 0; r < 16; ++r) P1[r] = -1e30f; } } while (0)
#define EXPS(P0, P1) do { _Pragma("unroll") for (int r = 0; r < 16; ++r) { P0[r] = __builtin_amdgcn_exp2f(P0[r]); P1[r] = __builtin_amdgcn_exp2f(P1[r]); } } while (0)
#define EXPH(P, B0_) do { _Pragma("unroll") for (int r = 0; r < 8; ++r) P[(B0_) + r] = __builtin_amdgcn_exp2f(P[(B0_) + r]); } while (0)
#define PK4(P, BASE, OUT) do { u32x4 w = {cvtpk(P[BASE + 0], P[BASE + 1]), cvtpk(P[BASE + 2], P[BASE + 3]), cvtpk(P[BASE + 4], P[BASE + 5]), cvtpk(P[BASE + 6], P[BASE + 7])}; \
    OUT = *reinterpret_cast<bf16x8*>(&w); } while (0)
#define PACK(P0, P1) do { float s0_ = P0[0], s1_ = P0[1], s2_ = P0[2], s3_ = P0[3]; \
    _Pragma("unroll") for (int r = 4; r < 16; r += 4) { s0_ = addf(s0_, P0[r]); s1_ = addf(s1_, P0[r + 1]); s2_ = addf(s2_, P0[r + 2]); s3_ = addf(s3_, P0[r + 3]); } \
    _Pragma("unroll") for (int r = 0; r < 16; r += 4) { s0_ = addf(s0_, P1[r]); s1_ = addf(s1_, P1[r + 1]); s2_ = addf(s2_, P1[r + 2]); s3_ = addf(s3_, P1[r + 3]); } \
    lsum += (s0_ + s1_) + (s2_ + s3_); \
    PK4(P0, 0, pa0); PK4(P0, 8, pa1); PK4(P1, 0, pa2); PK4(P1, 8, pa3); } while (0)
  \
  \
#define LOADV(V, D0, vb) do { V[0] = *(const bf16x8*)((vb) + voff[0] + (D0) * 4096); V[1] = *(const bf16x8*)((vb) + voff[1] + (D0) * 4096); \
    V[2] = *(const bf16x8*)((vb) + voff[2] + (D0) * 4096); V[3] = *(const bf16x8*)((vb) + voff[3] + (D0) * 4096); } while (0)
#define MMV(D0, V) do { o[D0] = MFMA32(pa0, V[0], o[D0]); o[D0] = MFMA32(pa1, V[1], o[D0]); o[D0] = MFMA32(pa2, V[2], o[D0]); o[D0] = MFMA32(pa3, V[3], o[D0]); } while (0)
#define STEP(C0, C1, N0, N1, jj, NX, MASKED) do { const int j_ = (jj); \
    if (j_ + 3 < NKT) GLDS(j_ + 3, ((j_ + 3) & 3) * 32768);          \
    SBAR(); \
    if (act) { if (NX) QKT(N0, N1, ((j_ + 1) & 3) * 32768, MASKED); \
    PACK(C0, C1); } \
    SBAR(); \
    if (act) { const char* vb_ = smem + (j_ & 3) * 32768; bf16x8 va_[4], vc_[4]; \
      LOADV(va_, 0, vb_); SBAR(); \
      LOADV(vc_, 1, vb_); SBAR(); MMV(0, va_); if (NX) EXPH(N0, 0); SBAR(); \
      LOADV(va_, 2, vb_); SBAR(); MMV(1, vc_); if (NX) EXPH(N0, 8); SBAR(); \
      LOADV(vc_, 3, vb_); SBAR(); MMV(2, va_); if (NX) EXPH(N1, 0); SBAR(); \
      MMV(3, vc_); if (NX) EXPH(N1, 8); } \
    SBAR(); \
    if (j_ + 3 < NKT) asm volatile("s_waitcnt vmcnt(4)" ::: "memory"); else asm volatile("s_waitcnt vmcnt(0)" ::: "memory");     \
    asm volatile("s_waitcnt lgkmcnt(0)" ::: "memory"); \
    __builtin_amdgcn_s_barrier(); \
    asm volatile("" ::: "memory"); SBAR(); } while (0)
  GLDS(0, 0); GLDS(1, 32768); GLDS(2, 65536);
  asm volatile("s_waitcnt vmcnt(4)" ::: "memory");
  __builtin_amdgcn_s_barrier();
  asm volatile("" ::: "memory"); SBAR();
  const bool act = (qb < 32) || (rg == 0);
  QKT(pA0, pA1, 0, 0); EXPS(pA0, pA1);
  for (int j = 0; j < NKT - 3; j += 2) {
    STEP(pA0, pA1, pB0, pB1, j, 1, 0);
    STEP(pB0, pB1, pA0, pA1, j + 1, 1, 0);
  }
  STEP(pA0, pA1, pB0, pB1, NKT - 3, 1, 0);
  STEP(pB0, pB1, pA0, pA1, NKT - 2, 1, 1);
  STEP(pA0, pA1, pB0, pB1, NKT - 1, 0, 0);
  __syncthreads();
#undef STEP
#undef LOADV
#undef MMV
#undef PACK
#undef PK4
#undef EXPS
#undef EXPH
#undef QKT
#undef QKMM
#undef GLDS
  lsum += __shfl_xor(lsum, 32);
  float inv = 1.0f / lsum; if (cm == 1) inv *= lam;
  float* li_l = (float*)(smem + 98304) + wid * 32;
  if (hi == 0) li_l[r32] = inv;
  __syncthreads();
  float rl[16];
#pragma unroll
  for (int r = 0; r < 16; ++r) rl[r] = li_l[crow(r, hi)];
#pragma unroll
  for (int d = 0; d < 4; ++d)
#pragma unroll
    for (int r = 0; r < 16; ++r) o[d][r] *= rl[r];
  float* xbuf = (float*)smem + rg * 4096;
  if (cm == 1) {
#pragma unroll
    for (int d = 0; d < 4; ++d)
#pragma unroll
      for (int r = 0; r < 16; ++r) xbuf[crow(r, hi) * 128 + d * 32 + r32] = o[d][r];
  }
  __syncthreads();
  if (cm == 0) {
    u16* gy = (u16*)(p.ws + OFF_GY); const u16* gg = (const u16*)(p.ws + OFF_GG);
    const float* sg = (const float*)(p.ws + OFF_SMALL) + 512 + li * 128;
    const float s0 = sg[r32], s1 = sg[32 + r32], s2 = sg[64 + r32], s3 = sg[96 + r32];
#pragma unroll
    for (int r = 0; r < 16; ++r) {
      const int rr = crow(r, hi);
      const float v0 = o[0][r] - xbuf[rr * 128 + r32], v1 = o[1][r] - xbuf[rr * 128 + 32 + r32];
      const float v2 = o[2][r] - xbuf[rr * 128 + 64 + r32], v3 = o[3][r] - xbuf[rr * 128 + 96 + r32];
      float ss = v0 * v0 + v1 * v1 + v2 * v2 + v3 * v3;
      ss += __shfl_xor(ss, 1); ss += __shfl_xor(ss, 2); ss += __shfl_xor(ss, 4); ss += __shfl_xor(ss, 8); ss += __shfl_xor(ss, 16);
      const float rinv = rsqrtf(ss * (1.0f / 128.f) + EPS) * oml;
      xbuf[rr * 128 + r32] = v0 * rinv * s0; xbuf[rr * 128 + 32 + r32] = v1 * rinv * s1;
      xbuf[rr * 128 + 64 + r32] = v2 * rinv * s2; xbuf[rr * 128 + 96 + r32] = v3 * rinv * s3;
    }
    asm volatile("s_waitcnt lgkmcnt(0)" ::: "memory");
#pragma unroll
    for (int it = 0; it < 8; ++it) {
      const int rw = it * 4 + (lane >> 4), c8 = (lane & 15) * 8;
      const int l = qb * 128 + rg * 32 + rw;
      const f32x4 a = *(const f32x4*)(xbuf + rw * 128 + c8), c = *(const f32x4*)(xbuf + rw * 128 + c8 + 4);
      if (l < L) {
        const size_t go = ((size_t)(b * L + l)) * DM + 512 + h * 128 + c8;
        const u32x4 gt = *(const u32x4*)(gg + go);
        u32x4 w;
        w[0] = cvtpk(a[0] * __uint_as_float(gt[0] << 16), a[1] * __uint_as_float(gt[0] & 0xffff0000u));
        w[1] = cvtpk(a[2] * __uint_as_float(gt[1] << 16), a[3] * __uint_as_float(gt[1] & 0xffff0000u));
        w[2] = cvtpk(c[0] * __uint_as_float(gt[2] << 16), c[1] * __uint_as_float(gt[2] & 0xffff0000u));
        w[3] = cvtpk(c[2] * __uint_as_float(gt[3] << 16), c[3] * __uint_as_float(gt[3] & 0xffff0000u));
        *(u32x4*)(gy + go) = w;
      }
    }
  }
  __syncthreads();
}

DI void fourier_tile(const P2& p, int li, int item, char* smem) {
  const int tid = opaque_tid(), wid = tid >> 6, lane = tid & 63, fr = lane & 15, fq = lane >> 4;
  const int qd = wid >> 2, wq = wid & 3;
  const int b = item / 36, rem = item - b * 36, g = rem / 9, kt = rem - g * 9;
  const u16* Cm = (const u16*)(p.ws + OFF_CM); const u16* Sm = (const u16*)(p.ws + OFF_SM);
  const u16* uta = (const u16*)(p.ws + OFF_UTA); const u16* utb = (const u16*)(p.ws + OFF_UTB);
  char* As = smem; char* Bs = smem + 65536;
  const int srow = tid >> 3, scc = tid & 7;
  const int soff = srow * 128 + ((scc ^ ((srow >> 1) & 7)) << 4);
  const u16* cgp = Cm + (size_t)(kt * 128 + srow) * KP + scc * 8;
  const u16* sgp = Sm + (size_t)(kt * 128 + srow) * KP + scc * 8;
  const u16* uap = uta + ((size_t)(b * 512 + g * 128 + srow)) * KP + scc * 8;
  const u16* ubp = utb + ((size_t)(b * 512 + g * 128 + srow)) * KP + scc * 8;
  u32x4 raA[4], ruaA[2], rubA[2];
#define FLOAD(ra, rua, rub, k2) do { ra[0] = *(const u32x4*)(cgp + (k2) * 64); ra[1] = *(const u32x4*)(cgp + (size_t)64 * KP + (k2) * 64); \
    ra[2] = *(const u32x4*)(sgp + (k2) * 64); ra[3] = *(const u32x4*)(sgp + (size_t)64 * KP + (k2) * 64); \
    rua[0] = *(const u32x4*)(uap + (k2) * 64); rua[1] = *(const u32x4*)(uap + (size_t)64 * KP + (k2) * 64); \
    rub[0] = *(const u32x4*)(ubp + (k2) * 64); rub[1] = *(const u32x4*)(ubp + (size_t)64 * KP + (k2) * 64); } while (0)
#define FWRITE(ra, rua, rub, bf) do { _Pragma("unroll") for (int i = 0; i < 4; ++i) *(u32x4*)(As + (bf) * 32768 + soff + i * 8192) = ra[i]; \
    _Pragma("unroll") for (int i = 0; i < 2; ++i) { u32x4 ev, ov; \
      _Pragma("unroll") for (int d = 0; d < 4; ++d) { const unsigned ua_ = rua[i][d], ub_ = rub[i][d]; \
        const float al = __uint_as_float(ua_ << 16), ah = __uint_as_float(ua_ & 0xffff0000u); \
        const float bl = __uint_as_float(ub_ << 16), bh_ = __uint_as_float(ub_ & 0xffff0000u); \
        ev[d] = cvtpk(al + bl, ah + bh_); ov[d] = cvtpk(al - bl, ah - bh_); } \
      *(u32x4*)(Bs + (bf) * 32768 + soff + i * 8192) = ev; *(u32x4*)(Bs + (bf) * 32768 + 16384 + soff + i * 8192) = ov; } } while (0)
  f32x4 acc[8][2], acc2[8][2];
#pragma unroll
  for (int m = 0; m < 8; ++m) { acc[m][0] = f32x4{0.f, 0.f, 0.f, 0.f}; acc[m][1] = f32x4{0.f, 0.f, 0.f, 0.f}; acc2[m][0] = f32x4{0.f, 0.f, 0.f, 0.f}; acc2[m][1] = f32x4{0.f, 0.f, 0.f, 0.f}; }
  const bf16x8 sgn = {0, (short)0x8000, 0, (short)0x8000, 0, (short)0x8000, 0, (short)0x8000};
  const int aoff0 = (qd * 128 + fr) * 128, boff0 = (qd * 128 + wq * 32 + fr) * 128, swz = fr >> 1;
  constexpr int NK2 = KP / 64;
#define FCOMP(buf) do { const char* Ab = As + (buf) * 32768; const char* Bb = Bs + (buf) * 32768; \
    _Pragma("unroll") for (int ks = 0; ks < 2; ++ks) { const int co = ((ks * 4 + fq) ^ swz) << 4; \
      const bf16x8 bf0 = *(const bf16x8*)(Bb + boff0 + co), bf1 = *(const bf16x8*)(Bb + boff0 + 2048 + co); \
      const bf16x8 bal0 = bf0 ^ sgn, bal1 = bf1 ^ sgn; \
      _Pragma("unroll") for (int mh = 0; mh < 2; ++mh) { bf16x8 af[4]; \
        _Pragma("unroll") for (int m = 0; m < 4; ++m) af[m] = *(const bf16x8*)(Ab + aoff0 + (mh * 4 + m) * 2048 + co); \
        _Pragma("unroll") for (int m = 0; m < 4; ++m) { acc[mh * 4 + m][0] = MFMA16(af[m], bf0, acc[mh * 4 + m][0]); acc[mh * 4 + m][1] = MFMA16(af[m], bf1, acc[mh * 4 + m][1]); \
          acc2[mh * 4 + m][0] = MFMA16(af[m], bal0, acc2[mh * 4 + m][0]); acc2[mh * 4 + m][1] = MFMA16(af[m], bal1, acc2[mh * 4 + m][1]); } } } } while (0)
  FLOAD(raA, ruaA, rubA, 0); FWRITE(raA, ruaA, rubA, 0);
  __syncthreads();
  for (int k2 = 0; k2 < NK2; ++k2) {
    const int buf = k2 & 1;
    if (k2 + 1 < NK2) FLOAD(raA, ruaA, rubA, k2 + 1);
    FCOMP(buf);
    if (k2 + 1 < NK2) FWRITE(raA, ruaA, rubA, buf ^ 1);
    __syncthreads();
  }
#undef FLOAD
#undef FWRITE
#undef FCOMP
  u16* gy = (u16*)(p.ws + OFF_GY); const u16* gg = (const u16*)(p.ws + OFF_GG);
  const u16* Mb = (const u16*)(p.ws + OFF_MCS) + ((size_t)(li * 4 + g) * 128) * 256;
  const int arow = wid * 16 + fr;
#pragma clang loop unroll(disable)
  for (int pass = 0; pass < 2; ++pass) {
#pragma unroll
    for (int m = 0; m < 8; ++m)
#pragma unroll
      for (int n = 0; n < 2; ++n)
#pragma unroll
        for (int j = 0; j < 4; ++j) {
          const int row = m * 16 + fq * 4 + j, col = qd * 128 + wq * 32 + n * 16 + fr;
          *(u16*)(smem + row * 512 + ((((col >> 3) ^ (row & 15))) << 4) + (col & 7) * 2) = f2bf(acc[m][n][j]);
        }
    __syncthreads();
    f32x4 accP[8], accQ[8];
#pragma unroll
    for (int n = 0; n < 8; ++n) { accP[n] = f32x4{0.f, 0.f, 0.f, 0.f}; accQ[n] = f32x4{0.f, 0.f, 0.f, 0.f}; }
#pragma clang loop unroll(disable)
    for (int ks = 0; ks < 4; ++ks) {
      const bf16x8 a = *(const bf16x8*)(smem + arow * 512 + (((ks * 4 + fq) ^ fr) << 4));
#pragma unroll
      for (int n = 0; n < 8; ++n) {
        const bf16x8 bb = *(const bf16x8*)(Mb + (size_t)(n * 16 + fr) * 256 + ks * 32 + fq * 8);
        accP[n] = MFMA16(a, bb, accP[n]);
      }
    }
#pragma clang loop unroll(disable)
    for (int ks = 4; ks < 8; ++ks) {
      const bf16x8 a = *(const bf16x8*)(smem + arow * 512 + (((ks * 4 + fq) ^ fr) << 4));
#pragma unroll
      for (int n = 0; n < 8; ++n) {
        const bf16x8 bb = *(const bf16x8*)(Mb + (size_t)(n * 16 + fr) * 256 + ks * 32 + fq * 8);
        accQ[n] = MFMA16(a, bb, accQ[n]);
      }
    }
    const float sq = pass ? -1.f : 1.f;
    float* stg = (float*)(smem + 65536 + wid * 8192);
#pragma unroll
    for (int half = 0; half < 2; ++half) {
      const float sh = half ? -sq : sq;
#pragma unroll
      for (int n = 0; n < 8; ++n)
#pragma unroll
        for (int j = 0; j < 4; ++j) stg[(fq * 4 + j) * 128 + n * 16 + fr] = accP[n][j] + sh * accQ[n][j];
      asm volatile("s_waitcnt lgkmcnt(0)" ::: "memory");
#pragma unroll
      for (int it = 0; it < 4; ++it) {
        const int rw = it * 4 + (lane >> 4), c8 = (lane & 15) * 8;
        const int k0 = kt * 128 + wid * 16 + rw;
        const int kk = pass ? LH - k0 : k0;
        bool ok = (k0 <= LH / 2) && !(pass && k0 == LH / 2);
        if (half) ok = ok && (kk >= 1) && (kk < LH);
        const int orow = half ? L - kk : kk;
        const f32x4 a = *(const f32x4*)(stg + rw * 128 + c8), c = *(const f32x4*)(stg + rw * 128 + c8 + 4);
        if (ok) {
          const size_t o1 = ((size_t)(b * L + orow)) * DM + g * 128 + c8;
          const u32x4 gt = *(const u32x4*)(gg + o1);
          u32x4 w;
          w[0] = cvtpk(a[0] * __uint_as_float(gt[0] << 16), a[1] * __uint_as_float(gt[0] & 0xffff0000u));
          w[1] = cvtpk(a[2] * __uint_as_float(gt[1] << 16), a[3] * __uint_as_float(gt[1] & 0xffff0000u));
          w[2] = cvtpk(c[0] * __uint_as_float(gt[2] << 16), c[1] * __uint_as_float(gt[2] & 0xffff0000u));
          w[3] = cvtpk(c[2] * __uint_as_float(gt[3] << 16), c[3] * __uint_as_float(gt[3] & 0xffff0000u));
          *(u32x4*)(gy + o1) = w;
        }
      }
      asm volatile("s_waitcnt lgkmcnt(0)" ::: "memory");
    }
    __syncthreads();
#pragma unroll
    for (int m = 0; m < 8; ++m) { acc[m][0] = acc2[m][0]; acc[m][1] = acc2[m][1]; }
  }
}

constexpr int N_ATT = NB * NH * 33;
constexpr int N_FOU = NB * 4 * 9;
#ifndef REPA
#define REPA 1
#endif
#ifndef REPB
#define REPB 1
#endif
#ifndef REPB_MODE
#define REPB_MODE 0
#endif
DI void phaseB(const P2& p, int li, char* smem, int rep) {
  int* qb_ = (int*)(p.ws + OFF_Q) + (li * 2 + rep) * 256;
  unsigned* bdone = (unsigned*)(p.ws + OFF_Q) + (li * 2) * 256 + 128;
  int* s_item = (int*)(smem + 131072);
  unsigned* sig1 = (unsigned*)(p.ws + OFF_CNT) + 40 + 2 * li + 1;
  const int myx = (int)(__builtin_amdgcn_s_getreg((3 << 11) | 20) & 7u);
  int d = 0;
  for (;;) {
    if (threadIdx.x == 0) {
      int dd = d, idx = -1, xq = 0;
      while (dd < 8) {
        xq = (myx + dd) & 7;
        idx = atomicAdd(qb_ + xq * 16, 1);
        if (idx < 168) break;
        idx = -1; ++dd;
      }
      s_item[0] = idx; s_item[1] = xq; s_item[3] = dd;
    }
    __syncthreads();
    const int idx = __builtin_amdgcn_readfirstlane(s_item[0]), xq = __builtin_amdgcn_readfirstlane(s_item[1]);
    d = __builtin_amdgcn_readfirstlane(s_item[3]);
    __syncthreads();
    if (idx < 0) break;
    const int grp = idx / 42, r = idx - grp * 42;
    int isf, sub;
    if (grp < 3) { const int f0 = (r * 9) / 42, f1 = ((r + 1) * 9) / 42; isf = f1 > f0; sub = isf ? f0 : r - f0; }
    else { isf = r >= 33; sub = isf ? r - 33 : r; }
    const int pair = xq + 8 * grp, bat = pair >> 2;
    if (bat == NB - 1) wait_sig(sig1, 96u);
    if (!isf) attn_tile(p, li, pair * 33 + sub, smem);
    else fourier_tile(p, li, bat * 36 + (pair & 3) * 9 + sub, smem);
  }
}

__global__ void __launch_bounds__(512) mega(Params p, int ph_begin, int ph_end) {
  __shared__ __attribute__((aligned(16))) char smem[131072 + 64 + 1024];
  if (ph_begin == 0) {
    phase0(p, smem);
    if (ph_end > 1) cg::this_grid().sync();
  }
  P2 q; q.out = p.out; q.ws = p.ws; q.x = p.x; q.meta = p.meta;
  unsigned nbar = 0;
#pragma clang loop unroll(disable)
  for (int ph = (ph_begin < 1 ? 1 : ph_begin); ph < ph_end; ++ph) {
    const int li = (ph - 1) / 3, s = (ph - 1) % 3;
    unsigned* sig0 = (unsigned*)(q.ws + OFF_CNT) + 40 + 2 * li;
    unsigned* sig1 = sig0 + 1;
    const int bx = blockIdx.x;
    { int mode = -1, lc = li;
      if (s == 2) mode = 0; else if (s == 1 && li > 0 && bx < 4) { mode = 1; lc = li - 1; }
      if (mode >= 0) phaseC(q, lc, smem, mode, bx, sig0); }
    { int mode = -1;
      if (s == 0) mode = 0; else if (s == 1 && bx >= 4 && bx < 16) { mode = 1; wait_sig(sig0, li > 0 ? 32u : 0u); }
      if (mode >= 0) phaseA(q, li, smem, mode, bx - 4, sig1); }
    if (s == 1) { for (int rep = 0; rep < REPB; ++rep) phaseB(q, li, smem, rep); }
    if (ph + 1 < ph_end) { ++nbar; grid_barrier((unsigned*)(q.ws + OFF_CNT) + 32, nbar * gridDim.x); }
  }
}

extern "C" void kernel_launch(void* const* d_in, const int* in_sizes, int n_in, void* d_out, int out_size, void* d_ws, size_t ws_size, hipStream_t stream) {
  if (ws_size < WS_END) { fprintf(stderr, "workspace too small: %zu < %zu\n", ws_size, (size_t)WS_END); return; }
  Params p{};
  p.x = (const float*)d_in[0]; p.meta = (const float*)d_in[1]; p.norm_gain = (const float*)d_in[2]; p.w_in = (const float*)d_in[3];
  p.w_f = (const float*)d_in[4]; p.qg = (const float*)d_in[5]; p.kg = (const float*)d_in[6]; p.lq1 = (const float*)d_in[7];
  p.lk1 = (const float*)d_in[8]; p.lq2 = (const float*)d_in[9]; p.lk2 = (const float*)d_in[10]; p.subln = (const float*)d_in[11];
  p.w_out = (const float*)d_in[12]; p.out = (float*)d_out; p.ws = (char*)d_ws;
  constexpr int NPH = 1 + 3 * DEPTH;
#if MULTI_LAUNCH
  for (int ph = 0; ph < NPH; ++ph) hipLaunchKernelGGL(mega, dim3(256), dim3(512), 0, stream, p, ph, ph + 1);
#else
  static int grid_blocks = 0;
  if (!grid_blocks) {
    int dev = 0, cus = 0, per_cu = 0;
    hipGetDevice(&dev);
    hipDeviceGetAttribute(&cus, hipDeviceAttributeMultiprocessorCount, dev);
    hipOccupancyMaxActiveBlocksPerMultiprocessor(&per_cu, mega, 512, 0);
    if (per_cu < 1) per_cu = 1;
    grid_blocks = cus * 1;
  }
  int b0 = 0, b1 = NPH;
  void* args[] = {&p, &b0, &b1};
  hipError_t e = hipLaunchCooperativeKernel((void*)mega, dim3(grid_blocks), dim3(512), args, 0, stream);
  if (e != hipSuccess) fprintf(stderr, "cooperative launch failed: %s (grid %d)\n", hipGetErrorString(e), grid_blocks);
#endif
}
```

```cpp
#include <hip/hip_runtime.h>
#include <hip/hip_bf16.h>
#include <hip/hip_cooperative_groups.h>
#include <cstdio>
#include <cstdint>
namespace cg = cooperative_groups;

#ifndef MULTI_LAUNCH
#define MULTI_LAUNCH 0
#endif

typedef unsigned short u16;
using bf16x8 = __attribute__((ext_vector_type(8))) short;
using s16x4  = __attribute__((ext_vector_type(4))) short;
using f32x4  = __attribute__((ext_vector_type(4))) float;
using f32x16 = __attribute__((ext_vector_type(16))) float;
using u32x4  = __attribute__((ext_vector_type(4))) unsigned;
using u32x2  = __attribute__((ext_vector_type(2))) unsigned;

constexpr int NB = 8, SEQ = 4096, NMETA = 16, L = 4112, DM = 1024, DEPTH = 4;
constexpr int R = NB * L;
constexpr int RP = 33024;
constexpr int INW = 3072;
constexpr int NH = 4;
constexpr int LP = 4224;
constexpr int LH = 2056;
constexpr int KROWS = 2176;
constexpr int KP = 2112;
constexpr int NKT = 65;
constexpr float EPS = 1e-6f;

constexpr size_t al256(size_t x) { return (x + 255) / 256 * 256; }
constexpr size_t OFF_META = 0;
constexpr size_t OFF_XB   = al256(OFF_META + (size_t)NB * NMETA * DM * 4);
constexpr size_t OFF_GY   = al256(OFF_XB + (size_t)RP * DM * 2);
constexpr size_t OFF_QN   = al256(OFF_GY + (size_t)RP * DM * 2);
constexpr size_t QKV_BYTES = (size_t)NB * NH * LP * 128 * 2;
constexpr size_t OFF_KN   = al256(OFF_QN + QKV_BYTES);
constexpr size_t OFF_VN   = al256(OFF_KN + QKV_BYTES);
constexpr size_t OFF_WIN  = al256(OFF_VN + QKV_BYTES);
constexpr size_t OFF_WOUT = al256(OFF_WIN + (size_t)DEPTH * INW * DM * 2);
constexpr size_t OFF_CM   = al256(OFF_WOUT + (size_t)DEPTH * DM * DM * 2);
constexpr size_t OFF_SM   = al256(OFF_CM + (size_t)KROWS * KP * 2);
constexpr size_t OFF_MCS  = al256(OFF_SM + (size_t)KROWS * KP * 2);
constexpr size_t OFF_UTA  = al256(OFF_MCS + (size_t)DEPTH * 4 * 128 * 256 * 2);
constexpr size_t OFF_UTB  = al256(OFF_UTA + (size_t)NB * 512 * KP * 2);
constexpr size_t OFF_RSS  = al256(OFF_UTB + (size_t)NB * 512 * KP * 2);
constexpr size_t OFF_ROPE = al256(OFF_RSS + (size_t)RP * 16 * 4);
constexpr size_t OFF_CST  = al256(OFF_ROPE + (size_t)L * 16 * 4);
constexpr size_t OFF_SMALL = al256(OFF_CST + 256);
constexpr size_t OFF_CNT  = al256(OFF_SMALL + 4096);
constexpr size_t OFF_GG   = al256(OFF_CNT + 256);
constexpr size_t OFF_Q    = al256(OFF_GG + (size_t)RP * DM * 2);
constexpr size_t WS_END   = OFF_Q + 4 * 2 * 16 * 16 * 4;

struct Params {
  const float *x, *meta, *norm_gain, *w_in, *w_f, *qg, *kg, *lq1, *lk1, *lq2, *lk2, *subln, *w_out;
  float* out;
  char* ws;
};

struct P2 { float* out; char* ws; const float* x; const float* meta; };
__device__ __forceinline__ void grid_barrier(unsigned* bar, unsigned target) {
  asm volatile("s_waitcnt vmcnt(0) lgkmcnt(0)" ::: "memory");
  __syncthreads();
  if (threadIdx.x == 0) {
    __builtin_amdgcn_fence(__ATOMIC_RELEASE, "agent");
    asm volatile("s_waitcnt vmcnt(0)" ::: "memory");
    __hip_atomic_fetch_add(bar, 1u, __ATOMIC_RELAXED, __HIP_MEMORY_SCOPE_AGENT);
    while (__hip_atomic_load(bar, __ATOMIC_RELAXED, __HIP_MEMORY_SCOPE_AGENT) < target) __builtin_amdgcn_s_sleep(2);
    __builtin_amdgcn_fence(__ATOMIC_ACQUIRE, "agent");
    asm volatile("s_waitcnt vmcnt(0)" ::: "memory");
  }
  __syncthreads();
}
#define DI __device__ __forceinline__
#define MFMA16(a, b, c) __builtin_amdgcn_mfma_f32_16x16x32_bf16((a), (b), (c), 0, 0, 0)
#define MFMA32(a, b, c) __builtin_amdgcn_mfma_f32_32x32x16_bf16((a), (b), (c), 0, 0, 0)

using bf16v2 = __attribute__((ext_vector_type(2))) __bf16;
DI void wait_sig(unsigned* sig, unsigned target) {
  if (threadIdx.x == 0) {
    while (__hip_atomic_load(sig, __ATOMIC_RELAXED, __HIP_MEMORY_SCOPE_AGENT) < target) __builtin_amdgcn_s_sleep(2);
    __builtin_amdgcn_fence(__ATOMIC_ACQUIRE, "agent");
    asm volatile("s_waitcnt vmcnt(0)" ::: "memory");
  }
  __syncthreads();
}
DI unsigned cvtpk(float lo, float hi) { bf16v2 v; v[0] = (__bf16)lo; v[1] = (__bf16)hi; return __builtin_bit_cast(unsigned, v); }
DI u16 f2bf(float x) { return (u16)(cvtpk(x, x) & 0xffffu); }
DI float bf2f(u16 v) { return __uint_as_float(((unsigned)v) << 16); }
DI float wave_sum(float v) { for (int o = 32; o; o >>= 1) v += __shfl_xor(v, o); return v; }
DI float wave_max(float v) { for (int o = 32; o; o >>= 1) v = fmaxf(v, __shfl_xor(v, o)); return v; }
DI float addf(float a, float b) { float r; asm volatile("v_add_f32 %0, %1, %2" : "=v"(r) : "v"(a), "v"(b)); return r; }
DI int crow(int r, int hi) { return (r & 3) + 8 * (r >> 2) + 4 * hi; }

DI float* hres_row(const Params& p, int row) {
  const int b = row / L, l = row - b * L;
  return l < NMETA ? (float*)(p.ws + OFF_META) + (size_t)(b * NMETA + l) * DM
                   : p.out + ((size_t)b * SEQ + (l - NMETA)) * DM;
}

DI void row_bl(int row, int b0, int& b, int& l) { b = b0 + ((row >= (b0 + 1) * L) ? 1 : 0); l = row - b * L; }
#define CBAR() asm volatile("" ::: "memory")
DI int opaque_tid() { int t = threadIdx.x; asm volatile("" : "+v"(t)); return t; }

__device__ const double INVF[8] = {1.0, 0.19392274474868576, 0.03760603093086393, 0.007292664737217109, 0.001414213562373095, 0.0002742481756762073, 5.318295896944988e-05, 1.031338537721246e-05};

DI void phase0(const Params& p, char* smem) {
  const int tid = threadIdx.x, gtid = blockIdx.x * 512 + tid, gsz = gridDim.x * 512;
  const int lane = tid & 63, gw = gtid >> 6, nw = gsz >> 6;
  u16* xb = (u16*)(p.ws + OFF_XB);
  float* rss = (float*)(p.ws + OFF_RSS);
  for (int row = gw; row < RP; row += nw) {
    if (row < R) {
      const int b = row / L, l = row - b * L;
      const float* src = l < NMETA ? p.meta + (size_t)l * DM : p.x + ((size_t)b * SEQ + (l - NMETA)) * DM;
      float ss = 0.f;
#pragma unroll
      for (int i = 0; i < 4; ++i) {
        const f32x4 v = *(const f32x4*)(src + i * 256 + lane * 4);
        ss += v[0] * v[0] + v[1] * v[1] + v[2] * v[2] + v[3] * v[3];
        u32x2 o = {cvtpk(v[0], v[1]), cvtpk(v[2], v[3])};
        *(u32x2*)(xb + (size_t)row * DM + i * 256 + lane * 4) = o;
      }
      ss = wave_sum(ss);
      if (lane == 0) rss[(size_t)row * 16] = ss;
    } else {
#pragma unroll
      for (int i = 0; i < 4; ++i) { u32x2 o = {0u, 0u}; *(u32x2*)(xb + (size_t)row * DM + i * 256 + lane * 4) = o; }
      if (lane == 0) rss[(size_t)row * 16] = 1024.f;
    }
    if (lane >= 1 && lane < 16) rss[(size_t)row * 16 + lane] = 0.f;
  }
  {
    u16* WinT = (u16*)(p.ws + OFF_WIN);
    for (long it = gtid; it < (long)DEPTH * 128 * INW; it += gsz) {
      const int nd = (int)(it % INW); const long t2 = it / INW; const int kc = (int)(t2 % 128), li = (int)(t2 / 128);
      const int c1 = nd & 255;
      const int n = (nd & ~255) + ((c1 >> 5) & 3) * 64 + (c1 >> 7) * 32 + (c1 & 31);
      const float* w = p.w_in + ((size_t)li * DM + kc * 8) * INW + n;
      const float* g = p.norm_gain + li * DM + kc * 8;
      float v[8];
#pragma unroll
      for (int j = 0; j < 8; ++j) v[j] = w[(size_t)j * INW] * g[j];
      u32x4 o = {cvtpk(v[0], v[1]), cvtpk(v[2], v[3]), cvtpk(v[4], v[5]), cvtpk(v[6], v[7])};
      *(u32x4*)(WinT + ((size_t)li * INW + nd) * DM + kc * 8) = o;
    }
  }
  {
    u16* WoutT = (u16*)(p.ws + OFF_WOUT);
    for (long it = gtid; it < (long)DEPTH * 128 * DM; it += gsz) {
      const int n = (int)(it % DM); const long t2 = it / DM; const int kc = (int)(t2 % 128), li = (int)(t2 / 128);
      const float* w = p.w_out + ((size_t)li * DM + kc * 8) * DM + n;
      float v[8];
#pragma unroll
      for (int j = 0; j < 8; ++j) v[j] = w[(size_t)j * DM];
      u32x4 o = {cvtpk(v[0], v[1]), cvtpk(v[2], v[3]), cvtpk(v[4], v[5]), cvtpk(v[6], v[7])};
      *(u32x4*)(WoutT + ((size_t)li * DM + n) * DM + kc * 8) = o;
    }
  }
  {
    u16* Cm = (u16*)(p.ws + OFF_CM); u16* Sm = (u16*)(p.ws + OFF_SM);
    for (int it = gtid; it < KROWS * (KP / 8); it += gsz) {
      const int k = it / (KP / 8), j0 = (it % (KP / 8)) * 8;
      float c[8], s[8];
#pragma unroll
      for (int jj = 0; jj < 8; ++jj) {
        const int j = j0 + jj;
        const bool valid = (k <= LH) && (j <= LH);
        const int m = valid ? (k * j) % L : 0;
        const float rev = (float)m / (float)L;
        c[jj] = valid ? __builtin_amdgcn_cosf(rev) : 0.f;
        s[jj] = valid ? __builtin_amdgcn_sinf(rev) : 0.f;
      }
      u32x4 oc = {cvtpk(c[0], c[1]), cvtpk(c[2], c[3]), cvtpk(c[4], c[5]), cvtpk(c[6], c[7])};
      u32x4 os = {cvtpk(s[0], s[1]), cvtpk(s[2], s[3]), cvtpk(s[4], s[5]), cvtpk(s[6], s[7])};
      *(u32x4*)(Cm + (size_t)k * KP + j0) = oc;
      *(u32x4*)(Sm + (size_t)k * KP + j0) = os;
    }
  }
  {
    u16* Mcs = (u16*)(p.ws + OFF_MCS);
    const float norm = 1.0f / sqrtf((float)L * 128.f);
    float* Wl = (float*)smem;
    float* tcs = (float*)(smem + 65536);
    float* tsn = tcs + 128;
    for (int u = blockIdx.x; u < DEPTH * 4 * 16; u += gridDim.x) {
      const int lg = u >> 4, ccb = u & 15;
      const float* wf = p.w_f + (size_t)lg * 128 * 128;
#pragma unroll
      for (int i = 0; i < 8; ++i) *(f32x4*)(Wl + (tid + 512 * i) * 4) = *(const f32x4*)(wf + (tid + 512 * i) * 4);
      if (tid < 128) { const float rev = (float)tid * (1.0f / 128.f); tcs[tid] = __builtin_amdgcn_cosf(rev); tsn[tid] = __builtin_amdgcn_sinf(rev); }
      __syncthreads();
      const int e = tid & 127, cc0 = ccb * 16 + (tid >> 7) * 4;
      const bool isS = ccb >= 8;
      const float* tab = isS ? tsn : tcs;
      const int c0 = cc0 & 127;
      float a0 = 0.f, a1 = 0.f, a2 = 0.f, a3 = 0.f;
      for (int m = 0; m < 128; ++m) {
        const float w = Wl[m * 128 + e];
        a0 += tab[(m * c0) & 127] * w; a1 += tab[(m * (c0 + 1)) & 127] * w; a2 += tab[(m * (c0 + 2)) & 127] * w; a3 += tab[(m * (c0 + 3)) & 127] * w;
      }
      const float sn = isS ? -norm : norm;
      u32x2 o = {cvtpk(a0 * sn, a1 * sn), cvtpk(a2 * sn, a3 * sn)};
      *(u32x2*)(Mcs + ((size_t)lg * 128 + e) * 256 + cc0) = o;
      __syncthreads();
    }
  }
  {
    u16* uta = (u16*)(p.ws + OFF_UTA); u16* utb = (u16*)(p.ws + OFF_UTB);
    for (int it = gtid; it < NB * 512 * 64; it += gsz) {
      const int row = it >> 6, i = it & 63;
      if (i < 55) { uta[(size_t)row * KP + 2057 + i] = 0; utb[(size_t)row * KP + 2057 + i] = 0; }
      else if (i == 55) utb[(size_t)row * KP] = 0;
      else if (i == 56) utb[(size_t)row * KP + LH] = 0;
    }
  }
  {
    u16* qn = (u16*)(p.ws + OFF_QN); u16* kn = (u16*)(p.ws + OFF_KN); u16* vt = (u16*)(p.ws + OFF_VN);
    for (int it = gtid; it < NB * NH * (LP - L) * 16; it += gsz) {
      const int ch = it & 15, rr = (it >> 4) % (LP - L), bh = (it >> 4) / (LP - L);
      const size_t off = ((size_t)bh * LP + L + rr) * 128 + ch * 8;
      u32x4 z = {0u, 0u, 0u, 0u};
      *(u32x4*)(qn + off) = z; *(u32x4*)(kn + off) = z;
    }
    for (int it = gtid; it < NB * NH * 128 * ((LP - L) / 8); it += gsz) {
      const int ch = it % ((LP - L) / 8), row = it / ((LP - L) / 8);
      u32x4 z = {0u, 0u, 0u, 0u};
      *(u32x4*)(vt + (size_t)row * LP + L + ch * 8) = z;
    }
  }
  {
    float* rope = (float*)(p.ws + OFF_ROPE);
    for (int it = gtid; it < L * 8; it += gsz) {
      const int l = it >> 3, i = it & 7;
      double rv = (double)l * INVF[i] * 0.15915494309189535;
      rv -= floor(rv);
      const float r = (float)rv;
      rope[l * 16 + i] = __builtin_amdgcn_cosf(r);
      rope[l * 16 + 8 + i] = __builtin_amdgcn_sinf(r);
    }
  }
  if (blockIdx.x == 0) {
    const int wid = tid >> 6;
    if (wid < DEPTH) {
      const int li = wid;
      float a = p.lq1[li * 64 + lane] * p.lk1[li * 64 + lane];
      float bq = p.lq2[li * 64 + lane] * p.lk2[li * 64 + lane];
      a = wave_sum(a); bq = wave_sum(bq);
      const float gq = wave_max(fabsf(p.qg[li * 64 + lane]));
      const float gk = wave_max(fabsf(p.kg[li * 64 + lane]));
      if (lane == 0) {
        float* cst = (float*)(p.ws + OFF_CST) + li * 8;
        const float lam_init = 0.8f - 0.6f * expf(-0.3f * (float)li);
        cst[0] = expf(a) - expf(bq) + lam_init;
        cst[1] = 1.0f - lam_init;
        cst[2] = (8.0f * gq * gk * 1.01f + 0.05f) * 1.4426950408889634f;
      }
    }
    if (tid < 64) ((int*)(p.ws + OFF_CNT))[tid] = 0;
    for (int i = tid; i < 4 * 2 * 16 * 16; i += 512) ((int*)(p.ws + OFF_Q))[i] = 0;
    float* sm = (float*)(p.ws + OFF_SMALL);
    if (tid < 256) { sm[tid] = p.qg[tid]; sm[256 + tid] = p.kg[tid]; }
    sm[512 + tid] = p.subln[tid];
  }
}

namespace pg8 {
#define PG8_LAS __attribute__((address_space(3)))
constexpr int BM = 256, BK = 64, HALF = 128, HTB = HALF * BK * 2, NXCD = 8, WGM = 8;
DI int lds_byte(int r, int c) { const int st = (r >> 4) * 2 + (c >> 5), rr = r & 15, cc = c & 31, ob = rr * 64 + cc * 2; return st * 1024 + (ob ^ (((ob >> 9) & 1) << 5)); }
DI void stage_rc(int b, int& R, int& C) { const int st = b / 1024, sb = b % 1024, swz = sb ^ (((sb >> 9) & 1) << 5); R = (st >> 1) * 16 + swz / 64; C = (st & 1) * 32 + (swz % 64) / 2; }
DI int perm32(int rho) { const int n = rho >> 4, i = rho & 15; return 8 * (i >> 2) + 4 * n + (i & 3); }
struct Unit { int pm, pn; };
struct Gemm { const u16* A; const u16* Bt; int M, N, K; };
struct StaticOrder {
  int nM, nN, nwg, G, c;
  DI void init(int M, int N, int G_, int c_) { nM = M / BM; nN = N / BM; nwg = nM * nN; G = G_; c = c_; }
  DI bool next(int i, Unit& u) const {
    const long Lx = (long)i * G + c; if (Lx >= nwg) return false;
    int wgid = (int)Lx; { const int q = nwg / NXCD, r = nwg % NXCD, xcd = wgid % NXCD, off = wgid / NXCD; wgid = (xcd < r ? xcd * (q + 1) : r * (q + 1) + (xcd - r) * q) + off; }
    const int nig = WGM * nN, gid = wgid / nig, fm = gid * WGM, gsz = (nM - fm) < WGM ? (nM - fm) : WGM;
    u.pm = fm + ((wgid % nig) % gsz); u.pn = (wgid % nig) / gsz; return true;
  }
  DI void done(int) const {}
};
struct Order {
  int mode; StaticOrder st; int pm, pn; unsigned* sig;
  const unsigned* bready;
  DI void a_ready(const Unit& u) const {
    if (bready == nullptr) return;
    if (threadIdx.x < 64) {
      const int b1 = (u.pm * 256) / L; int b2 = (u.pm * 256 + 255) / L; if (b2 > NB - 1) b2 = NB - 1;
      while ((unsigned)__builtin_amdgcn_readfirstlane(__hip_atomic_load(bready + b1 * 16, __ATOMIC_RELAXED, __HIP_MEMORY_SCOPE_AGENT)) < 200u ||
             (unsigned)__builtin_amdgcn_readfirstlane(__hip_atomic_load(bready + b2 * 16, __ATOMIC_RELAXED, __HIP_MEMORY_SCOPE_AGENT)) < 200u) __builtin_amdgcn_s_sleep(2);
      __builtin_amdgcn_fence(__ATOMIC_ACQUIRE, "agent");
      asm volatile("s_waitcnt vmcnt(0)" ::: "memory");
    }
    asm volatile("" ::: "memory"); __builtin_amdgcn_s_barrier(); asm volatile("" ::: "memory");
  }
  DI bool next(int i, Unit& u) const { if (mode == 0) return st.next(i, u); if (i != 0) return false; u.pm = pm; u.pn = pn; return true; }
  DI void done(int lane) const {
    if (mode == 1) {
      asm volatile("s_waitcnt vmcnt(0)" ::: "memory");
      __builtin_amdgcn_fence(__ATOMIC_RELEASE, "agent");
      asm volatile("s_waitcnt vmcnt(0)" ::: "memory");
      if (lane == 0) __hip_atomic_fetch_add(sig, 1u, __ATOMIC_RELAXED, __HIP_MEMORY_SCOPE_AGENT);
    }
  }
};
template <class Epi, class Sched>
DI void gemm_phase(PG8_LAS unsigned char* lds, const Gemm g, const Sched& S, const Epi& E) {
  const int tid = opaque_tid(), wid = __builtin_amdgcn_readfirstlane(tid >> 6), lane = tid & 63, wr = wid >> 2, wc = wid & 3, fr = lane & 15, fq = lane >> 4;
  const int K = g.K, nt = K / BK;
  unsigned voffA[2], voffB[2];
#pragma unroll
  for (int i = 0; i < 2; ++i) { int R_, C_; stage_rc(tid * 16 + i * 8192, R_, C_); const int Rb = (R_ & ~31) + perm32(R_ & 31);
    voffA[i] = (unsigned)(R_ * K + C_) * 2u; voffB[i] = (unsigned)(Rb * K + C_) * 2u; }
  const size_t kstep = (size_t)(BK * 2);
  const size_t hstep = (size_t)HALF * K * 2;
  const size_t tstep = 2 * hstep;
  const unsigned ldsw = (unsigned)wid * 1024u;
  const int aoff = lds_byte(wr * 64 + fr, fq * 8), boff = lds_byte(wc * 32 + fr, fq * 8);
#define PG8_SA(b, h) (((b) * 2 + (h)) * HTB)
#define PG8_SB(b, h) ((4 + (b) * 2 + (h)) * HTB)
#define PG8_STAGE(bufoff, gbase, voff) do { _Pragma("unroll") for (int _i = 0; _i < 2; ++_i) \
    __builtin_amdgcn_global_load_lds((const unsigned*)((const char*)(gbase) + (voff)[_i]), (PG8_LAS unsigned*)(lds + (bufoff) + ldsw + _i * 8192), 16, 0, 0); } while (0)
#define PG8_LDA(dst, b, h) do { _Pragma("unroll") for (int m = 0; m < 4; ++m) _Pragma("unroll") for (int k = 0; k < 2; ++k) dst[m][k] = *(const PG8_LAS bf16x8*)(lds + PG8_SA(b, h) + aoff + m * 2048 + k * 1024); } while (0)
#define PG8_LDB(dst, b, h) do { _Pragma("unroll") for (int n = 0; n < 2; ++n) _Pragma("unroll") for (int k = 0; k < 2; ++k) dst[n][k] = *(const PG8_LAS bf16x8*)(lds + PG8_SB(b, h) + boff + n * 2048 + k * 1024); } while (0)
#define PG8_MMA(ai, bj, At, Bt) do { __builtin_amdgcn_s_setprio(1); _Pragma("unroll") for (int m = 0; m < 4; ++m) _Pragma("unroll") for (int n = 0; n < 2; ++n) _Pragma("unroll") for (int k = 0; k < 2; ++k) \
    acc[ai][bj][m][n] = __builtin_amdgcn_mfma_f32_16x16x32_bf16(Bt[n][k], At[m][k], acc[ai][bj][m][n], 0, 0, 0); __builtin_amdgcn_s_setprio(0); } while (0)
#define PG8_WAIT_V(n) asm volatile("s_waitcnt vmcnt(" #n ")" ::: "memory")
#define PG8_WAIT_L(n) asm volatile("s_waitcnt lgkmcnt(" #n ")" ::: "memory")
#define PG8_BAR __builtin_amdgcn_s_barrier()
#define PG8_SCHED __builtin_amdgcn_sched_barrier(0)
  Unit cur, nxt; int ui = 0;
  if (!S.next(0, cur)) return;
  f32x4 acc[2][2][4][2];
#pragma unroll
  for (int a = 0; a < 2; ++a)
#pragma unroll
    for (int b = 0; b < 2; ++b)
#pragma unroll
      for (int m = 0; m < 4; ++m)
#pragma unroll
        for (int n = 0; n < 2; ++n) acc[a][b][m][n] = (f32x4){0.f, 0.f, 0.f, 0.f};
  bf16x8 At[4][2], B0[2][2], B1[2][2];
  const char* cA = (const char*)g.A + (size_t)cur.pm * tstep; const char* cB = (const char*)g.Bt + (size_t)cur.pn * tstep;
  S.a_ready(cur);
  PG8_STAGE(PG8_SB(0, 0), cB, voffB); PG8_STAGE(PG8_SA(0, 0), cA, voffA); PG8_STAGE(PG8_SB(0, 1), cB + hstep, voffB); PG8_STAGE(PG8_SA(0, 1), cA + hstep, voffA);
  if (wr == 1) PG8_BAR;
  PG8_WAIT_V(4); PG8_BAR;
  PG8_STAGE(PG8_SB(1, 0), cB + kstep, voffB); PG8_STAGE(PG8_SA(1, 0), cA + kstep, voffA); PG8_STAGE(PG8_SB(1, 1), cB + hstep + kstep, voffB);
  PG8_WAIT_V(6); PG8_BAR;
  for (;;) {
    const bool has_next = S.next(ui + 1, nxt);
    const char* nA = has_next ? (const char*)g.A + (size_t)nxt.pm * tstep : cA; const char* nB = has_next ? (const char*)g.Bt + (size_t)nxt.pn * tstep : cB;
    for (int t = 0; t < nt; t += 2) {
      const bool last = (t == nt - 2);
      const char* a1 = cA + (size_t)(t + 1) * kstep;
      const char* a2 = last ? nA : cA + (size_t)(t + 2) * kstep; const char* b2 = last ? nB : cB + (size_t)(t + 2) * kstep;
      const char* a3 = a2 + kstep; const char* b3 = b2 + kstep;
      if (last && has_next) S.a_ready(nxt);
      PG8_LDB(B0, 0, 0); PG8_SCHED; PG8_LDA(At, 0, 0); PG8_STAGE(PG8_SA(1, 1), a1 + hstep, voffA);
      PG8_WAIT_L(8); PG8_BAR; PG8_WAIT_L(0); PG8_MMA(0, 0, At, B0); PG8_BAR; PG8_SCHED;
      PG8_LDB(B1, 0, 1); PG8_STAGE(PG8_SB(0, 0), b2, voffB);
      PG8_BAR; PG8_WAIT_L(0); PG8_MMA(0, 1, At, B1); PG8_BAR;
      PG8_LDA(At, 0, 1); PG8_STAGE(PG8_SA(0, 0), a2, voffA);
      PG8_BAR; PG8_WAIT_L(0); PG8_MMA(1, 0, At, B0); PG8_BAR; PG8_SCHED;
      PG8_STAGE(PG8_SB(0, 1), b2 + hstep, voffB);
      PG8_WAIT_V(6); PG8_BAR; PG8_MMA(1, 1, At, B1); PG8_BAR;
      PG8_LDB(B0, 1, 0); PG8_SCHED; PG8_LDA(At, 1, 0); PG8_STAGE(PG8_SA(0, 1), a2 + hstep, voffA);
      PG8_WAIT_L(8); PG8_BAR; PG8_WAIT_L(0); PG8_MMA(0, 0, At, B0); PG8_BAR; PG8_SCHED;
      PG8_LDB(B1, 1, 1); PG8_STAGE(PG8_SB(1, 0), b3, voffB);
      PG8_BAR; PG8_WAIT_L(0); PG8_MMA(0, 1, At, B1); PG8_BAR;
      PG8_LDA(At, 1, 1); PG8_STAGE(PG8_SA(1, 0), a3, voffA);
      PG8_BAR; PG8_WAIT_L(0); PG8_MMA(1, 0, At, B0); PG8_BAR; PG8_SCHED;
      PG8_STAGE(PG8_SB(1, 1), b3 + hstep, voffB);
      PG8_WAIT_V(6); PG8_BAR; PG8_MMA(1, 1, At, B1); PG8_BAR;
    }
    E(acc, cur, wr, wc, fr, fq);
    S.done(lane);
    if (!has_next) break;
#pragma unroll
    for (int a = 0; a < 2; ++a)
#pragma unroll
      for (int b = 0; b < 2; ++b)
#pragma unroll
        for (int m = 0; m < 4; ++m)
#pragma unroll
          for (int n = 0; n < 2; ++n) acc[a][b][m][n] = (f32x4){0.f, 0.f, 0.f, 0.f};
    cur = nxt; cA = nA; cB = nB; ++ui;
  }
  PG8_WAIT_V(0);
  if (wr == 0) PG8_BAR;
  PG8_BAR;
#undef PG8_SA
#undef PG8_SB
#undef PG8_STAGE
#undef PG8_LDA
#undef PG8_LDB
#undef PG8_MMA
#undef PG8_WAIT_V
#undef PG8_WAIT_L
#undef PG8_BAR
#undef PG8_SCHED
}
}

DI float row_scale(const float* rsp, int row) {
  const f32x4* rp = (const f32x4*)(rsp + (size_t)row * 16);
  const f32x4 a0 = rp[0], a1 = rp[1], a2 = rp[2], a3 = rp[3];
  const float s = ((a0[0] + a0[1]) + (a0[2] + a0[3])) + ((a1[0] + a1[1]) + (a1[2] + a1[3])) + ((a2[0] + a2[1]) + (a2[2] + a2[3])) + ((a3[0] + a3[1]) + (a3[2] + a3[3]));
  return rsqrtf(s * (1.0f / DM) + EPS);
}

struct EpiA {
  char* ws; int li;
  DI void operator()(const f32x4 (&acc)[2][2][4][2], const pg8::Unit& u, int wr, int wc, int fr, int fq) const {
    const int mt = u.pm, nt = u.pn;
    const float* rsp = (const float*)(ws + OFF_RSS);
    const int b0 = (mt * 256) / L;
    const int rbase = mt * 256 + wr * 64 + fr;
    float scv[2][4];
    {
      const int lane_ = fq * 16 + fr, r0_ = mt * 256 + wr * 64 + lane_;
      const float so0 = row_scale(rsp, r0_ < R ? r0_ : 0), so1 = row_scale(rsp, r0_ + 128 < R ? r0_ + 128 : 0);
#pragma unroll
      for (int m = 0; m < 4; ++m) { scv[0][m] = __shfl(so0, m * 16 + fr); scv[1][m] = __shfl(so1, m * 16 + fr); }
    }
    if (nt < 2) {
      u16* uta = (u16*)(ws + OFF_UTA); u16* utb = (u16*)(ws + OFF_UTB);
      const int chb = nt * 256 + wc * 64 + 8 * fq;
#pragma unroll
      for (int ai = 0; ai < 2; ++ai)
#pragma unroll
        for (int m = 0; m < 4; ++m) {
          const int row = rbase + ai * 128 + m * 16;
          if (row < R) {
            int b, l; row_bl(row, b0, b, l);
            const float sc = scv[ai][m];
            u16* dst = (l <= LH) ? uta + (size_t)b * 512 * KP + l : utb + (size_t)b * 512 * KP + (L - l);
#pragma unroll
            for (int bj = 0; bj < 2; ++bj)
#pragma unroll
              for (int n = 0; n < 2; ++n)
#pragma unroll
                for (int j = 0; j < 4; ++j) dst[(size_t)(chb + bj * 32 + n * 4 + j) * KP] = f2bf(acc[ai][bj][m][n][j] * sc);
          }
          CBAR();
        }
    } else if (nt < 6) {
      const bool isq = nt < 4;
      const int gi = (isq ? nt - 2 : nt - 4) * 4 + wc;
      const int h = gi >> 1, comp = gi & 1;
      const float* gain = (const float*)(ws + OFF_SMALL) + (isq ? 0 : 256) + li * 64 + 8 * fq;
      const f32x4 g00 = *(const f32x4*)(gain), g01 = *(const f32x4*)(gain + 4), g10 = *(const f32x4*)(gain + 32), g11 = *(const f32x4*)(gain + 36);
      const float qsc = isq ? 0.125f * 1.4426950408889634f : 1.0f;
      const float* rope = (const float*)(ws + OFF_ROPE);
      u16* dbase = (u16*)(ws + (isq ? OFF_QN : OFF_KN));
#pragma unroll
      for (int ai = 0; ai < 2; ++ai)
#pragma unroll
        for (int m = 0; m < 4; ++m) {
          const int row = rbase + ai * 128 + m * 16;
          const bool valid = row < R;
          const int rowc = valid ? row : 0;
          int b, l; row_bl(rowc, valid ? b0 : 0, b, l);
          const float sc = scv[ai][m];
          f32x4 v00 = acc[ai][0][m][0] * sc, v01 = acc[ai][0][m][1] * sc, v10 = acc[ai][1][m][0] * sc, v11 = acc[ai][1][m][1] * sc;
          float ss = 0.f;
#pragma unroll
          for (int j = 0; j < 4; ++j) ss += v00[j] * v00[j] + v01[j] * v01[j] + v10[j] * v10[j] + v11[j] * v11[j];
          ss += __shfl_xor(ss, 16); ss += __shfl_xor(ss, 32);
          const float rq = rsqrtf(ss * (1.0f / 64.f) + EPS) * qsc;
          v00 = v00 * g00 * rq; v01 = v01 * g01 * rq; v10 = v10 * g10 * rq; v11 = v11 * g11 * rq;
          const f32x4 c0 = *(const f32x4*)(rope + l * 16), c1 = *(const f32x4*)(rope + l * 16 + 4), s0 = *(const f32x4*)(rope + l * 16 + 8), s1 = *(const f32x4*)(rope + l * 16 + 12);
          f32x4 p0, p1;
#pragma unroll
          for (int j = 0; j < 4; ++j) { p0[j] = __shfl_xor(v00[j], 16); p1[j] = __shfl_xor(v01[j], 16); }
          if (fq == 0) { v00 = v00 * c0 - p0 * s0; v01 = v01 * c1 - p1 * s1; }
          else if (fq == 1) { v00 = v00 * c0 + p0 * s0; v01 = v01 * c1 + p1 * s1; }
          if (valid) {
            u16* dst = dbase + (((size_t)(b * NH + h)) * LP + l) * 128 + comp * 64 + 8 * fq;
            u32x4 w0 = {cvtpk(v00[0], v00[1]), cvtpk(v00[2], v00[3]), cvtpk(v01[0], v01[1]), cvtpk(v01[2], v01[3])};
            u32x4 w1 = {cvtpk(v10[0], v10[1]), cvtpk(v10[2], v10[3]), cvtpk(v11[0], v11[1]), cvtpk(v11[2], v11[3])};
            *(u32x4*)(dst) = w0; *(u32x4*)(dst + 32) = w1;
          }
          CBAR();
        }
    } else if (nt < 8) {
      const int cv = (nt - 6) * 256 + wc * 64;
      const int h = cv >> 7, dv = (cv & 127) + 8 * fq;
      u16* vt = (u16*)(ws + OFF_VN);
#pragma unroll
      for (int ai = 0; ai < 2; ++ai)
#pragma unroll
        for (int m = 0; m < 4; ++m) {
          const int row = rbase + ai * 128 + m * 16;
          if (row < R) {
            int b, l; row_bl(row, b0, b, l);
            const float sc = scv[ai][m];
            const int o = l & 15;
            const int pos = (l & ~15) + 8 * ((o >> 2) & 1) + 4 * (o >> 3) + (o & 3);
            u16* dst = vt + ((size_t)(b * NH + h) * 128 + dv) * LP + pos;
#pragma unroll
            for (int bj = 0; bj < 2; ++bj)
#pragma unroll
              for (int n = 0; n < 2; ++n)
#pragma unroll
                for (int j = 0; j < 4; ++j) dst[(size_t)(bj * 32 + n * 4 + j) * LP] = f2bf(acc[ai][bj][m][n][j] * sc);
          }
          CBAR();
        }
    } else {
      u16* gg = (u16*)(ws + OFF_GG);
      const int cgc = (nt - 8) * 256 + wc * 64 + 8 * fq;
#pragma unroll
      for (int ai = 0; ai < 2; ++ai)
#pragma unroll
        for (int m = 0; m < 4; ++m) {
          const int row = rbase + ai * 128 + m * 16;
          if (row < R) {
            const float sc = scv[ai][m];
            u16* dst = gg + (size_t)row * DM + cgc;
#pragma unroll
            for (int bj = 0; bj < 2; ++bj) {
              f32x4 a = acc[ai][bj][m][0] * sc, c = acc[ai][bj][m][1] * sc;
#pragma unroll
              for (int j = 0; j < 4; ++j) { a[j] = a[j] * __builtin_amdgcn_rcpf(1.0f + __expf(-a[j])); c[j] = c[j] * __builtin_amdgcn_rcpf(1.0f + __expf(-c[j])); }
              u32x4 w = {cvtpk(a[0], a[1]), cvtpk(a[2], a[3]), cvtpk(c[0], c[1]), cvtpk(c[2], c[3])};
              *(u32x4*)(dst + bj * 32) = w;
            }
          }
          CBAR();
        }
    }
  }
};
DI void phaseA(const P2& p, int li, char* smem, int mode, int pn, unsigned* sig) {
  pg8::Gemm g; g.A = (const u16*)(p.ws + OFF_XB); g.Bt = (const u16*)(p.ws + OFF_WIN) + (size_t)li * INW * DM; g.M = RP; g.N = INW; g.K = DM;
  pg8::Order S; S.mode = mode; S.st.init(RP - 256, INW, gridDim.x, blockIdx.x); S.pm = RP / 256 - 1; S.pn = pn; S.sig = sig; S.bready = nullptr;
  EpiA E; E.ws = p.ws; E.li = li;
  pg8::gemm_phase((PG8_LAS unsigned char*)smem, g, S, E);
}

struct EpiC {
  char* ws; float* out; const float* x; const float* meta; int li;
  DI void operator()(const f32x4 (&acc)[2][2][4][2], const pg8::Unit& u, int wr, int wc, int fr, int fq) const {
    const int mt = u.pm, nt = u.pn;
    const bool last = (li == DEPTH - 1), first = (li == 0);
    u16* xb = (u16*)(ws + OFF_XB);
    float* rsp = (float*)(ws + OFF_RSS);
    const int b0 = (mt * 256) / L;
    const int rbase = mt * 256 + wr * 64 + fr;
    const int cb = nt * 256 + wc * 32 + 8 * fq;
#pragma unroll
    for (int ai = 0; ai < 2; ++ai)
#pragma unroll
      for (int m = 0; m < 4; ++m) {
        const int row = rbase + ai * 128 + m * 16;
        const bool valid = row < R;
        float ss = 0.f;
        if (valid) {
          int b, l; row_bl(row, b0, b, l);
          u16* xr = xb + (size_t)row * DM + cb;
          const float* xin = (l < NMETA ? meta + (size_t)l * DM : x + ((size_t)b * SEQ + (l - NMETA)) * DM) + cb;
          float* orow = out + ((size_t)b * SEQ + (l - NMETA)) * DM + cb;
#pragma unroll
          for (int bj = 0; bj < 2; ++bj) {
            f32x4 a, c;
            if (first) { a = *(const f32x4*)(xin + bj * 128); c = *(const f32x4*)(xin + bj * 128 + 4); }
            else { const u32x4 w = *(const u32x4*)(xr + bj * 128);
              a = f32x4{__uint_as_float(w[0] << 16), __uint_as_float(w[0] & 0xffff0000u), __uint_as_float(w[1] << 16), __uint_as_float(w[1] & 0xffff0000u)};
              c = f32x4{__uint_as_float(w[2] << 16), __uint_as_float(w[2] & 0xffff0000u), __uint_as_float(w[3] << 16), __uint_as_float(w[3] & 0xffff0000u)}; }
            a += acc[ai][bj][m][0]; c += acc[ai][bj][m][1];
            if (last) { if (l >= NMETA) { *(f32x4*)(orow + bj * 128) = a; *(f32x4*)(orow + bj * 128 + 4) = c; } }
            else { u32x4 w = {cvtpk(a[0], a[1]), cvtpk(a[2], a[3]), cvtpk(c[0], c[1]), cvtpk(c[2], c[3])}; *(u32x4*)(xr + bj * 128) = w; }
#pragma unroll
            for (int j = 0; j < 4; ++j) ss += a[j] * a[j] + c[j] * c[j];
          }
        }
        ss += __shfl_xor(ss, 16); ss += __shfl_xor(ss, 32);
        if (valid && !last && fq == 0) rsp[(size_t)row * 16 + nt * 4 + wc] = ss;
        if (m == 1 || m == 3) CBAR();
      }
  }
};
DI void phaseC(const P2& p, int li, char* smem, int mode, int pn, unsigned* sig) {
  pg8::Gemm g; g.A = (const u16*)(p.ws + OFF_GY); g.Bt = (const u16*)(p.ws + OFF_WOUT) + (size_t)li * DM * DM; g.M = RP; g.N = DM; g.K = DM;
  pg8::Order S; S.mode = mode; S.st.init(li == DEPTH - 1 ? RP : RP - 256, DM, gridDim.x, blockIdx.x); S.pm = RP / 256 - 1; S.pn = pn; S.sig = sig;
  S.bready = nullptr;
  EpiC E; E.ws = p.ws; E.out = p.out; E.x = p.x; E.meta = p.meta; E.li = li;
  pg8::gemm_phase((PG8_LAS unsigned char*)smem, g, S, E);
}

#define KSWZ(row, colB) ((row) * 256 + ((colB) ^ (((row) & 15) << 4)))
DI int v_st(int k, int c) { const int kk = (k & ~0xC) | ((k & 4) << 1) | ((k & 8) >> 1); return ((kk >> 3) * 4 + (c >> 5)) * 512 + ((kk & 7) * 32 + (c & 31)) * 2; }
DI int v_rd_base(int lane) { return ((lane & 3) << 3) | (((lane >> 2) & 3) << 6) | (((lane >> 4) & 1) << 5) | (((lane >> 5) & 1) << 8); }
constexpr int v_rd_off(int d0, int ks, int half) { return d0 * 512 + ks * 4096 + half * 2048; }
template <int OFF> DI s16x4 tr_read(int vb) {
  s16x4 r; asm volatile("ds_read_b64_tr_b16 %0, %1 offset:%2" : "=&v"(r) : "v"(vb), "i"(OFF) : "memory"); return r;
}
template <int D0> DI void pv_one(f32x16& od, int vb, bf16x8 pa0, bf16x8 pa1, bf16x8 pa2, bf16x8 pa3) {
  const s16x4 l0 = tr_read<v_rd_off(D0, 0, 0)>(vb), h0 = tr_read<v_rd_off(D0, 0, 1)>(vb), l1 = tr_read<v_rd_off(D0, 1, 0)>(vb), h1 = tr_read<v_rd_off(D0, 1, 1)>(vb);
  const s16x4 l2 = tr_read<v_rd_off(D0, 2, 0)>(vb), h2 = tr_read<v_rd_off(D0, 2, 1)>(vb), l3 = tr_read<v_rd_off(D0, 3, 0)>(vb), h3 = tr_read<v_rd_off(D0, 3, 1)>(vb);
  asm volatile("s_waitcnt lgkmcnt(0)" ::: "memory"); __builtin_amdgcn_sched_barrier(0);
#define PKV(Lo, Hi) (bf16x8){Lo[0], Lo[1], Lo[2], Lo[3], Hi[0], Hi[1], Hi[2], Hi[3]}
  od = MFMA32(pa0, PKV(l0, h0), od);
  od = MFMA32(pa1, PKV(l1, h1), od);
  od = MFMA32(pa2, PKV(l2, h2), od);
  od = MFMA32(pa3, PKV(l3, h3), od);
#undef PKV
}

DI void attn_tile(const P2& p, int li, int item, char* smem) {
  const int tid = opaque_tid(), wid = tid >> 6, lane = tid & 63, r32 = lane & 31, hi = lane >> 5;
  const int cm = wid >> 2, rg = wid & 3;
  const int bh = item / 33, qb = item - bh * 33;
  const int b = bh >> 2, h = bh & 3;
  const u16* Qh = (const u16*)(p.ws + OFF_QN) + (size_t)bh * LP * 128;
  const u16* Kh = (const u16*)(p.ws + OFF_KN) + (size_t)bh * LP * 128;
  const u16* Vh = (const u16*)(p.ws + OFF_VN) + (size_t)bh * 128 * LP;
  const float* cst = (const float*)(p.ws + OFF_CST) + li * 8;
  const float lam = cst[0], oml = cst[1];
  const int lq = qb * 128 + rg * 32 + r32;
  bf16x8 qr[4];
#pragma unroll
  for (int d0 = 0; d0 < 4; ++d0) qr[d0] = *(const bf16x8*)(Qh + (size_t)lq * 128 + cm * 64 + d0 * 16 + hi * 8);
  PG8_LAS unsigned char* ldsp = (PG8_LAS unsigned char*)smem;
  const int widu = __builtin_amdgcn_readfirstlane(wid);
  int kgo[2], vgo[2];
#pragma unroll
  for (int q = 0; q < 2; ++q) {
    const int rowk = 8 * wid + 4 * q + (lane >> 4), rowv = 16 * wid + 8 * q + (lane >> 3);
    kgo[q] = rowk * 128 + (((lane & 15) ^ (rowk & 15)) << 3);
    vgo[q] = rowv * LP + (((lane & 7) ^ ((rowv >> 1) & 7)) << 3);
  }
  int voff[4];
#pragma unroll
  for (int ks = 0; ks < 4; ++ks) voff[ks] = 16384 + r32 * 128 + (((2 * ks + hi) ^ ((r32 >> 1) & 7)) << 4);
  int koff[4];
#pragma unroll
  for (int d0 = 0; d0 < 4; ++d0) koff[d0] = r32 * 256 + ((cm * 128 + d0 * 32 + hi * 16) ^ ((r32 & 15) << 4));
  f32x16 o[4];
#pragma unroll
  for (int d = 0; d < 4; ++d)
#pragma unroll
    for (int r = 0; r < 16; ++r) o[d][r] = 0.f;
  float lsum = 0.f;
  f32x16 pA0, pA1, pB0, pB1;
  bf16x8 pa0, pa1, pa2, pa3;
#define SBAR() __builtin_amdgcn_sched_barrier(0)
#define GLDS(t, slot) do { const u16* kt_ = Kh + (size_t)(t) * 64 * 128; const u16* vt_ = Vh + (size_t)(t) * 64; \
    _Pragma("unroll") for (int q = 0; q < 2; ++q) __builtin_amdgcn_global_load_lds((const unsigned*)(kt_ + kgo[q]), (PG8_LAS unsigned*)(ldsp + (slot) + (2 * widu + q) * 1024), 16, 0, 0); \
    _Pragma("unroll") for (int q = 0; q < 2; ++q) __builtin_amdgcn_global_load_lds((const unsigned*)(vt_ + vgo[q]), (PG8_LAS unsigned*)(ldsp + (slot) + 16384 + (2 * widu + q) * 1024), 16, 0, 0); } while (0)
#define QKMM(P0, P1, kb_) do { _Pragma("unroll") for (int d0 = 0; d0 < 4; ++d0) { \
      const bf16x8 b0_ = *(const bf16x8*)((kb_) + koff[d0]); const bf16x8 b1_ = *(const bf16x8*)((kb_) + koff[d0] + 8192); \
      P0 = MFMA32(b0_, qr[d0], P0); P1 = MFMA32(b1_, qr[d0], P1); } } while (0)
  \
  \
#define QKT(P0, P1, ro, MASKED) do { const char* kb_ = smem + (ro); \
    _Pragma("unroll") for (int r = 0; r < 16; ++r) { P0[r] = 0.f; P1[r] = 0.f; } \
    QKMM(P0, P1, kb_); \
    if (MASKED) { _Pragma("unroll") for (int r = 8; r < 16; ++r) P0[r] = -1e30f; _Pragma("unroll") for (int r = 0; r < 16; ++r) P1[r] = -1e30f; } } while (0)
#define EXPS(P0, P1) do { _Pragma("unroll") for (int r = 0; r < 16; ++r) { P0[r] = __builtin_amdgcn_exp2f(P0[r]); P1[r] = __builtin_amdgcn_exp2f(P1[r]); } } while (0)
#define EXPH(P, B0_) do { _Pragma("unroll") for (int r = 0; r < 8; ++r) P[(B0_) + r] = __builtin_amdgcn_exp2f(P[(B0_) + r]); } while (0)
#define PK4(P, BASE, OUT) do { u32x4 w = {cvtpk(P[BASE + 0], P[BASE + 1]), cvtpk(P[BASE + 2], P[BASE + 3]), cvtpk(P[BASE + 4], P[BASE + 5]), cvtpk(P[BASE + 6], P[BASE + 7])}; \
    OUT = *reinterpret_cast<bf16x8*>(&w); } while (0)
#define PACK(P0, P1) do { float s0_ = P0[0], s1_ = P0[1], s2_ = P0[2], s3_ = P0[3]; \
    _Pragma("unroll") for (int r = 4; r < 16; r += 4) { s0_ = addf(s0_, P0[r]); s1_ = addf(s1_, P0[r + 1]); s2_ = addf(s2_, P0[r + 2]); s3_ = addf(s3_, P0[r + 3]); } \
    _Pragma("unroll") for (int r = 0; r < 16; r += 4) { s0_ = addf(s0_, P1[r]); s1_ = addf(s1_, P1[r + 1]); s2_ = addf(s2_, P1[r + 2]); s3_ = addf(s3_, P1[r + 3]); } \
    lsum += (s0_ + s1_) + (s2_ + s3_); \
    PK4(P0, 0, pa0); PK4(P0, 8, pa1); PK4(P1, 0, pa2); PK4(P1, 8, pa3); } while (0)
  \
  \
#define LOADV(V, D0, vb) do { V[0] = *(const bf16x8*)((vb) + voff[0] + (D0) * 4096); V[1] = *(const bf16x8*)((vb) + voff[1] + (D0) * 4096); \
    V[2] = *(const bf16x8*)((vb) + voff[2] + (D0) * 4096); V[3] = *(const bf16x8*)((vb) + voff[3] + (D0) * 4096); } while (0)
  \
#define EX2(P, i0) do { P[i0] = __builtin_amdgcn_exp2f(P[i0]); P[(i0) + 1] = __builtin_amdgcn_exp2f(P[(i0) + 1]); } while (0)
#define MME(D0, V, NXF, P, B0) do { o[D0] = MFMA32(pa0, V[0], o[D0]); if (NXF) EX2(P, (B0)); SBAR(); \
    o[D0] = MFMA32(pa1, V[1], o[D0]); if (NXF) EX2(P, (B0) + 2); SBAR(); \
    o[D0] = MFMA32(pa2, V[2], o[D0]); if (NXF) EX2(P, (B0) + 4); SBAR(); \
    o[D0] = MFMA32(pa3, V[3], o[D0]); if (NXF) EX2(P, (B0) + 6); } while (0)
#define MMV(D0, V) do { o[D0] = MFMA32(pa0, V[0], o[D0]); o[D0] = MFMA32(pa1, V[1], o[D0]); o[D0] = MFMA32(pa2, V[2], o[D0]); o[D0] = MFMA32(pa3, V[3], o[D0]); } while (0)
#define STEP(C0, C1, N0, N1, jj, NX, MASKED) do { const int j_ = (jj); \
    if (j_ + 3 < NKT) GLDS(j_ + 3, ((j_ + 3) & 3) * 32768);          \
    SBAR(); \
    if (act) { if (NX) QKT(N0, N1, ((j_ + 1) & 3) * 32768, MASKED); \
    PACK(C0, C1); } \
    SBAR(); \
    if (act) { const char* vb_ = smem + (j_ & 3) * 32768; bf16x8 va_[4], vc_[4]; \
      LOADV(va_, 0, vb_); SBAR(); \
      LOADV(vc_, 1, vb_); SBAR(); MME(0, va_, NX, N0, 0); SBAR(); \
      LOADV(va_, 2, vb_); SBAR(); MME(1, vc_, NX, N0, 8); SBAR(); \
      LOADV(vc_, 3, vb_); SBAR(); MME(2, va_, NX, N1, 0); SBAR(); \
      MME(3, vc_, NX, N1, 8); } \
    SBAR(); \
    if (j_ + 3 < NKT) asm volatile("s_waitcnt vmcnt(4)" ::: "memory"); else asm volatile("s_waitcnt vmcnt(0)" ::: "memory");     \
    asm volatile("s_waitcnt lgkmcnt(0)" ::: "memory"); \
    __builtin_amdgcn_s_barrier(); \
    asm volatile("" ::: "memory"); SBAR(); } while (0)
  GLDS(0, 0); GLDS(1, 32768); GLDS(2, 65536);
  asm volatile("s_waitcnt vmcnt(4)" ::: "memory");
  __builtin_amdgcn_s_barrier();
  asm volatile("" ::: "memory"); SBAR();
  const bool act = (qb < 32) || (rg == 0);
  QKT(pA0, pA1, 0, 0); EXPS(pA0, pA1);
  for (int j = 0; j < NKT - 3; j += 2) {
    STEP(pA0, pA1, pB0, pB1, j, 1, 0);
    STEP(pB0, pB1, pA0, pA1, j + 1, 1, 0);
  }
  STEP(pA0, pA1, pB0, pB1, NKT - 3, 1, 0);
  STEP(pB0, pB1, pA0, pA1, NKT - 2, 1, 1);
  STEP(pA0, pA1, pB0, pB1, NKT - 1, 0, 0);
  __syncthreads();
#undef STEP
#undef LOADV
#undef MMV
#undef MME
#undef EX2
#undef PACK
#undef PK4
#undef EXPS
#undef EXPH
#undef QKT
#undef QKMM
#undef GLDS
  lsum += __shfl_xor(lsum, 32);
  float inv = 1.0f / lsum; if (cm == 1) inv *= lam;
  float* li_l = (float*)(smem + 98304) + wid * 32;
  if (hi == 0) li_l[r32] = inv;
  __syncthreads();
  float rl[16];
#pragma unroll
  for (int r = 0; r < 16; ++r) rl[r] = li_l[crow(r, hi)];
#pragma unroll
  for (int d = 0; d < 4; ++d)
#pragma unroll
    for (int r = 0; r < 16; ++r) o[d][r] *= rl[r];
  float* xbuf = (float*)smem + rg * 4096;
  if (cm == 1) {
#pragma unroll
    for (int d = 0; d < 4; ++d)
#pragma unroll
      for (int r = 0; r < 16; ++r) xbuf[crow(r, hi) * 128 + d * 32 + r32] = o[d][r];
  }
  __syncthreads();
  if (cm == 0) {
    u16* gy = (u16*)(p.ws + OFF_GY); const u16* gg = (const u16*)(p.ws + OFF_GG);
    const float* sg = (const float*)(p.ws + OFF_SMALL) + 512 + li * 128;
    const float s0 = sg[r32], s1 = sg[32 + r32], s2 = sg[64 + r32], s3 = sg[96 + r32];
#pragma unroll
    for (int r = 0; r < 16; ++r) {
      const int rr = crow(r, hi);
      const float v0 = o[0][r] - xbuf[rr * 128 + r32], v1 = o[1][r] - xbuf[rr * 128 + 32 + r32];
      const float v2 = o[2][r] - xbuf[rr * 128 + 64 + r32], v3 = o[3][r] - xbuf[rr * 128 + 96 + r32];
      float ss = v0 * v0 + v1 * v1 + v2 * v2 + v3 * v3;
      ss += __shfl_xor(ss, 1); ss += __shfl_xor(ss, 2); ss += __shfl_xor(ss, 4); ss += __shfl_xor(ss, 8); ss += __shfl_xor(ss, 16);
      const float rinv = rsqrtf(ss * (1.0f / 128.f) + EPS) * oml;
      xbuf[rr * 128 + r32] = v0 * rinv * s0; xbuf[rr * 128 + 32 + r32] = v1 * rinv * s1;
      xbuf[rr * 128 + 64 + r32] = v2 * rinv * s2; xbuf[rr * 128 + 96 + r32] = v3 * rinv * s3;
    }
    asm volatile("s_waitcnt lgkmcnt(0)" ::: "memory");
#pragma unroll
    for (int it = 0; it < 8; ++it) {
      const int rw = it * 4 + (lane >> 4), c8 = (lane & 15) * 8;
      const int l = qb * 128 + rg * 32 + rw;
      const f32x4 a = *(const f32x4*)(xbuf + rw * 128 + c8), c = *(const f32x4*)(xbuf + rw * 128 + c8 + 4);
      if (l < L) {
        const size_t go = ((size_t)(b * L + l)) * DM + 512 + h * 128 + c8;
        const u32x4 gt = *(const u32x4*)(gg + go);
        u32x4 w;
        w[0] = cvtpk(a[0] * __uint_as_float(gt[0] << 16), a[1] * __uint_as_float(gt[0] & 0xffff0000u));
        w[1] = cvtpk(a[2] * __uint_as_float(gt[1] << 16), a[3] * __uint_as_float(gt[1] & 0xffff0000u));
        w[2] = cvtpk(c[0] * __uint_as_float(gt[2] << 16), c[1] * __uint_as_float(gt[2] & 0xffff0000u));
        w[3] = cvtpk(c[2] * __uint_as_float(gt[3] << 16), c[3] * __uint_as_float(gt[3] & 0xffff0000u));
        *(u32x4*)(gy + go) = w;
      }
    }
  }
  __syncthreads();
}

DI void fourier_tile(const P2& p, int li, int item, char* smem) {
  const int tid = opaque_tid(), wid = tid >> 6, lane = tid & 63, fr = lane & 15, fq = lane >> 4;
  const int qd = wid >> 2, wq = wid & 3;
  const int b = item / 36, rem = item - b * 36, g = rem / 9, kt = rem - g * 9;
  const u16* Cm = (const u16*)(p.ws + OFF_CM); const u16* Sm = (const u16*)(p.ws + OFF_SM);
  const u16* uta = (const u16*)(p.ws + OFF_UTA); const u16* utb = (const u16*)(p.ws + OFF_UTB);
  char* As = smem; char* Bs = smem + 65536;
  const int srow = tid >> 3, scc = tid & 7;
  const int soff = srow * 128 + ((scc ^ ((srow >> 1) & 7)) << 4);
  const u16* cgp = Cm + (size_t)(kt * 128 + srow) * KP + scc * 8;
  const u16* sgp = Sm + (size_t)(kt * 128 + srow) * KP + scc * 8;
  const u16* uap = uta + ((size_t)(b * 512 + g * 128 + srow)) * KP + scc * 8;
  const u16* ubp = utb + ((size_t)(b * 512 + g * 128 + srow)) * KP + scc * 8;
  u32x4 raA[4], ruaA[2], rubA[2];
#define FLOAD(ra, rua, rub, k2) do { ra[0] = *(const u32x4*)(cgp + (k2) * 64); ra[1] = *(const u32x4*)(cgp + (size_t)64 * KP + (k2) * 64); \
    ra[2] = *(const u32x4*)(sgp + (k2) * 64); ra[3] = *(const u32x4*)(sgp + (size_t)64 * KP + (k2) * 64); \
    rua[0] = *(const u32x4*)(uap + (k2) * 64); rua[1] = *(const u32x4*)(uap + (size_t)64 * KP + (k2) * 64); \
    rub[0] = *(const u32x4*)(ubp + (k2) * 64); rub[1] = *(const u32x4*)(ubp + (size_t)64 * KP + (k2) * 64); } while (0)
#define FWRITE(ra, rua, rub, bf) do { _Pragma("unroll") for (int i = 0; i < 4; ++i) *(u32x4*)(As + (bf) * 32768 + soff + i * 8192) = ra[i]; \
    _Pragma("unroll") for (int i = 0; i < 2; ++i) { u32x4 ev, ov; \
      _Pragma("unroll") for (int d = 0; d < 4; ++d) { const unsigned ua_ = rua[i][d], ub_ = rub[i][d]; \
        const float al = __uint_as_float(ua_ << 16), ah = __uint_as_float(ua_ & 0xffff0000u); \
        const float bl = __uint_as_float(ub_ << 16), bh_ = __uint_as_float(ub_ & 0xffff0000u); \
        ev[d] = cvtpk(al + bl, ah + bh_); ov[d] = cvtpk(al - bl, ah - bh_); } \
      *(u32x4*)(Bs + (bf) * 32768 + soff + i * 8192) = ev; *(u32x4*)(Bs + (bf) * 32768 + 16384 + soff + i * 8192) = ov; } } while (0)
  f32x4 acc[8][2], acc2[8][2];
#pragma unroll
  for (int m = 0; m < 8; ++m) { acc[m][0] = f32x4{0.f, 0.f, 0.f, 0.f}; acc[m][1] = f32x4{0.f, 0.f, 0.f, 0.f}; acc2[m][0] = f32x4{0.f, 0.f, 0.f, 0.f}; acc2[m][1] = f32x4{0.f, 0.f, 0.f, 0.f}; }
  const bf16x8 sgn = {0, (short)0x8000, 0, (short)0x8000, 0, (short)0x8000, 0, (short)0x8000};
  const int aoff0 = (qd * 128 + fr) * 128, boff0 = (qd * 128 + wq * 32 + fr) * 128, swz = fr >> 1;
  constexpr int NK2 = KP / 64;
#define FCOMP(buf) do { const char* Ab = As + (buf) * 32768; const char* Bb = Bs + (buf) * 32768; \
    _Pragma("unroll") for (int ks = 0; ks < 2; ++ks) { const int co = ((ks * 4 + fq) ^ swz) << 4; \
      const bf16x8 bf0 = *(const bf16x8*)(Bb + boff0 + co), bf1 = *(const bf16x8*)(Bb + boff0 + 2048 + co); \
      const bf16x8 bal0 = bf0 ^ sgn, bal1 = bf1 ^ sgn; \
      _Pragma("unroll") for (int mh = 0; mh < 2; ++mh) { bf16x8 af[4]; \
        _Pragma("unroll") for (int m = 0; m < 4; ++m) af[m] = *(const bf16x8*)(Ab + aoff0 + (mh * 4 + m) * 2048 + co); \
        _Pragma("unroll") for (int m = 0; m < 4; ++m) { acc[mh * 4 + m][0] = MFMA16(af[m], bf0, acc[mh * 4 + m][0]); acc[mh * 4 + m][1] = MFMA16(af[m], bf1, acc[mh * 4 + m][1]); \
          acc2[mh * 4 + m][0] = MFMA16(af[m], bal0, acc2[mh * 4 + m][0]); acc2[mh * 4 + m][1] = MFMA16(af[m], bal1, acc2[mh * 4 + m][1]); } } } } while (0)
  FLOAD(raA, ruaA, rubA, 0); FWRITE(raA, ruaA, rubA, 0);
  __syncthreads();
  for (int k2 = 0; k2 < NK2; ++k2) {
    const int buf = k2 & 1;
    if (k2 + 1 < NK2) FLOAD(raA, ruaA, rubA, k2 + 1);
    FCOMP(buf);
    if (k2 + 1 < NK2) FWRITE(raA, ruaA, rubA, buf ^ 1);
    __syncthreads();
  }
#undef FLOAD
#undef FWRITE
#undef FCOMP
  u16* gy = (u16*)(p.ws + OFF_GY); const u16* gg = (const u16*)(p.ws + OFF_GG);
  const u16* Mb = (const u16*)(p.ws + OFF_MCS) + ((size_t)(li * 4 + g) * 128) * 256;
  const int arow = wid * 16 + fr;
#pragma clang loop unroll(disable)
  for (int pass = 0; pass < 2; ++pass) {
#pragma unroll
    for (int m = 0; m < 8; ++m)
#pragma unroll
      for (int n = 0; n < 2; ++n)
#pragma unroll
        for (int j = 0; j < 4; ++j) {
          const int row = m * 16 + fq * 4 + j, col = qd * 128 + wq * 32 + n * 16 + fr;
          *(u16*)(smem + row * 512 + ((((col >> 3) ^ (row & 15))) << 4) + (col & 7) * 2) = f2bf(acc[m][n][j]);
        }
    __syncthreads();
    f32x4 accP[8], accQ[8];
#pragma unroll
    for (int n = 0; n < 8; ++n) { accP[n] = f32x4{0.f, 0.f, 0.f, 0.f}; accQ[n] = f32x4{0.f, 0.f, 0.f, 0.f}; }
#pragma clang loop unroll(disable)
    for (int ks = 0; ks < 4; ++ks) {
      const bf16x8 a = *(const bf16x8*)(smem + arow * 512 + (((ks * 4 + fq) ^ fr) << 4));
#pragma unroll
      for (int n = 0; n < 8; ++n) {
        const bf16x8 bb = *(const bf16x8*)(Mb + (size_t)(n * 16 + fr) * 256 + ks * 32 + fq * 8);
        accP[n] = MFMA16(a, bb, accP[n]);
      }
    }
#pragma clang loop unroll(disable)
    for (int ks = 4; ks < 8; ++ks) {
      const bf16x8 a = *(const bf16x8*)(smem + arow * 512 + (((ks * 4 + fq) ^ fr) << 4));
#pragma unroll
      for (int n = 0; n < 8; ++n) {
        const bf16x8 bb = *(const bf16x8*)(Mb + (size_t)(n * 16 + fr) * 256 + ks * 32 + fq * 8);
        accQ[n] = MFMA16(a, bb, accQ[n]);
      }
    }
    const float sq = pass ? -1.f : 1.f;
    float* stg = (float*)(smem + 65536 + wid * 8192);
#pragma unroll
    for (int half = 0; half < 2; ++half) {
      const float sh = half ? -sq : sq;
#pragma unroll
      for (int n = 0; n < 8; ++n)
#pragma unroll
        for (int j = 0; j < 4; ++j) stg[(fq * 4 + j) * 128 + n * 16 + fr] = accP[n][j] + sh * accQ[n][j];
      asm volatile("s_waitcnt lgkmcnt(0)" ::: "memory");
#pragma unroll
      for (int it = 0; it < 4; ++it) {
        const int rw = it * 4 + (lane >> 4), c8 = (lane & 15) * 8;
        const int k0 = kt * 128 + wid * 16 + rw;
        const int kk = pass ? LH - k0 : k0;
        bool ok = (k0 <= LH / 2) && !(pass && k0 == LH / 2);
        if (half) ok = ok && (kk >= 1) && (kk < LH);
        const int orow = half ? L - kk : kk;
        const f32x4 a = *(const f32x4*)(stg + rw * 128 + c8), c = *(const f32x4*)(stg + rw * 128 + c8 + 4);
        if (ok) {
          const size_t o1 = ((size_t)(b * L + orow)) * DM + g * 128 + c8;
          const u32x4 gt = *(const u32x4*)(gg + o1);
          u32x4 w;
          w[0] = cvtpk(a[0] * __uint_as_float(gt[0] << 16), a[1] * __uint_as_float(gt[0] & 0xffff0000u));
          w[1] = cvtpk(a[2] * __uint_as_float(gt[1] << 16), a[3] * __uint_as_float(gt[1] & 0xffff0000u));
          w[2] = cvtpk(c[0] * __uint_as_float(gt[2] << 16), c[1] * __uint_as_float(gt[2] & 0xffff0000u));
          w[3] = cvtpk(c[2] * __uint_as_float(gt[3] << 16), c[3] * __uint_as_float(gt[3] & 0xffff0000u));
          *(u32x4*)(gy + o1) = w;
        }
      }
      asm volatile("s_waitcnt lgkmcnt(0)" ::: "memory");
    }
    __syncthreads();
#pragma unroll
    for (int m = 0; m < 8; ++m) { acc[m][0] = acc2[m][0]; acc[m][1] = acc2[m][1]; }
  }
}

constexpr int N_ATT = NB * NH * 33;
constexpr int N_FOU = NB * 4 * 9;
#ifndef REPA
#define REPA 1
#endif
#ifndef REPB
#define REPB 1
#endif
#ifndef REPB_MODE
#define REPB_MODE 0
#endif
DI void phaseB(const P2& p, int li, char* smem, int rep) {
  int* qb_ = (int*)(p.ws + OFF_Q) + (li * 2 + rep) * 256;
  unsigned* bdone = (unsigned*)(p.ws + OFF_Q) + (li * 2) * 256 + 128;
  int* s_item = (int*)(smem + 131072);
  unsigned* sig1 = (unsigned*)(p.ws + OFF_CNT) + 40 + 2 * li + 1;
  const int myx = (int)(__builtin_amdgcn_s_getreg((3 << 11) | 20) & 7u);
  int d = 0;
  for (;;) {
    if (threadIdx.x == 0) {
      int dd = d, idx = -1, xq = 0;
      while (dd < 8) {
        xq = (myx + dd) & 7;
        idx = atomicAdd(qb_ + xq * 16, 1);
        if (idx < 168) break;
        idx = -1; ++dd;
      }
      s_item[0] = idx; s_item[1] = xq; s_item[3] = dd;
    }
    __syncthreads();
    const int idx = __builtin_amdgcn_readfirstlane(s_item[0]), xq = __builtin_amdgcn_readfirstlane(s_item[1]);
    d = __builtin_amdgcn_readfirstlane(s_item[3]);
    __syncthreads();
    if (idx < 0) break;
    const int grp = idx / 42, r = idx - grp * 42;
    int isf, sub;
    if (grp < 3) { const int f0 = (r * 9) / 42, f1 = ((r + 1) * 9) / 42; isf = f1 > f0; sub = isf ? f0 : r - f0; }
    else { isf = r >= 33; sub = isf ? r - 33 : r; }
    const int pair = xq + 8 * grp, bat = pair >> 2;
    if (bat == NB - 1) wait_sig(sig1, 96u);
    if (!isf) attn_tile(p, li, pair * 33 + sub, smem);
    else fourier_tile(p, li, bat * 36 + (pair & 3) * 9 + sub, smem);
  }
}

__global__ void __launch_bounds__(512) mega(Params p, int ph_begin, int ph_end) {
  __shared__ __attribute__((aligned(16))) char smem[131072 + 64 + 1024];
  if (ph_begin == 0) {
    phase0(p, smem);
    if (ph_end > 1) cg::this_grid().sync();
  }
  P2 q; q.out = p.out; q.ws = p.ws; q.x = p.x; q.meta = p.meta;
  unsigned nbar = 0;
#pragma clang loop unroll(disable)
  for (int ph = (ph_begin < 1 ? 1 : ph_begin); ph < ph_end; ++ph) {
    const int li = (ph - 1) / 3, s = (ph - 1) % 3;
    unsigned* sig0 = (unsigned*)(q.ws + OFF_CNT) + 40 + 2 * li;
    unsigned* sig1 = sig0 + 1;
    const int bx = blockIdx.x;
    { int mode = -1, lc = li;
      if (s == 2) mode = 0; else if (s == 1 && li > 0 && bx < 4) { mode = 1; lc = li - 1; }
      if (mode >= 0) phaseC(q, lc, smem, mode, bx, sig0); }
    { int mode = -1;
      if (s == 0) mode = 0; else if (s == 1 && bx >= 4 && bx < 16) { mode = 1; wait_sig(sig0, li > 0 ? 32u : 0u); }
      if (mode >= 0) phaseA(q, li, smem, mode, bx - 4, sig1); }
    if (s == 1) { for (int rep = 0; rep < REPB; ++rep) phaseB(q, li, smem, rep); }
    if (ph + 1 < ph_end) { ++nbar; grid_barrier((unsigned*)(q.ws + OFF_CNT) + 32, nbar * gridDim.x); }
  }
}

extern "C" void kernel_launch(void* const* d_in, const int* in_sizes, int n_in, void* d_out, int out_size, void* d_ws, size_t ws_size, hipStream_t stream) {
  if (ws_size < WS_END) { fprintf(stderr, "workspace too small: %zu < %zu\n", ws_size, (size_t)WS_END); return; }
  Params p{};
  p.x = (const float*)d_in[0]; p.meta = (const float*)d_in[1]; p.norm_gain = (const float*)d_in[2]; p.w_in = (const float*)d_in[3];
  p.w_f = (const float*)d_in[4]; p.qg = (const float*)d_in[5]; p.kg = (const float*)d_in[6]; p.lq1 = (const float*)d_in[7];
  p.lk1 = (const float*)d_in[8]; p.lq2 = (const float*)d_in[9]; p.lk2 = (const float*)d_in[10]; p.subln = (const float*)d_in[11];
  p.w_out = (const float*)d_in[12]; p.out = (float*)d_out; p.ws = (char*)d_ws;
  constexpr int NPH = 1 + 3 * DEPTH;
#if MULTI_LAUNCH
  for (int ph = 0; ph < NPH; ++ph) hipLaunchKernelGGL(mega, dim3(256), dim3(512), 0, stream, p, ph, ph + 1);
#else
  static int grid_blocks = 0;
  if (!grid_blocks) {
    int dev = 0, cus = 0, per_cu = 0;
    hipGetDevice(&dev);
    hipDeviceGetAttribute(&cus, hipDeviceAttributeMultiprocessorCount, dev);
    hipOccupancyMaxActiveBlocksPerMultiprocessor(&per_cu, mega, 512, 0);
    if (per_cu < 1) per_cu = 1;
    grid_blocks = cus * 1;
  }
  int b0 = 0, b1 = NPH;
  void* args[] = {&p, &b0, &b1};
  hipError_t e = hipLaunchCooperativeKernel((void*)mega, dim3(grid_blocks), dim3(512), args, 0, stream);
  if (e != hipSuccess) fprintf(stderr, "cooperative launch failed: %s (grid %d)\n", hipGetErrorString(e), grid_blocks);
#endif
}
```
